# Optimizing an MI355X kernel written in HIP

```python
import math
import jax, jax.numpy as jnp
from jax import lax
import numpy as np

D_MODEL = 1024
BATCH = 8
SEQ = 2048
DEPTH = 2

PLE_DIM = 256
N_MIXERS = 2
N_EVEN = (DEPTH + 1) // 2
N_ODD = DEPTH // 2

DH = 64
N_HEADS = D_MODEL // (2 * DH)
QK_WIDTH = N_HEADS * 2 * DH
V_WIDTH = N_HEADS * 2 * DH
QKV_WIDTH = 2 * QK_WIDTH + V_WIDTH
ATTN_SCALE = 1.0 / math.sqrt(DH)
ROPE_THETA = 10000.0
Q_BLOCK = 128

POOL_WINDOWS = (2, 4, 8, 16)
N_GROUPS = len(POOL_WINDOWS)
GROUP_W = D_MODEL // N_GROUPS

D_FF = 2816
N_EXPERTS = 8
TOP_K = 2
D_FF_EXPERT = 3584

RMS_EPS = 1e-6

kernel_name = "hybrid_diffattn_pool_moe_ple"


def rms_norm(x, g, eps=RMS_EPS):
    xf = x.astype(jnp.float32)
    y = xf * lax.rsqrt(jnp.mean(xf * xf, axis=-1, keepdims=True) + eps)
    return (y * g.astype(jnp.float32)).astype(x.dtype)


def rope_tables(seq, dim):
    inv = 1.0 / (ROPE_THETA ** (jnp.arange(0, dim, 2, dtype=jnp.float32) / dim))
    ang = jnp.arange(seq, dtype=jnp.float32)[:, None] * inv[None, :]
    return jnp.cos(ang), jnp.sin(ang)


def apply_rope(x, cos, sin):
    c = cos[None, :, None, None, :].astype(x.dtype)
    s = sin[None, :, None, None, :].astype(x.dtype)
    x1, x2 = jnp.split(x, 2, axis=-1)
    return jnp.concatenate([x1 * c - x2 * s, x2 * c + x1 * s], axis=-1)


def diff_attention(xn, w_qkv, w_o, q_norm, k_norm, lq1, lk1, lq2, lk2, subln_g, lam_init):
    B, S, _ = xn.shape
    qkv = xn @ w_qkv
    q, k, v = jnp.split(qkv, [QK_WIDTH, 2 * QK_WIDTH], axis=-1)
    q = q.reshape(B, S, N_HEADS, 2, DH)
    k = k.reshape(B, S, N_HEADS, 2, DH)
    v = v.reshape(B, S, N_HEADS, 2 * DH)
    cos, sin = rope_tables(S, DH)
    q = apply_rope(rms_norm(q, q_norm), cos, sin)
    k = apply_rope(rms_norm(k, k_norm), cos, sin)
    lam = (jnp.exp(jnp.sum(lq1.astype(jnp.float32) * lk1.astype(jnp.float32)))
           - jnp.exp(jnp.sum(lq2.astype(jnp.float32) * lk2.astype(jnp.float32)))
           + lam_init)
    outs = []
    for blk in range(S // Q_BLOCK):
        q0 = blk * Q_BLOCK
        q1 = q0 + Q_BLOCK
        qb = q[:, q0:q1]
        kb = k[:, :q1]
        vb = v[:, :q1]
        s = jnp.einsum('bqhcd,bkhcd->bhcqk', qb, kb).astype(jnp.float32) * ATTN_SCALE
        mask = jnp.arange(q1)[None, :] <= jnp.arange(q0, q1)[:, None]
        s = jnp.where(mask, s, -jnp.inf)
        a = jax.nn.softmax(s, axis=-1)
        a = a[:, :, 0] - lam * a[:, :, 1]
        outs.append(jnp.einsum('bhqk,bkhe->bqhe', a.astype(vb.dtype), vb))
    o = jnp.concatenate(outs, axis=1)
    o = rms_norm(o, subln_g) * (1.0 - lam_init)
    return o.reshape(B, S, V_WIDTH) @ w_o


def pool_mixer(xn, w_pool, b_pool, scale):
    B, S, D = xn.shape
    xg = xn.reshape(B, S, N_GROUPS, GROUP_W).astype(jnp.float32)
    csum = jnp.cumsum(xg, axis=1)
    t = jnp.arange(S)
    outs = []
    for g, w in enumerate(POOL_WINDOWS):
        cg = csum[:, :, g]
        prev = jnp.pad(cg, ((0, 0), (w, 0), (0, 0)))[:, :S]
        cnt = jnp.minimum(t + 1, w).astype(jnp.float32)[None, :, None]
        outs.append((cg - prev) / cnt - xg[:, :, g])
    y = jnp.stack(outs, axis=2).astype(xn.dtype)
    y = jnp.einsum('bsgc,gce->bsge', y, w_pool) + b_pool
    return y.reshape(B, S, D) * scale


def swiglu(xn, w_gate, w_up, w_down):
    return (jax.nn.silu(xn @ w_gate) * (xn @ w_up)) @ w_down


def moe_swiglu(xn, w_router, w_gate, w_up, w_down):
    logits = (xn @ w_router).astype(jnp.float32)
    top_v, top_i = lax.top_k(logits, TOP_K)
    top_w = jax.nn.softmax(top_v, axis=-1)
    gates = jnp.sum(jax.nn.one_hot(top_i, N_EXPERTS, dtype=jnp.float32) * top_w[..., None], axis=-2)
    out = jnp.zeros_like(xn)
    for e in range(N_EXPERTS):
        ye = swiglu(xn, w_gate[e], w_up[e], w_down[e])
        out = out + gates[..., e:e + 1].astype(xn.dtype) * ye
    return out


def setup_inputs(seed: int = 0) -> dict:
    key = jax.random.key(seed)
    ks = iter(jax.random.split(key, 40))
    f32 = jnp.float32

    def w(shape, fan_in):
        return jax.random.normal(next(ks), shape, f32) * (fan_in ** -0.5)

    def gain(shape):
        return 1.0 + 0.02 * jax.random.normal(next(ks), shape, f32)

    return {
        "x": jax.random.normal(next(ks), (BATCH, SEQ, D_MODEL), f32),
        "p": jax.random.normal(next(ks), (DEPTH, BATCH, SEQ, PLE_DIM), f32),
        "norm_mix": gain((DEPTH, D_MODEL)),
        "norm_ffn": gain((DEPTH, D_MODEL)),
        "norm_ple": gain((DEPTH, D_MODEL)),
        "attn_w_qkv": w((N_EVEN, D_MODEL, QKV_WIDTH), D_MODEL),
        "attn_w_o": w((N_EVEN, V_WIDTH, D_MODEL), V_WIDTH),
        "attn_q_norm": gain((N_EVEN, DH)),
        "attn_k_norm": gain((N_EVEN, DH)),
        "attn_lambda_q1": 0.1 * jax.random.normal(next(ks), (N_EVEN, DH), f32),
        "attn_lambda_k1": 0.1 * jax.random.normal(next(ks), (N_EVEN, DH), f32),
        "attn_lambda_q2": 0.1 * jax.random.normal(next(ks), (N_EVEN, DH), f32),
        "attn_lambda_k2": 0.1 * jax.random.normal(next(ks), (N_EVEN, DH), f32),
        "attn_subln": gain((N_EVEN, 2 * DH)),
        "pool_w": w((N_ODD, N_GROUPS, GROUP_W, GROUP_W), GROUP_W),
        "pool_b": 0.02 * jax.random.normal(next(ks), (N_ODD, N_GROUPS, GROUP_W), f32),
        "pool_scale": 1.0 + 0.1 * jax.random.normal(next(ks), (N_ODD, D_MODEL), f32),
        "ffn_w_gate": w((N_EVEN, D_MODEL, D_FF), D_MODEL),
        "ffn_w_up": w((N_EVEN, D_MODEL, D_FF), D_MODEL),
        "ffn_w_down": w((N_EVEN, D_FF, D_MODEL), D_FF),
        "moe_router": w((N_ODD, D_MODEL, N_EXPERTS), D_MODEL),
        "moe_w_gate": w((N_ODD, N_EXPERTS, D_MODEL, D_FF_EXPERT), D_MODEL),
        "moe_w_up": w((N_ODD, N_EXPERTS, D_MODEL, D_FF_EXPERT), D_MODEL),
        "moe_w_down": w((N_ODD, N_EXPERTS, D_FF_EXPERT, D_MODEL), D_FF_EXPERT),
        "ple_w_proj": w((DEPTH, PLE_DIM, D_MODEL), PLE_DIM),
        "ple_w_gate": w((DEPTH, D_MODEL, D_MODEL), D_MODEL),
    }


def reference(x, p, norm_mix, norm_ffn, norm_ple,
              attn_w_qkv, attn_w_o, attn_q_norm, attn_k_norm,
              attn_lambda_q1, attn_lambda_k1, attn_lambda_q2, attn_lambda_k2, attn_subln,
              pool_w, pool_b, pool_scale,
              ffn_w_gate, ffn_w_up, ffn_w_down,
              moe_router, moe_w_gate, moe_w_up, moe_w_down,
              ple_w_proj, ple_w_gate):
    h = x
    for i in range(DEPTH):
        j = i // 2
        xn = rms_norm(h, norm_mix[i])
        if i % N_MIXERS == 0:
            lam_init = 0.8 - 0.6 * math.exp(-0.3 * i)
            mix = diff_attention(xn, attn_w_qkv[j], attn_w_o[j], attn_q_norm[j], attn_k_norm[j],
                                 attn_lambda_q1[j], attn_lambda_k1[j],
                                 attn_lambda_q2[j], attn_lambda_k2[j], attn_subln[j], lam_init)
        else:
            mix = pool_mixer(xn, pool_w[j], pool_b[j], pool_scale[j])
        h = h + mix
        xn = rms_norm(h, norm_ffn[i])
        if i % 2 == 0:
            ff = swiglu(xn, ffn_w_gate[j], ffn_w_up[j], ffn_w_down[j])
        else:
            ff = moe_swiglu(xn, moe_router[j], moe_w_gate[j], moe_w_up[j], moe_w_down[j])
        h = h + ff
        gate = jax.nn.sigmoid(rms_norm(h, norm_ple[i]) @ ple_w_gate[i])
        h = h + gate * (p[i].astype(h.dtype) @ ple_w_proj[i])
    return h
```

```cpp
#include <hip/hip_runtime.h>
#include <math.h>
#include <stdint.h>
#include <stdio.h>

constexpr int D = 1024, NB = 8, S = 2048, M = NB * S, PLE = 256;
constexpr int DH = 64, NH = 8, QKW = 1024, QKVW = 3072;
constexpr int DFF = 2816, NE = 8, DFE = 3584;
constexpr float EPS = 1e-6f;
constexpr float LAM_INIT0 = 0.2f;

__device__ __forceinline__ float wave_sum(float v) {
#pragma unroll
    for (int o = 1; o < 64; o <<= 1) v += __shfl_xor(v, o);
    return v;
}
__device__ __forceinline__ float sigmoidf_(float v) { return 1.f / (1.f + __expf(-v)); }
__device__ __forceinline__ float siluf_(float v) { return v / (1.f + __expf(-v)); }

__global__ void k_rope_table(float2* tab) {
    const int idx = blockIdx.x * blockDim.x + threadIdx.x;
    if (idx >= S * 32) return;
    const int pos = idx >> 5, i = idx & 31;
    const float inv = 1.0f / exp2f((float)i * (13.287712379549449f / 32.f));
    const float ang = (float)pos * inv;
    const double a = (double)ang * 0.15915494309189535;
    const double fr = a - rint(a);
    const float f = (float)fr;
    tab[idx] = make_float2(__builtin_amdgcn_cosf(f), __builtin_amdgcn_sinf(f));
}

__global__ void __launch_bounds__(256) k_rmsnorm(const float* __restrict__ x, const float* __restrict__ g, float* __restrict__ out) {
    const int row = blockIdx.x * 4 + (threadIdx.x >> 6), lane = threadIdx.x & 63;
    const float4* xr = (const float4*)(x + (size_t)row * D);
    float4 v[4]; float s = 0.f;
#pragma unroll
    for (int j = 0; j < 4; ++j) { v[j] = xr[lane + 64 * j]; s += v[j].x * v[j].x + v[j].y * v[j].y + v[j].z * v[j].z + v[j].w * v[j].w; }
    const float r = rsqrtf(wave_sum(s) * (1.f / D) + EPS);
    float4* o = (float4*)(out + (size_t)row * D);
#pragma unroll
    for (int j = 0; j < 4; ++j) { const float4 gg = ((const float4*)g)[lane + 64 * j]; o[lane + 64 * j] = make_float4(v[j].x * r * gg.x, v[j].y * r * gg.y, v[j].z * r * gg.z, v[j].w * r * gg.w); }
}

struct EStore { float* C; int ldc; int pad; __device__ void operator()(int r, int c, float v) const { C[(size_t)r * ldc + c] = v; } };
struct EAddRes { const float* X; float* H; __device__ void operator()(int r, int c, float v) const { H[(size_t)r * D + c] = X[(size_t)r * D + c] + v; } };
struct ESiluMul { float* G; int ld; int pad; __device__ void operator()(int r, int c, float v) const { const size_t i = (size_t)r * ld + c; G[i] = siluf_(G[i]) * v; } };
struct EPle { float* H; const float* P; __device__ void operator()(int r, int c, float v) const { const size_t i = (size_t)r * D + c; H[i] = H[i] + sigmoidf_(v) * P[i]; } };
struct EPool { float* H; const float* bias; const float* scale; int colofs; int pad; __device__ void operator()(int r, int c, float v) const { const size_t i = (size_t)r * D + colofs + c; H[i] = H[i] + (v + bias[c]) * scale[colofs + c]; } };
struct EMoeDown { float* H; const int* list; const float* gw; __device__ void operator()(int r, int c, float v) const { const size_t i = (size_t)list[r] * D + c; H[i] = H[i] + gw[r] * v; } };

template <class Epi>
__global__ void __launch_bounds__(256) k_gemm(const float* __restrict__ A, int lda, const int* __restrict__ rowlist, const int* __restrict__ count_ptr, int Mrows,
                                              const float* __restrict__ Bm, int ldb, int K, Epi epi) {
    __shared__ float As[16][68];
    __shared__ float Bs[16][68];
    const int m0 = blockIdx.y * 64, n0 = blockIdx.x * 64;
    const int cnt = count_ptr ? *count_ptr : Mrows;
    if (m0 >= cnt) return;
    const int tid = threadIdx.x, tx = tid & 15, ty = tid >> 4;
    float acc[4][4];
#pragma unroll
    for (int i = 0; i < 4; ++i)
#pragma unroll
        for (int j = 0; j < 4; ++j) acc[i][j] = 0.f;
    const int ar = tid >> 2, ak = (tid & 3) * 4;
    const int arow = m0 + ar;
    const int src_row = (arow < cnt) ? (rowlist ? rowlist[arow] : arow) : -1;
    const int bk = tid >> 4, bn = (tid & 15) * 4;
    for (int k0 = 0; k0 < K; k0 += 16) {
        float4 av = make_float4(0.f, 0.f, 0.f, 0.f);
        if (src_row >= 0) av = *(const float4*)(A + (size_t)src_row * lda + k0 + ak);
        const float4 bv = *(const float4*)(Bm + (size_t)(k0 + bk) * ldb + n0 + bn);
        As[ak + 0][ar] = av.x; As[ak + 1][ar] = av.y; As[ak + 2][ar] = av.z; As[ak + 3][ar] = av.w;
        *(float4*)&Bs[bk][bn] = bv;
        __syncthreads();
#pragma unroll
        for (int kk = 0; kk < 16; ++kk) {
            const float4 a4 = *(const float4*)&As[kk][ty * 4];
            const float4 b4 = *(const float4*)&Bs[kk][tx * 4];
            const float a[4] = {a4.x, a4.y, a4.z, a4.w}, b[4] = {b4.x, b4.y, b4.z, b4.w};
#pragma unroll
            for (int i = 0; i < 4; ++i)
#pragma unroll
                for (int j = 0; j < 4; ++j) acc[i][j] = fmaf(a[i], b[j], acc[i][j]);
        }
        __syncthreads();
    }
#pragma unroll
    for (int i = 0; i < 4; ++i) {
        const int r = m0 + ty * 4 + i;
        if (r < cnt) {
#pragma unroll
            for (int j = 0; j < 4; ++j) epi(r, n0 + tx * 4 + j, acc[i][j]);
        }
    }
}

__global__ void __launch_bounds__(64) k_qknorm_rope(float* __restrict__ qkv, const float* __restrict__ qn, const float* __restrict__ kn, const float2* __restrict__ tab) {
    const int row = blockIdx.x >> 5, chunk = blockIdx.x & 31, d = threadIdx.x;
    float* p = qkv + (size_t)row * QKVW + chunk * 64;
    const float v = p[d];
    const float r = rsqrtf(wave_sum(v * v) * (1.f / 64.f) + EPS);
    const float y = v * r * (chunk < 16 ? qn[d] : kn[d]);
    const float other = __shfl_xor(y, 32);
    const float2 cs = tab[(row % S) * 32 + (d & 31)];
    p[d] = (d < 32) ? (y * cs.x - other * cs.y) : (y * cs.x + other * cs.y);
}

__global__ void __launch_bounds__(256) k_attn(const float* __restrict__ qkv, float* __restrict__ O  ) {
    __shared__ float Ks[64][64];
    __shared__ float Vs[64][64];
    const int qb = blockIdx.x & 7; int t = blockIdx.x >> 3; const int e = t & 1; t >>= 1; const int c = t & 1; t >>= 1; const int h = t & 7; const int b = t >> 3;
    const int tid = threadIdx.x;
    const int qrow = qb * 256 + tid;
    const size_t rowbase = (size_t)b * S;
    const float* qp = qkv + (rowbase + qrow) * QKVW + (h * 2 + c) * 64;
    float q[64], o[64];
#pragma unroll
    for (int i = 0; i < 64; ++i) { q[i] = qp[i] * 0.125f; o[i] = 0.f; }
    float m = -INFINITY, l = 0.f;
    const int nt = (qb + 1) * 4;
    for (int kt = 0; kt < nt; ++kt) {
        __syncthreads();
        for (int i = tid; i < 64 * 64; i += 256) { const int r = i >> 6, cc = i & 63; const float* src = qkv + (rowbase + kt * 64 + r) * QKVW;
            Ks[r][cc] = src[QKW + (h * 2 + c) * 64 + cc]; Vs[r][cc] = src[2 * QKW + h * 128 + e * 64 + cc]; }
        __syncthreads();
        for (int j = 0; j < 64; ++j) {
            const int key = kt * 64 + j;
            if (key > qrow) break;
            float s = 0.f;
#pragma unroll
            for (int i = 0; i < 64; ++i) s = fmaf(q[i], Ks[j][i], s);
            const float mn = fmaxf(m, s), corr = __expf(m - mn), pp = __expf(s - mn);
            l = l * corr + pp; m = mn;
#pragma unroll
            for (int i = 0; i < 64; ++i) o[i] = fmaf(pp, Vs[j][i], o[i] * corr);
        }
    }
    const float il = 1.f / l;
    float* op = O + (size_t)c * M * D + (rowbase + qrow) * D + h * 128 + e * 64;
#pragma unroll
    for (int i = 0; i < 64; ++i) op[i] = o[i] * il;
}

__global__ void __launch_bounds__(64) k_subln(const float* __restrict__ O, const float* __restrict__ lq1, const float* __restrict__ lk1, const float* __restrict__ lq2, const float* __restrict__ lk2,
                                              const float* __restrict__ sg, float* __restrict__ on) {
    const int row = blockIdx.x >> 3, h = blockIdx.x & 7, lane = threadIdx.x;
    const float lam = __expf(wave_sum(lq1[lane] * lk1[lane])) - __expf(wave_sum(lq2[lane] * lk2[lane])) + LAM_INIT0;
    const size_t i0 = (size_t)row * D + h * 128 + lane * 2;
    const float a0 = O[i0] - lam * O[(size_t)M * D + i0], a1 = O[i0 + 1] - lam * O[(size_t)M * D + i0 + 1];
    const float r = rsqrtf(wave_sum(a0 * a0 + a1 * a1) * (1.f / 128.f) + EPS) * (1.f - LAM_INIT0);
    on[i0] = a0 * r * sg[lane * 2]; on[i0 + 1] = a1 * r * sg[lane * 2 + 1];
}

__global__ void __launch_bounds__(256) k_pool(const float* __restrict__ xn, float* __restrict__ out) {
    const size_t idx = (size_t)blockIdx.x * 256 + threadIdx.x;
    const int row = (int)(idx >> 10), col = (int)(idx & 1023);
    const int g = col >> 8, w = 2 << g, t = row % S;
    const int cnt = (t + 1 < w) ? t + 1 : w;
    float s = 0.f;
    for (int k = 0; k < cnt; ++k) s += xn[(size_t)(row - k) * D + col];
    out[idx] = s / (float)cnt - xn[idx];
}

__global__ void __launch_bounds__(256) k_router(const float* __restrict__ xn, const float* __restrict__ wr, int2* __restrict__ e01, float2* __restrict__ g01) {
    const int row = blockIdx.x * 4 + (threadIdx.x >> 6), lane = threadIdx.x & 63;
    float acc[8];
#pragma unroll
    for (int e = 0; e < 8; ++e) acc[e] = 0.f;
    for (int k = lane; k < D; k += 64) { const float xv = xn[(size_t)row * D + k]; const float4 w0 = *(const float4*)(wr + k * 8), w1 = *(const float4*)(wr + k * 8 + 4);
        acc[0] = fmaf(xv, w0.x, acc[0]); acc[1] = fmaf(xv, w0.y, acc[1]); acc[2] = fmaf(xv, w0.z, acc[2]); acc[3] = fmaf(xv, w0.w, acc[3]);
        acc[4] = fmaf(xv, w1.x, acc[4]); acc[5] = fmaf(xv, w1.y, acc[5]); acc[6] = fmaf(xv, w1.z, acc[6]); acc[7] = fmaf(xv, w1.w, acc[7]); }
#pragma unroll
    for (int e = 0; e < 8; ++e) acc[e] = wave_sum(acc[e]);
    int i0 = 0; float v0 = acc[0];
#pragma unroll
    for (int e = 1; e < 8; ++e) if (acc[e] > v0) { v0 = acc[e]; i0 = e; }
    int i1 = -1; float v1 = -INFINITY;
#pragma unroll
    for (int e = 0; e < 8; ++e) if (e != i0 && acc[e] > v1) { v1 = acc[e]; i1 = e; }
    const float g1 = 1.f / (1.f + __expf(v0 - v1)), g0 = 1.f - g1;
    if (lane == 0) { e01[row] = make_int2(i0, i1); g01[row] = make_float2(g0, g1); }
}

__global__ void __launch_bounds__(1024) k_lists(const int2* __restrict__ e01, const float2* __restrict__ g01, int* __restrict__ lists, float* __restrict__ gws, int* __restrict__ counts) {
    __shared__ int wsum[16];
    __shared__ int base_s;
    const int e = blockIdx.x, tid = threadIdx.x, lane = tid & 63, wv = tid >> 6;
    if (tid == 0) base_s = 0;
    __syncthreads();
    for (int chunk = 0; chunk < M / 1024; ++chunk) {
        const int tok = chunk * 1024 + tid;
        const int2 ee = e01[tok]; const float2 gg = g01[tok];
        const bool sel = (ee.x == e) || (ee.y == e);
        const float gv = (ee.x == e) ? gg.x : gg.y;
        const unsigned long long bal = __ballot(sel);
        const int pre = __popcll(bal & ((1ull << lane) - 1ull));
        if (lane == 0) wsum[wv] = __popcll(bal);
        __syncthreads();
        int off = base_s, tot = 0;
        for (int w = 0; w < 16; ++w) { const int c = wsum[w]; if (w < wv) off += c; tot += c; }
        if (sel) { lists[e * M + off + pre] = tok; gws[e * M + off + pre] = gv; }
        __syncthreads();
        if (tid == 0) base_s += tot;
        __syncthreads();
    }
    if (tid == 0) counts[e] = base_s;
}

template <class Epi>
static void gemm(hipStream_t st, const float* A, int lda, const int* rowlist, const int* count_ptr, int Mrows, const float* Bm, int ldb, int N, int K, Epi epi) {
    dim3 grid(N / 64, Mrows / 64);
    hipLaunchKernelGGL(k_gemm<Epi>, grid, dim3(256), 0, st, A, lda, rowlist, count_ptr, Mrows, Bm, ldb, K, epi);
}

extern "C" void kernel_launch(void* const* d_in, const int* in_sizes, int n_in, void* d_out, int out_size, void* d_ws, size_t ws_size, hipStream_t stream) {
    const float* x = (const float*)d_in[0];
    const float* p = (const float*)d_in[1];
    const float* norm_mix = (const float*)d_in[2];
    const float* norm_ffn = (const float*)d_in[3];
    const float* norm_ple = (const float*)d_in[4];
    const float* w_qkv = (const float*)d_in[5];
    const float* w_o = (const float*)d_in[6];
    const float* q_norm = (const float*)d_in[7];
    const float* k_norm = (const float*)d_in[8];
    const float* lq1 = (const float*)d_in[9];
    const float* lk1 = (const float*)d_in[10];
    const float* lq2 = (const float*)d_in[11];
    const float* lk2 = (const float*)d_in[12];
    const float* subln = (const float*)d_in[13];
    const float* pool_w = (const float*)d_in[14];
    const float* pool_b = (const float*)d_in[15];
    const float* pool_scale = (const float*)d_in[16];
    const float* ffn_wg = (const float*)d_in[17];
    const float* ffn_wu = (const float*)d_in[18];
    const float* ffn_wd = (const float*)d_in[19];
    const float* moe_router = (const float*)d_in[20];
    const float* moe_wg = (const float*)d_in[21];
    const float* moe_wu = (const float*)d_in[22];
    const float* moe_wd = (const float*)d_in[23];
    const float* ple_wp = (const float*)d_in[24];
    const float* ple_wg = (const float*)d_in[25];
    float* H = (float*)d_out;

    constexpr size_t MiB = 1u << 20;
    char* ws = (char*)d_ws;
    if (n_in != 26 || ws_size < 420 * MiB) { fprintf(stderr, "kernel_launch: unexpected inputs / workspace\n"); return; }
    float2* ROPE = (float2*)(ws);
    int2* E01 = (int2*)(ws + 1 * MiB);
    float2* G01 = (float2*)(ws + 1 * MiB + 256 * 1024);
    int* COUNTS = (int*)(ws + 1 * MiB + 512 * 1024);
    int* LISTS = (int*)(ws + 2 * MiB);
    float* GWS = (float*)(ws + 3 * MiB);
    float* XN = (float*)(ws + 4 * MiB);
    float* BIG = (float*)(ws + 68 * MiB);
    float* OB = (float*)(ws + 292 * MiB);
    float* PROJ = OB;

    hipLaunchKernelGGL(k_rope_table, dim3(S * 32 / 256), dim3(256), 0, stream, ROPE);
    hipLaunchKernelGGL(k_rmsnorm, dim3(M / 4), dim3(256), 0, stream, x, norm_mix, XN);
    gemm(stream, XN, D, nullptr, nullptr, M, w_qkv, QKVW, QKVW, D, EStore{BIG, QKVW, 0});
    hipLaunchKernelGGL(k_qknorm_rope, dim3(M * 32), dim3(64), 0, stream, BIG, q_norm, k_norm, ROPE);
    hipLaunchKernelGGL(k_attn, dim3(NB * NH * 2 * 2 * 8), dim3(256), 0, stream, BIG, OB);
    hipLaunchKernelGGL(k_subln, dim3(M * 8), dim3(64), 0, stream, OB, lq1, lk1, lq2, lk2, subln, XN);
    gemm(stream, XN, D, nullptr, nullptr, M, w_o, D, D, D, EAddRes{x, H});
    hipLaunchKernelGGL(k_rmsnorm, dim3(M / 4), dim3(256), 0, stream, H, norm_ffn, XN);
    gemm(stream, XN, D, nullptr, nullptr, M, ffn_wg, DFF, DFF, D, EStore{BIG, DFF, 0});
    gemm(stream, XN, D, nullptr, nullptr, M, ffn_wu, DFF, DFF, D, ESiluMul{BIG, DFF, 0});
    gemm(stream, BIG, DFF, nullptr, nullptr, M, ffn_wd, D, D, DFF, EAddRes{H, H});
    hipLaunchKernelGGL(k_rmsnorm, dim3(M / 4), dim3(256), 0, stream, H, norm_ple, XN);
    gemm(stream, p, PLE, nullptr, nullptr, M, ple_wp, D, D, PLE, EStore{PROJ, D, 0});
    gemm(stream, XN, D, nullptr, nullptr, M, ple_wg, D, D, D, EPle{H, PROJ});
    hipLaunchKernelGGL(k_rmsnorm, dim3(M / 4), dim3(256), 0, stream, H, norm_mix + D, XN);
    hipLaunchKernelGGL(k_pool, dim3(M * D / 256), dim3(256), 0, stream, XN, BIG);
    for (int g = 0; g < 4; ++g)
        gemm(stream, BIG + g * 256, D, nullptr, nullptr, M, pool_w + (size_t)g * 256 * 256, 256, 256, 256, EPool{H, pool_b + g * 256, pool_scale, g * 256, 0});
    hipLaunchKernelGGL(k_rmsnorm, dim3(M / 4), dim3(256), 0, stream, H, norm_ffn + D, XN);
    hipLaunchKernelGGL(k_router, dim3(M / 4), dim3(256), 0, stream, XN, moe_router, E01, G01);
    hipLaunchKernelGGL(k_lists, dim3(NE), dim3(1024), 0, stream, E01, G01, LISTS, GWS, COUNTS);
    for (int e = 0; e < NE; ++e) {
        const size_t wo = (size_t)e * D * DFE;
        gemm(stream, XN, D, LISTS + e * M, COUNTS + e, M, moe_wg + wo, DFE, DFE, D, EStore{BIG, DFE, 0});
        gemm(stream, XN, D, LISTS + e * M, COUNTS + e, M, moe_wu + wo, DFE, DFE, D, ESiluMul{BIG, DFE, 0});
        gemm(stream, BIG, DFE, nullptr, COUNTS + e, M, moe_wd + wo, D, D, DFE, EMoeDown{H, LISTS + e * M, GWS + e * M});
    }
    hipLaunchKernelGGL(k_rmsnorm, dim3(M / 4), dim3(256), 0, stream, H, norm_ple + D, XN);
    gemm(stream, p + (size_t)M * PLE, PLE, nullptr, nullptr, M, ple_wp + (size_t)PLE * D, D, D, PLE, EStore{PROJ, D, 0});
    gemm(stream, XN, D, nullptr, nullptr, M, ple_wg + (size_t)D * D, D, D, D, EPle{H, PROJ});
}
```

```cpp
#define MEGA_END 17
#define MK_N_LAUNCHES 1
#include <hip/hip_runtime.h>
#include <cstdio>
#include <cstdint>
namespace pg8 {
#define PG8_LAS __attribute__((address_space(3)))
typedef unsigned short bf16_t;
typedef short bf16x8 __attribute__((ext_vector_type(8)));
typedef float f32x4 __attribute__((ext_vector_type(4)));
typedef float f32x2 __attribute__((ext_vector_type(2)));
typedef unsigned u32x4 __attribute__((ext_vector_type(4)));
typedef unsigned u32x2 __attribute__((ext_vector_type(2)));
constexpr int BM = 256, BK = 64, HALF = 128, HTB = HALF * BK * 2  , STAGE_BYTES = 8 * HTB, NXCD = 8;

__host__ __device__ __forceinline__ int lds_byte(int r, int c) { const int st = (r >> 4) * 2 + (c >> 5), rr = r & 15, cc = c & 31, ob = rr * 64 + cc * 2; return st * 1024 + (ob ^ (((ob >> 9) & 1) << 5)); }
__host__ __device__ __forceinline__ void stage_rc(int b, int& R, int& C) { const int st = b / 1024, sb = b % 1024, swz = sb ^ (((sb >> 9) & 1) << 5); R = (st >> 1) * 16 + swz / 64; C = (st & 1) * 32 + (swz % 64) / 2; }
__host__ __device__ __forceinline__ int perm32(int rho) { const int n = rho >> 4, i = rho & 15; return 8 * (i >> 2) + 4 * n + (i & 3); }

struct Unit { const char* A; const char* B; const int* list; int r0, c0, nvalid, ex; };
struct Pre { float rs[2][4]; };

__device__ __forceinline__ unsigned cvt_pk_bf16(float lo, float hi) { unsigned r; asm volatile("v_cvt_pk_bf16_f32 %0, %1, %2" : "=v"(r) : "v"(lo), "v"(hi)); return r; }
__device__ __forceinline__ float bf_lo(unsigned w) { return __uint_as_float(w << 16); }
__device__ __forceinline__ float bf_hi(unsigned w) { return __uint_as_float(w & 0xffff0000u); }

__device__ __forceinline__ void tile_of(int L, int nM, int nN, int& pm, int& pn, int WGM = 8) {
    const int nwg = nM * nN; int wgid = L; { const int q = nwg / NXCD, r = nwg % NXCD, xcd = wgid % NXCD, off = wgid / NXCD; wgid = (xcd < r ? xcd * (q + 1) : r * (q + 1) + (xcd - r) * q) + off; }
    const int nig = WGM * nN, gid = wgid / nig, fm = gid * WGM, gsz = (nM - fm) < WGM ? (nM - fm) : WGM;
    pm = fm + ((wgid % nig) % gsz); pn = (wgid % nig) / gsz;
}
struct DenseSched {
    const char* A; const char* B; int nM, nN, G, c; long a_pm, a_pn, b_pn; int wgm;
    __device__ __forceinline__ bool next(int i, Unit& u) const {
        if (c < 0) return false; const long L = (long)i * G + c; if (L >= (long)nM * nN) return false;
        int pm, pn; tile_of((int)L, nM, nN, pm, pn, wgm);
        u.A = A + pm * a_pm + pn * a_pn; u.B = B + pn * b_pn; u.list = nullptr; u.r0 = pm * BM; u.c0 = pn * BM; u.nvalid = BM; u.ex = 0; return true;
    }
};
struct ProjSched {
    const char* A0; const char* B0; long dA, dB; int G, c;
    __device__ __forceinline__ bool next(int i, Unit& u) const {
        if (c < 0) return false; const long L = (long)i * G + c; if (L >= 64 * 8) return false;
        int pm, pn; tile_of((int)L, 64, 8, pm, pn, 8); const int layer = pn >> 2, pc = pn & 3;
        u.A = A0 + layer * dA + (long)pm * (256 * 256 * 2); u.B = B0 + layer * dB + (long)pc * (256 * 256 * 2); u.list = nullptr; u.r0 = pm * BM; u.c0 = pc * BM; u.nvalid = BM; u.ex = layer; return true;
    }
};
struct MoeSched {
    const char* A; const char* B; const int* lists; int cnt[8]; int nN, G, c; long b_e, b_pn, a_row; int list_stride; bool gather; int lim; int WGM;
    __device__ __forceinline__ int total() const { int tot = 0;
#pragma unroll
        for (int e = 0; e < 8; ++e) tot += ((cnt[e] + 255) >> 8) * nN;
        return tot; }
    __device__ __forceinline__ void decode(int L, Unit& u) const {
        const int tot = total();
        int w = L; { const int q = tot / NXCD, r = tot % NXCD, xcd = w % NXCD, off = w / NXCD; w = (xcd < r ? xcd * (q + 1) : r * (q + 1) + (xcd - r) * q) + off; }
        int ex = 0, off_rows = 0, tiles = 0, ce = 0; bool found = false;
#pragma unroll
        for (int e = 0; e < 8; ++e) { const int t = (cnt[e] + 255) >> 8, ue = t * nN; if (!found) { if (w < ue) { found = true; ex = e; tiles = t; ce = cnt[e]; } else { w -= ue; off_rows += cnt[e]; } } }
        const int nig = WGM * nN, gid = w / nig, fm = gid * WGM, gsz = (tiles - fm) < WGM ? (tiles - fm) : WGM;
        const int pm = fm + ((w % nig) % gsz), pn = (w % nig) / gsz;
        u.r0 = off_rows + pm * BM; u.c0 = pn * BM; u.nvalid = (ce - pm * BM) < BM ? (ce - pm * BM) : BM; u.ex = ex;
        u.B = B + ex * b_e + pn * b_pn;
        u.list = lists + (long)ex * list_stride + pm * BM;
        u.A = gather ? A : A + (long)u.r0 * a_row;
    }
    __device__ __forceinline__ bool next(int i, Unit& u) const {
        const long L0 = (long)i * G + c; if (L0 >= lim) return false;
        decode((int)L0, u); return true;
    }
};
struct PieceSched {
    MoeSched S; int L0, R, P; long kbytes;
    __device__ __forceinline__ bool next(int i, Unit& u) const {
        if (i != 0 || S.c >= R * P) return false;
        const int q = S.c, j = q / P, p = q - j * P;
        S.decode(L0 + j, u); u.A += p * kbytes; u.B += p * kbytes; u.ex = q; return true;
    }
};

template <class Epi, class Sched, bool GATHER, bool ALIGN_EPI>
__device__ __forceinline__ void gemm_phase(PG8_LAS unsigned char* lds, const int K, const int lda, const int ldb, const Sched& S, const Epi& E) {
    int tid_ = threadIdx.x; asm volatile("" : "+v"(tid_));
    const int tid = tid_, wid = __builtin_amdgcn_readfirstlane(tid >> 6), lane = tid & 63, wr = wid >> 2, wc = wid & 3, fr = lane & 15, fq = lane >> 4;
    int Kr_ = K; asm volatile("" : "+s"(Kr_));
    const int nt = Kr_ / BK;
    int RA[2], CA[2]; unsigned voffB[2];
#pragma unroll
    for (int i = 0; i < 2; ++i) { int R, C; stage_rc(tid * 16 + i * 8192, R, C); RA[i] = R; CA[i] = C; const int Rb = Epi::PERM ? ((R & ~31) + perm32(R & 31)) : R; voffB[i] = (unsigned)(Rb * ldb + C) * 2u; }
    const size_t kstep = (size_t)(BK * 2);
    const size_t hstep = (size_t)HALF * ldb * 2;
    const unsigned ldsw = (unsigned)wid * 1024u;
    const int aoff = lds_byte(wr * 64 + fr, fq * 8), boff = lds_byte(wc * 32 + fr, fq * 8);
#define PG8_SA(b, h) (((b) * 2 + (h)) * HTB)
#define PG8_SB(b, h) ((4 + (b) * 2 + (h)) * HTB)
#define PG8_STAGE(bufoff, gbase, voff) do { _Pragma("unroll") for (int _i = 0; _i < 2; ++_i) \
        __builtin_amdgcn_global_load_lds((const unsigned*)((const char*)(gbase) + (voff)[_i]), (PG8_LAS unsigned*)(lds + (bufoff) + ldsw + _i * 8192), 16, 0, 0); } while (0)
#define PG8_SETOFF(v, u) do { _Pragma("unroll") for (int _h = 0; _h < 2; ++_h) _Pragma("unroll") for (int _i = 0; _i < 2; ++_i) { const int _r = _h * HALF + RA[_i]; \
        if constexpr (GATHER) { const int _rr = _r < (u).nvalid ? _r : (u).nvalid - 1; v[_h][_i] = (unsigned)(u).list[_rr] * (unsigned)(lda * 2) + (unsigned)(CA[_i] * 2); } \
        else { v[_h][_i] = (unsigned)(_r * lda + CA[_i]) * 2u; } } } while (0)
#define PG8_LDA(dst, b, h) do { _Pragma("unroll") for (int m = 0; m < 4; ++m) _Pragma("unroll") for (int k = 0; k < 2; ++k) dst[m][k] = *(const PG8_LAS bf16x8*)(lds + PG8_SA(b, h) + aoff + m * 2048 + k * 1024); } while (0)
#define PG8_LDB(dst, b, h) do { _Pragma("unroll") for (int n = 0; n < 2; ++n) _Pragma("unroll") for (int k = 0; k < 2; ++k) dst[n][k] = *(const PG8_LAS bf16x8*)(lds + PG8_SB(b, h) + boff + n * 2048 + k * 1024); } while (0)
#define PG8_MMA(ai, bj, At, Bt) do { __builtin_amdgcn_s_setprio(1); _Pragma("unroll") for (int m = 0; m < 4; ++m) _Pragma("unroll") for (int n = 0; n < 2; ++n) _Pragma("unroll") for (int k = 0; k < 2; ++k) \
        acc[ai][bj][m][n] = __builtin_amdgcn_mfma_f32_16x16x32_bf16(Bt[n][k], At[m][k], acc[ai][bj][m][n], 0, 0, 0); __builtin_amdgcn_s_setprio(0); } while (0)
#define PG8_WAIT_V(n) asm volatile("s_waitcnt vmcnt(" #n ")" ::: "memory")
#define PG8_WAIT_L(n) asm volatile("s_waitcnt lgkmcnt(" #n ")" ::: "memory")
#define PG8_BAR __builtin_amdgcn_s_barrier()
#define PG8_SCHED __builtin_amdgcn_sched_barrier(0)
    Unit cur, nxt; int ui = 0;
    if (!S.next(0, cur)) return;
    unsigned va[2][2], vn[2][2];
    PG8_SETOFF(va, cur);
    Pre pre; E.prefetch(cur, wr, fr, pre);
#pragma unroll
    for (int h = 0; h < 2; ++h)
#pragma unroll
        for (int i = 0; i < 2; ++i) vn[h][i] = va[h][i];
    f32x4 acc[2][2][4][2];
#pragma unroll
    for (int a = 0; a < 2; ++a)
#pragma unroll
        for (int b = 0; b < 2; ++b)
#pragma unroll
            for (int m = 0; m < 4; ++m)
#pragma unroll
                for (int n = 0; n < 2; ++n) acc[a][b][m][n] = (f32x4){0.f, 0.f, 0.f, 0.f};
    bf16x8 At[4][2], B0[2][2], B1[2][2];
    const char* cA = cur.A; const char* cB = cur.B;
    PG8_STAGE(PG8_SB(0, 0), cB, voffB); PG8_STAGE(PG8_SB(0, 1), cB + hstep, voffB); PG8_STAGE(PG8_SA(0, 0), cA, va[0]); PG8_STAGE(PG8_SA(0, 1), cA, va[1]);
    if (wr == 1) PG8_BAR;
    PG8_WAIT_V(2); PG8_BAR;
    PG8_STAGE(PG8_SB(1, 0), cB + kstep, voffB); PG8_STAGE(PG8_SA(1, 0), cA + kstep, va[0]); PG8_STAGE(PG8_SB(1, 1), cB + hstep + kstep, voffB);
    PG8_WAIT_V(6); PG8_BAR;
    for (;;) {
        const bool has_next = S.next(ui + 1, nxt);
        if constexpr (GATHER) { if (has_next) {
#pragma unroll
            for (int h = 0; h < 2; ++h)
#pragma unroll
                for (int i = 0; i < 2; ++i) { const int r_ = h * HALF + RA[i]; vn[h][i] = (unsigned)nxt.list[r_ < nxt.nvalid ? r_ : nxt.nvalid - 1]; } } }
        const char* nA = has_next ? nxt.A : cA; const char* nB = has_next ? nxt.B : cB;
        for (int t = 0; t < nt; t += 2) {
            const bool last = (t == nt - 2);
            const char* a1 = cA + (size_t)(t + 1) * kstep;
            const char* a2 = last ? nA : cA + (size_t)(t + 2) * kstep; const char* b2 = last ? nB : cB + (size_t)(t + 2) * kstep;
            const char* a3 = a2 + kstep; const char* b3 = b2 + kstep;
            unsigned o2[2][2];
#pragma unroll
            for (int h = 0; h < 2; ++h)
#pragma unroll
                for (int i = 0; i < 2; ++i) { if constexpr (GATHER) o2[h][i] = (last && has_next) ? vn[h][i] * (unsigned)(lda * 2) + (unsigned)(CA[i] * 2) : va[h][i]; else o2[h][i] = va[h][i]; }
            PG8_LDB(B0, 0, 0); PG8_LDB(B1, 0, 1); PG8_SCHED; PG8_LDA(At, 0, 0); PG8_STAGE(PG8_SA(1, 1), a1, va[1]);
            PG8_WAIT_V(8); PG8_WAIT_L(0); PG8_BAR; PG8_MMA(0, 0, At, B0); PG8_MMA(0, 1, At, B1); PG8_BAR; PG8_SCHED;
            PG8_LDA(At, 0, 1); PG8_STAGE(PG8_SB(0, 0), b2, voffB); PG8_STAGE(PG8_SB(0, 1), b2 + hstep, voffB); PG8_STAGE(PG8_SA(0, 0), a2, o2[0]);
            PG8_WAIT_V(8); PG8_WAIT_L(0); PG8_BAR; PG8_MMA(1, 0, At, B0); PG8_MMA(1, 1, At, B1); PG8_BAR; PG8_SCHED;
            PG8_LDB(B0, 1, 0); PG8_LDB(B1, 1, 1); PG8_SCHED; PG8_LDA(At, 1, 0); PG8_STAGE(PG8_SA(0, 1), a2, o2[1]);
            PG8_WAIT_V(8); PG8_WAIT_L(0); PG8_BAR; PG8_MMA(0, 0, At, B0); PG8_MMA(0, 1, At, B1); PG8_BAR; PG8_SCHED;
            PG8_LDA(At, 1, 1); PG8_STAGE(PG8_SB(1, 0), b3, voffB); PG8_STAGE(PG8_SB(1, 1), b3 + hstep, voffB); PG8_STAGE(PG8_SA(1, 0), a3, o2[0]);
            PG8_WAIT_V(8); PG8_WAIT_L(0); PG8_BAR; PG8_MMA(1, 0, At, B0); PG8_MMA(1, 1, At, B1); PG8_BAR; PG8_SCHED;
        }
        if constexpr (ALIGN_EPI) { if (wr == 0) PG8_BAR; }
        E(acc, cur, wr, wc, fr, fq, pre);
        if (!has_next) break;
#pragma unroll
        for (int a = 0; a < 2; ++a)
#pragma unroll
            for (int b = 0; b < 2; ++b)
#pragma unroll
                for (int m = 0; m < 4; ++m)
#pragma unroll
                    for (int n = 0; n < 2; ++n) acc[a][b][m][n] = (f32x4){0.f, 0.f, 0.f, 0.f};
        cur = nxt; cA = nA; cB = nB; ++ui;
        E.prefetch(cur, wr, fr, pre);
#pragma unroll
        for (int h = 0; h < 2; ++h)
#pragma unroll
            for (int i = 0; i < 2; ++i) { if constexpr (GATHER) va[h][i] = vn[h][i] * (unsigned)(lda * 2) + (unsigned)(CA[i] * 2); else va[h][i] = vn[h][i]; }
        if constexpr (ALIGN_EPI) { if (wr == 1) PG8_BAR; }
    }
    PG8_WAIT_V(0);
    if constexpr (!ALIGN_EPI) { if (wr == 0) PG8_BAR; }
    PG8_BAR;
#undef PG8_SA
#undef PG8_SB
#undef PG8_STAGE
#undef PG8_SETOFF
#undef PG8_LDA
#undef PG8_LDB
#undef PG8_MMA
#undef PG8_WAIT_V
#undef PG8_WAIT_L
#undef PG8_BAR
#undef PG8_SCHED
}
}
namespace pg8 {
constexpr float LOG2E = 1.4426950408889634f;
__device__ __forceinline__ float fast_sigmoid(float v) { return __builtin_amdgcn_rcpf(1.f + __builtin_amdgcn_exp2f(-v * LOG2E)); }
__device__ __forceinline__ f32x4 sig4(f32x4 v) { return (f32x4){fast_sigmoid(v[0]), fast_sigmoid(v[1]), fast_sigmoid(v[2]), fast_sigmoid(v[3])}; }
__device__ __forceinline__ u32x4 pack8(f32x4 a, f32x4 b) { u32x4 w; w.x = cvt_pk_bf16(a[0], a[1]); w.y = cvt_pk_bf16(a[2], a[3]); w.z = cvt_pk_bf16(b[0], b[1]); w.w = cvt_pk_bf16(b[2], b[3]); return w; }

struct EpiQKV {
    static constexpr bool PERM = true;
    bf16_t* Q; size_t split_stride  ; const float* qkn  ; const float* cosT; const float* sinT; float c2, eps;
    __device__ __forceinline__ void prefetch(const Unit&, int, int, Pre&) const {}
    __device__ __forceinline__ void operator()(const f32x4 (&acc)[2][2][4][2], const Unit& u, int wr, int wc, int fr, int fq, const Pre& pre) const {
        const int which = u.c0 >> 10, colt = u.c0 & 1023;
        bf16_t* base = Q + (size_t)which * split_stride;
        const int ocol = colt + 64 * wc + 8 * fq;
        if (which == 2) {
#pragma unroll
            for (int ai = 0; ai < 2; ++ai)
#pragma unroll
                for (int m = 0; m < 4; ++m) { bf16_t* rowp = base + (size_t)(u.r0 + ai * HALF + wr * 64 + m * 16 + fr) * 1024 + ocol;
#pragma unroll
                    for (int bj = 0; bj < 2; ++bj) *(u32x4*)(rowp + 32 * bj) = pack8(acc[ai][bj][m][0], acc[ai][bj][m][1]); }
        } else {
            const float* gp = qkn + 64 * which; const float sc = which == 0 ? c2 : 1.f;
            f32x4 g[2][2];
#pragma unroll
            for (int bj = 0; bj < 2; ++bj)
#pragma unroll
                for (int n = 0; n < 2; ++n) g[bj][n] = *(const f32x4*)(gp + 32 * bj + 8 * fq + 4 * n);
#pragma unroll
            for (int ai = 0; ai < 2; ++ai)
#pragma unroll
                for (int m = 0; m < 4; ++m) {
                    const int row = u.r0 + ai * HALF + wr * 64 + m * 16 + fr, pos = row & 2047;
                    f32x4 c[2], s[2];
#pragma unroll
                    for (int n = 0; n < 2; ++n) { c[n] = *(const f32x4*)(cosT + pos * 32 + 8 * fq + 4 * n); s[n] = *(const f32x4*)(sinT + pos * 32 + 8 * fq + 4 * n); }
                    float ss = 0.f;
#pragma unroll
                    for (int bj = 0; bj < 2; ++bj)
#pragma unroll
                        for (int n = 0; n < 2; ++n) { const f32x4 v = acc[ai][bj][m][n]; ss += (v[0] * v[0] + v[1] * v[1]) + (v[2] * v[2] + v[3] * v[3]); }
                    ss += __shfl_xor(ss, 16); ss += __shfl_xor(ss, 32);
                    const float rstd = __builtin_amdgcn_rsqf(ss * (1.f / 64.f) + eps);
                    f32x4 o0[2], o1[2];
#pragma unroll
                    for (int n = 0; n < 2; ++n) { const f32x4 y0 = acc[ai][0][m][n] * rstd * g[0][n], y1 = acc[ai][1][m][n] * rstd * g[1][n];
                        o0[n] = (y0 * c[n] - y1 * s[n]) * sc; o1[n] = (y1 * c[n] + y0 * s[n]) * sc; }
                    bf16_t* rowp = base + (size_t)row * 1024 + ocol;
                    *(u32x4*)(rowp) = pack8(o0[0], o0[1]); *(u32x4*)(rowp + 32) = pack8(o1[0], o1[1]);
                }
        }
    }
};
__device__ __forceinline__ float row_rstd(const float* ssqp, int row, float eps) {
    const f32x4* p = (const f32x4*)(ssqp + (size_t)row * 16); const f32x4 a = p[0], b = p[1], c = p[2], d = p[3];
    const float s = (((a[0] + a[1]) + (a[2] + a[3])) + ((b[0] + b[1]) + (b[2] + b[3]))) + (((c[0] + c[1]) + (c[2] + c[3])) + ((d[0] + d[1]) + (d[2] + d[3])));
    return __builtin_amdgcn_rsqf(s * (1.f / 1024.f) + eps);
}
__device__ __forceinline__ f32x4 bf4(u32x2 w) { return (f32x4){bf_lo(w.x), bf_hi(w.x), bf_lo(w.y), bf_hi(w.y)}; }
template <bool BASE_BF16> struct EpiResNorm {
    static constexpr bool PERM = false;
    const void* base; bf16_t* hb; float* ssqp;
    __device__ __forceinline__ void prefetch(const Unit&, int, int, Pre&) const {}
    __device__ __forceinline__ void operator()(const f32x4 (&acc)[2][2][4][2], const Unit& u, int wr, int wc, int fr, int fq, const Pre& pre) const {
        const int col0 = u.c0 + wc * 32 + 4 * fq;
#pragma unroll
        for (int ai = 0; ai < 2; ++ai)
#pragma unroll
            for (int m = 0; m < 4; ++m) { const int row = u.r0 + ai * HALF + wr * 64 + m * 16 + fr; const size_t off = (size_t)row * 1024 + col0; float ss = 0.f;
#pragma unroll
                for (int bj = 0; bj < 2; ++bj)
#pragma unroll
                    for (int n = 0; n < 2; ++n) { const size_t o2 = off + bj * HALF + n * 16;
                        f32x4 b; if constexpr (BASE_BF16) b = bf4(*(const u32x2*)((const bf16_t*)base + o2)); else b = *(const f32x4*)((const float*)base + o2);
                        const f32x4 h = b + acc[ai][bj][m][n]; u32x2 w; w.x = cvt_pk_bf16(h[0], h[1]); w.y = cvt_pk_bf16(h[2], h[3]); *(u32x2*)(hb + o2) = w;
                        const f32x4 hr = bf4(w); ss += (hr[0] * hr[0] + hr[1] * hr[1]) + (hr[2] * hr[2] + hr[3] * hr[3]); }
                ss += __shfl_xor(ss, 16); ss += __shfl_xor(ss, 32);
                if (fq == 0) ssqp[(size_t)row * 16 + (u.c0 >> 8) * 4 + wc] = ss; }
    }
};
template <int RS  > struct EpiSwiGLU {
    static constexpr bool PERM = true;
    bf16_t* O; int ldo; float eps; const float* ssqp; const int* lists_base;
    __device__ __forceinline__ void prefetch(const Unit& u, int wr, int fr, Pre& pre) const {
#pragma unroll
        for (int ai = 0; ai < 2; ++ai)
#pragma unroll
            for (int m = 0; m < 4; ++m) { const int rl = ai * HALF + wr * 64 + m * 16 + fr;
                if constexpr (RS == 1) pre.rs[ai][m] = row_rstd(ssqp, u.r0 + rl, eps); else pre.rs[ai][m] = ssqp[(u.list - lists_base) + (rl < u.nvalid ? rl : u.nvalid - 1)]; }
    }
    __device__ __forceinline__ void operator()(const f32x4 (&acc)[2][2][4][2], const Unit& u, int wr, int wc, int fr, int fq, const Pre& pre) const {
        const int col0 = (u.c0 >> 1) + wc * 32 + 8 * fq;
#pragma unroll
        for (int ai = 0; ai < 2; ++ai)
#pragma unroll
            for (int m = 0; m < 4; ++m) { const int rl = ai * HALF + wr * 64 + m * 16 + fr;
                const float rs = pre.rs[ai][m];
                f32x4 o[2];
#pragma unroll
                for (int n = 0; n < 2; ++n) { const f32x4 gt = acc[ai][0][m][n] * rs, up = acc[ai][1][m][n] * rs; o[n] = gt * sig4(gt) * up; }
                if (rl < u.nvalid) *(u32x4*)(O + (size_t)(u.r0 + rl) * ldo + col0) = pack8(o[0], o[1]); }
    }
};
struct EpiProj {
    static constexpr bool PERM = true;
    bf16_t* P0; long dP;
    __device__ __forceinline__ void prefetch(const Unit&, int, int, Pre&) const {}
    __device__ __forceinline__ void operator()(const f32x4 (&acc)[2][2][4][2], const Unit& u, int wr, int wc, int fr, int fq, const Pre& pre) const {
        bf16_t* base = P0 + u.ex * dP; const int col0 = u.c0 + wc * 32 + 8 * fq;
#pragma unroll
        for (int ai = 0; ai < 2; ++ai)
#pragma unroll
            for (int m = 0; m < 4; ++m) { bf16_t* rowp = base + (size_t)(u.r0 + ai * HALF + wr * 64 + m * 16 + fr) * 1024 + col0;
#pragma unroll
                for (int bj = 0; bj < 2; ++bj) *(u32x4*)(rowp + bj * HALF) = pack8(acc[ai][bj][m][0], acc[ai][bj][m][1]); }
    }
};
template <int RS, bool OUT_F32> struct EpiPle {
    static constexpr bool PERM = false;
    const bf16_t* Hin; const bf16_t* P; void* out; const float* ssq_in; float* ssq_out; float eps; int pad;
    __device__ __forceinline__ void prefetch(const Unit& u, int wr, int fr, Pre& pre) const {
#pragma unroll
        for (int ai = 0; ai < 2; ++ai)
#pragma unroll
            for (int m = 0; m < 4; ++m) { const int row = u.r0 + ai * HALF + wr * 64 + m * 16 + fr;
                if constexpr (RS == 1) pre.rs[ai][m] = row_rstd(ssq_in, row, eps); else pre.rs[ai][m] = ssq_in[row]; }
    }
    __device__ __forceinline__ void operator()(const f32x4 (&acc)[2][2][4][2], const Unit& u, int wr, int wc, int fr, int fq, const Pre& pre) const {
        const int col0 = u.c0 + wc * 32 + 4 * fq;
#pragma unroll
        for (int ai = 0; ai < 2; ++ai)
#pragma unroll
            for (int m = 0; m < 4; ++m) { const int row = u.r0 + ai * HALF + wr * 64 + m * 16 + fr; const size_t off = (size_t)row * 1024 + col0; float ss = 0.f;
                const float rs = pre.rs[ai][m];
#pragma unroll
                for (int bj = 0; bj < 2; ++bj)
#pragma unroll
                    for (int n = 0; n < 2; ++n) { const size_t o2 = off + bj * HALF + n * 16;
                        const f32x4 h = bf4(*(const u32x2*)(Hin + o2)) + sig4(acc[ai][bj][m][n] * rs) * bf4(*(const u32x2*)(P + o2));
                        if constexpr (OUT_F32) *(f32x4*)((float*)out + o2) = h;
                        else { u32x2 w; w.x = cvt_pk_bf16(h[0], h[1]); w.y = cvt_pk_bf16(h[2], h[3]); *(u32x2*)((bf16_t*)out + o2) = w; const f32x4 hr = bf4(w); ss += (hr[0] * hr[0] + hr[1] * hr[1]) + (hr[2] * hr[2] + hr[3] * hr[3]); } }
                if constexpr (!OUT_F32) { ss += __shfl_xor(ss, 16); ss += __shfl_xor(ss, 32); if (fq == 0) ssq_out[(size_t)row * 16 + (u.c0 >> 8) * 4 + wc] = ss; } }
    }
};
struct EpiPool {
    static constexpr bool PERM = false;
    bf16_t* HB; const float* bias; const float* scale;
    __device__ __forceinline__ void prefetch(const Unit&, int, int, Pre&) const {}
    __device__ __forceinline__ void operator()(const f32x4 (&acc)[2][2][4][2], const Unit& u, int wr, int wc, int fr, int fq, const Pre& pre) const {
        const int col0 = u.c0 + wc * 32 + 4 * fq;
#pragma unroll
        for (int bj = 0; bj < 2; ++bj)
#pragma unroll
            for (int n = 0; n < 2; ++n) { const f32x4 bv = *(const f32x4*)(bias + col0 + bj * HALF + n * 16), sv = *(const f32x4*)(scale + col0 + bj * HALF + n * 16);
#pragma unroll
                for (int ai = 0; ai < 2; ++ai)
#pragma unroll
                    for (int m = 0; m < 4; ++m) { const size_t o2 = (size_t)(u.r0 + ai * HALF + wr * 64 + m * 16 + fr) * 1024 + col0 + bj * HALF + n * 16;
                        const f32x4 h = bf4(*(const u32x2*)(HB + o2)) + (acc[ai][bj][m][n] + bv) * sv; u32x2 w; w.x = cvt_pk_bf16(h[0], h[1]); w.y = cvt_pk_bf16(h[2], h[3]); *(u32x2*)(HB + o2) = w; } }
    }
};
struct EpiMoeDown {
    static constexpr bool PERM = true;
    bf16_t* Ys;
    __device__ __forceinline__ void prefetch(const Unit& u, int wr, int fr, Pre& pre) const { const float* gw = (const float*)u.list;
#pragma unroll
        for (int ai = 0; ai < 2; ++ai)
#pragma unroll
            for (int m = 0; m < 4; ++m) { const int rl = ai * HALF + wr * 64 + m * 16 + fr; pre.rs[ai][m] = gw[rl < u.nvalid ? rl : u.nvalid - 1]; }
    }
    __device__ __forceinline__ void operator()(const f32x4 (&acc)[2][2][4][2], const Unit& u, int wr, int wc, int fr, int fq, const Pre& pre) const {
        const int col0 = u.c0 + wc * 32 + 8 * fq;
#pragma unroll
        for (int ai = 0; ai < 2; ++ai)
#pragma unroll
            for (int m = 0; m < 4; ++m) { const int rl = ai * HALF + wr * 64 + m * 16 + fr;
                if (rl < u.nvalid) { const float g = pre.rs[ai][m]; bf16_t* rowp = Ys + (size_t)(u.r0 + rl) * 1024 + col0;
#pragma unroll
                    for (int bj = 0; bj < 2; ++bj) *(u32x4*)(rowp + bj * HALF) = pack8(acc[ai][bj][m][0] * g, acc[ai][bj][m][1] * g); } }
    }
};
struct EpiPart {
    static constexpr bool PERM = false;
    float* PART;
    __device__ __forceinline__ void prefetch(const Unit&, int, int, Pre&) const {}
    __device__ __forceinline__ void operator()(const f32x4 (&acc)[2][2][4][2], const Unit& u, int wr, int wc, int fr, int fq, const Pre& pre) const {
        float* base = PART + (size_t)u.ex * 65536 + wc * 32 + 4 * fq;
#pragma unroll
        for (int ai = 0; ai < 2; ++ai)
#pragma unroll
            for (int m = 0; m < 4; ++m) { float* rowp = base + (size_t)(ai * HALF + wr * 64 + m * 16 + fr) * 256;
#pragma unroll
                for (int bj = 0; bj < 2; ++bj)
#pragma unroll
                    for (int n = 0; n < 2; ++n) *(f32x4*)(rowp + bj * HALF + n * 16) = acc[ai][bj][m][n]; }
    }
};
}
#include <hip/hip_bf16.h>
#include <cmath>
namespace attn_body {
using bf16=__hip_bfloat16;
using bf16x8=__attribute__((ext_vector_type(8)))short;
using s16x4=__attribute__((ext_vector_type(4)))short;
using f32x16=__attribute__((ext_vector_type(16)))float;
using u32x4=__attribute__((ext_vector_type(4)))unsigned;
constexpr int BATCH=8,SEQ=2048,D=64,DM=1024;
constexpr int NW=8,QBLK=32,QB=QBLK*NW,KVBLK=64,NQB=SEQ/QB;
constexpr int ATTN_PITCH=DM, ATTN_UNIT_ROWS=QB;
__device__ __forceinline__ int crow(int r,int hi){return (r&3)+8*(r>>2)+4*hi;}
#define SBAR() __builtin_amdgcn_sched_barrier(0)
__device__ __forceinline__ void cmask(f32x16&p0,f32x16&p1,int jb,int qrel,int hi){
  const float NEG=-INFINITY; int kb=64*jb+4*hi;
  #pragma unroll
  for(int r=0;r<16;++r){int kv=kb+(r&3)+8*(r>>2); if(kv>qrel)p0[r]=NEG; if(kv+32>qrel)p1[r]=NEG;}
}

constexpr int NSLOT=3, SLOTB=8192;
constexpr int LDS_K=0, LDS_V=NSLOT*SLOTB, LDS_WS=2*NSLOT*SLOTB, LDS_OST=LDS_WS+NW*64*4, LDS_BYTES=LDS_OST+NW*4096;
constexpr float C2=0.125f*1.4426950408889634f;
__device__ __forceinline__ void glds16(const void*gsrc,unsigned lds_dst){unsigned keep;
  asm volatile("s_mov_b32 %0, m0\n\ts_mov_b32 m0, %2\n\ts_nop 0\n\tglobal_load_lds_dwordx4 %1, off\n\ts_mov_b32 m0, %0":"=&s"(keep):"v"(gsrc),"s"(lds_dst):"memory");}
__device__ __forceinline__ float max3f(float a,float b,float c){float r;asm("v_max3_f32 %0, %1, %2, %3":"=v"(r):"v"(a),"v"(b),"v"(c));return r;}
__device__ __forceinline__ float max2f(float a,float b){float r;asm("v_max_f32_e32 %0, %1, %2":"=v"(r):"v"(a),"v"(b));return r;}
__device__ __forceinline__ float fadd_s(float a,float b){float r;asm("v_add_f32_e32 %0, %1, %2":"=v"(r):"v"(a),"v"(b));return r;}
__device__ __forceinline__ float fsub_s(float a,float b){float r;asm("v_sub_f32_e32 %0, %1, %2":"=v"(r):"v"(a),"v"(b));return r;}
typedef float f32x2_t __attribute__((ext_vector_type(2))); typedef __bf16 bf16x2_t __attribute__((ext_vector_type(2)));
__device__ __forceinline__ unsigned cvtpk_s(float lo,float hi){f32x2_t v={lo,hi};bf16x2_t b=__builtin_convertvector(v,bf16x2_t);return __builtin_bit_cast(unsigned,b);}
#define WAIT_BAR(N) asm volatile("s_waitcnt vmcnt(" #N ") lgkmcnt(0)\n\ts_barrier":::"memory")

__device__ __forceinline__ void qkt(f32x16&p0,f32x16&p1,const char*Kslot,const bf16x8*qr,const f32x16&negm,int r32,int hi){
  const char*kb=Kslot+hi*1024+r32*16;
  #pragma unroll
  for(int d0=0;d0<4;++d0){
    const bf16x8 b0=*reinterpret_cast<const bf16x8*>(kb+d0*2048);
    const bf16x8 b1=*reinterpret_cast<const bf16x8*>(kb+d0*2048+512);
    if(d0==0){p0=__builtin_amdgcn_mfma_f32_32x32x16_bf16(b0,qr[0],negm,0,0,0);p1=__builtin_amdgcn_mfma_f32_32x32x16_bf16(b1,qr[0],negm,0,0,0);}
    else{p0=__builtin_amdgcn_mfma_f32_32x32x16_bf16(b0,qr[d0],p0,0,0,0);p1=__builtin_amdgcn_mfma_f32_32x32x16_bf16(b1,qr[d0],p1,0,0,0);}}
}
typedef __attribute__((address_space(3))) const char* lds_cptr;
typedef short v4i16_t __attribute__((ext_vector_type(4)));
__device__ __forceinline__ void kload8(bf16x8*kf,lds_cptr kp){
  kf[0]=*(const __attribute__((address_space(3))) bf16x8*)(kp);      kf[1]=*(const __attribute__((address_space(3))) bf16x8*)(kp+512);
  kf[2]=*(const __attribute__((address_space(3))) bf16x8*)(kp+2048); kf[3]=*(const __attribute__((address_space(3))) bf16x8*)(kp+2560);
  kf[4]=*(const __attribute__((address_space(3))) bf16x8*)(kp+4096); kf[5]=*(const __attribute__((address_space(3))) bf16x8*)(kp+4608);
  kf[6]=*(const __attribute__((address_space(3))) bf16x8*)(kp+6144); kf[7]=*(const __attribute__((address_space(3))) bf16x8*)(kp+6656);
}
__device__ __forceinline__ void kload2(bf16x8*kf,lds_cptr kp,int j){ kf[2*j]=*(const __attribute__((address_space(3))) bf16x8*)(kp+j*2048); kf[2*j+1]=*(const __attribute__((address_space(3))) bf16x8*)(kp+j*2048+512); }
__device__ __forceinline__ s16x4 vtr(lds_cptr p){ return __builtin_bit_cast(s16x4,__builtin_amdgcn_ds_read_tr16_b64_v4i16((__attribute__((address_space(3))) v4i16_t*)p)); }
__device__ __forceinline__ float rowmax(const f32x16&p0,const f32x16&p1){
  float a=max3f(p0[0],p0[1],p1[0]),b=max3f(p0[2],p0[3],p1[1]);a=max3f(a,p1[2],p1[3]);
  #pragma unroll
  for(int r=4;r<16;r+=4){a=max3f(a,p0[r],p0[r+1]);b=max3f(b,p0[r+2],p0[r+3]);a=max3f(a,p1[r],p1[r+1]);b=max3f(b,p1[r+2],p1[r+3]);}
  const float m=max2f(a,b);
  auto rr=__builtin_amdgcn_permlane32_swap(__float_as_uint(m),__float_as_uint(m),false,false);
  return max2f(__uint_as_float(rr[0]),__uint_as_float(rr[1]));
}
__device__ __forceinline__ void pv(f32x16*o,int vb,bf16x8 pa0,bf16x8 pa1,bf16x8 pa2,bf16x8 pa3){
  #pragma unroll
  for(int d0=0;d0<2;++d0){s16x4 lo[4],hi[4];
    #pragma unroll
    for(int ks=0;ks<4;++ks){
      asm volatile("ds_read_b64_tr_b16 %0,%1 offset:%c2":"=&v"(lo[ks]):"v"(vb),"i"(d0*4096+ks*1024):"memory");
      asm volatile("ds_read_b64_tr_b16 %0,%1 offset:%c2":"=&v"(hi[ks]):"v"(vb),"i"(d0*4096+ks*1024+512):"memory");}
    asm volatile("s_waitcnt lgkmcnt(0)":::"memory");SBAR();
    #define PK(k) (bf16x8){lo[k][0],lo[k][1],lo[k][2],lo[k][3],hi[k][0],hi[k][1],hi[k][2],hi[k][3]}
    o[d0]=__builtin_amdgcn_mfma_f32_32x32x16_bf16(pa0,PK(0),o[d0],0,0,0);
    o[d0]=__builtin_amdgcn_mfma_f32_32x32x16_bf16(pa1,PK(1),o[d0],0,0,0);
    o[d0]=__builtin_amdgcn_mfma_f32_32x32x16_bf16(pa2,PK(2),o[d0],0,0,0);
    o[d0]=__builtin_amdgcn_mfma_f32_32x32x16_bf16(pa3,PK(3),o[d0],0,0,0);
    #undef PK
  }
}

#ifndef ATTN_STORE16
#define ATTN_STORE16(p,v) (*(u32x4*)(p)=(v))
#endif
template<int THRL> __device__ __forceinline__ void attn_unit(int b,int qb,const bf16*Q,const bf16*__restrict__ K,const bf16*__restrict__ V,bf16*O,char*shm){
  int tid_=threadIdx.x; asm volatile("":"+v"(tid_));
  const int tid=tid_,lane=tid&63,r32=lane&31,hi=lane>>5; const int wid=__builtin_amdgcn_readfirstlane(tid>>6);
  const long rowbase=(long)b*SEQ; const int q0=qb*QB;
  const bf16*Qw=Q+(rowbase+q0+wid*QBLK)*DM;
  const bf16*Kh=K+rowbase*DM,*Vh=V+rowbase*DM;
  const unsigned lds0=(unsigned)(uintptr_t)shm;
  float*wsf=(float*)(shm+LDS_WS)+wid*64;
  const bf16*ksrc=Kh+(long)lane*DM+wid*8;
  const bf16*vsrc=Vh+(long)(16*(wid&3)+(lane>>2))*DM+(wid>>2)*32+(lane&3)*8;
  const unsigned kdst=lds0+LDS_K+wid*1024, vdst=lds0+LDS_V+wid*1024;
  #define DMA_K(t,slot) glds16(ksrc+(long)(t)*KVBLK*DM,(unsigned)__builtin_amdgcn_readfirstlane(kdst+(slot)))
  #define DMA_V(t,slot) glds16(vsrc+(long)(t)*KVBLK*DM,(unsigned)__builtin_amdgcn_readfirstlane(vdst+(slot)))
  const int vb0=(int)(lds0+LDS_V)+((lane>>4)&1)*32+(lane&3)*8+(4*hi+((lane&15)>>2))*64;
  const char*Kbase=shm+LDS_K; bf16x8 kf[8];
  const lds_cptr shm3=(lds_cptr)shm; const lds_cptr kp0=shm3+LDS_K+hi*1024+r32*16; const lds_cptr vp0=shm3+LDS_V+((lane>>4)&1)*32+(lane&3)*8+(4*hi+((lane&15)>>2))*64;
  const int NT=(q0+QB)/KVBLK;
  DMA_K(0,0);DMA_V(0,0);DMA_K(1,SLOTB);
  bf16x8 qr[4];
  #pragma unroll
  for(int d0=0;d0<4;++d0)qr[d0]=*reinterpret_cast<const bf16x8*>(&Qw[(long)r32*DM+d0*16+hi*8]);
  float zz_=0.f; asm volatile("":"+v"(zz_)); const f32x16 zv_={zz_,zz_,zz_,zz_,zz_,zz_,zz_,zz_,zz_,zz_,zz_,zz_,zz_,zz_,zz_,zz_};
  float mhat=zz_,l_reg=zz_;f32x16 o[2];o[0]=zv_;o[1]=zv_;f32x16 negm=zv_;asm volatile("":"+v"(negm));
  const int qrel=wid*QBLK+r32;
  #define CMASK(P0,P1,t) do{int jb_=(t)-(NT-4); if(jb_>=0)cmask(P0,P1,jb_,qrel,hi);}while(0)
  bool resc=false;
  #define START(P0,P1) do{ const float rm=rowmax(P0,P1); resc=false; \
    { const float dl=rm; mhat=fadd_s(mhat,dl); \
      _Pragma("unroll") for(int r=0;r<16;++r){P0[r]=fsub_s(P0[r],dl);P1[r]=fsub_s(P1[r],dl);} \
      _Pragma("unroll") for(int r=0;r<16;++r)negm[r]=-mhat; asm volatile("":"+v"(negm)); } \
    _Pragma("unroll") for(int r=0;r<16;++r)P0[r]=__builtin_amdgcn_exp2f(P0[r]); }while(0)
  #define RESC() do{ if(resc){ asm volatile("s_waitcnt lgkmcnt(0)":::"memory"); \
      _Pragma("unroll") for(int d_=0;d_<2;++d_) _Pragma("unroll") for(int r=0;r<16;++r)o[d_][r]*=wsf[crow(r,hi)]; } }while(0)
  f32x16 pA0,pA1,pB0,pB1;
  int sl_prev=0,sl_cur=0,sl_next=SLOTB;
  #define ROT() do{sl_prev=sl_cur;sl_cur=sl_next;sl_next=(sl_next==(NSLOT-1)*SLOTB)?0:sl_next+SLOTB;}while(0)
  DMA_K(2,2*SLOTB);
  WAIT_BAR(3);
  qkt(pA0,pA1,Kbase,qr,negm,r32,hi);asm volatile("s_nop 15\n\ts_nop 7":"+v"(pA0),"+v"(pA1));CMASK(pA0,pA1,0);
  START(pA0,pA1);
  _Pragma("unroll") for(int r=0;r<16;++r)pA1[r]=__builtin_amdgcn_exp2f(pA1[r]);
  WAIT_BAR(0);
  DMA_K(3,0);DMA_V(1,SLOTB);
  ROT();
  kload8(kf,kp0+sl_cur);
  WAIT_BAR(2);
  s16x4 vlo[8],vhi[8]; u32x4 pw0,pw1,pw2,pw3;
  #define PKW(P,B) cvtpk_s(P[B],P[B+1])
  #define PAF(k) __builtin_bit_cast(bf16x8,pw##k)
  #define VFR(i) (bf16x8){vlo[i][0],vlo[i][1],vlo[i][2],vlo[i][3],vhi[i][0],vhi[i][1],vhi[i][2],vhi[i][3]}
  #define PIN(x) asm volatile("":"+v"(x))
  #define MX3(a,b,c) __builtin_fmaxf(__builtin_fmaxf((a),(b)),(c))
  #define GAPA(MF,A0,A1,A2,A3,W0,W1,PW) do{ MF; sacc+=A0; sacc+=A1; sacc+=A2; sacc+=A3; PIN(sacc); W0; W1; PIN(PW); SBAR(); }while(0)
  #define EX(v) __builtin_amdgcn_exp2f(v)
  #define GAPB(MF,X,B) do{ MF; X[B]=EX(X[B]); X[B+1]=EX(X[B+1]); X[B+2]=EX(X[B+2]); X[B+3]=EX(X[B+3]); PIN(X); SBAR(); }while(0)
  #define VRD(i) do{ vlo[i]=vtr(vp_+(((i)>>2)*4096+((i)&3)*1024)); vhi[i]=vtr(vp_+(((i)>>2)*4096+((i)&3)*1024+512)); }while(0)
  #define KRD(G,j) do{ if(G){ kload2(kf,kp0+sl_next,j); SBAR(); } }while(0)
  #define STEP(C0,C1,P0,P1,t,GK,GV,GL) do{ SBAR(); \
    const lds_cptr vp_=vp0+sl_prev; \
    VRD(0); SBAR(); float sacc=(P0[0]+P0[1]); \
    GAPA(C0=__builtin_amdgcn_mfma_f32_32x32x16_bf16(kf[0],qr[0],negm,0,0,0), P0[2],P0[3],P0[4],P0[5],     pw0[0]=PKW(P0,0), pw0[1]=PKW(P0,2), pw0); \
    VRD(4); SBAR(); GAPA(C1=__builtin_amdgcn_mfma_f32_32x32x16_bf16(kf[1],qr[0],negm,0,0,0), P0[6],P0[7],P0[8],P0[9],     pw0[2]=PKW(P0,4), pw0[3]=PKW(P0,6), pw0); \
    VRD(1); SBAR(); GAPA(C0=__builtin_amdgcn_mfma_f32_32x32x16_bf16(kf[2],qr[1],C0,0,0,0),   P0[10],P0[11],P0[12],P0[13], pw1[0]=PKW(P0,8), pw1[1]=PKW(P0,10), pw1); \
    VRD(5); SBAR(); GAPA(C1=__builtin_amdgcn_mfma_f32_32x32x16_bf16(kf[3],qr[1],C1,0,0,0),   P0[14],P0[15],P1[0],P1[1],   pw1[2]=PKW(P0,12),pw1[3]=PKW(P0,14), pw1); \
    VRD(2); SBAR(); GAPA(C0=__builtin_amdgcn_mfma_f32_32x32x16_bf16(kf[4],qr[2],C0,0,0,0),   P1[2],P1[3],P1[4],P1[5],     pw2[0]=PKW(P1,0), pw2[1]=PKW(P1,2), pw2); \
    VRD(6); SBAR(); GAPA(C1=__builtin_amdgcn_mfma_f32_32x32x16_bf16(kf[5],qr[2],C1,0,0,0),   P1[6],P1[7],P1[8],P1[9],     pw2[2]=PKW(P1,4), pw2[3]=PKW(P1,6), pw2); \
    VRD(3); SBAR(); GAPA(C0=__builtin_amdgcn_mfma_f32_32x32x16_bf16(kf[6],qr[3],C0,0,0,0),   P1[10],P1[11],P1[12],P1[13], pw3[0]=PKW(P1,8), pw3[1]=PKW(P1,10), pw3); \
    VRD(7); SBAR(); GAPA(C1=__builtin_amdgcn_mfma_f32_32x32x16_bf16(kf[7],qr[3],C1,0,0,0),   P1[14],P1[15],0.f,0.f,       pw3[2]=PKW(P1,12),pw3[3]=PKW(P1,14), pw3); \
    l_reg+=sacc; \
    if(GK){DMA_K((t)+3,sl_cur);} if(GV){DMA_V((t)+1,sl_next);} \
    CMASK(C0,C1,t); \
    { float a=MX3(C0[0],C0[1],C1[0]),b=MX3(C0[2],C0[3],C1[1]); a=MX3(a,C1[2],C1[3]); \
      _Pragma("unroll") for(int r=4;r<16;r+=4){a=MX3(a,C0[r],C0[r+1]);b=MX3(b,C0[r+2],C0[r+3]);a=MX3(a,C1[r],C1[r+1]);b=MX3(b,C1[r+2],C1[r+3]);} \
      float rm=__builtin_fmaxf(a,b); { auto rr=__builtin_amdgcn_permlane32_swap(__float_as_uint(rm),__float_as_uint(rm),false,false); rm=__builtin_fmaxf(__uint_as_float(rr[0]),__uint_as_float(rr[1])); } \
      resc=false; \
      if(__builtin_expect(__any(rm>(float)THRL),0)){ const float dl=__builtin_fmaxf(rm,0.f); mhat+=dl; \
        _Pragma("unroll") for(int r=0;r<16;++r){C0[r]-=dl;C1[r]-=dl;} \
        _Pragma("unroll") for(int r=0;r<16;++r)negm[r]=-mhat; asm volatile("":"+v"(negm)); \
        const float f=__builtin_amdgcn_exp2f(-dl); l_reg*=f; if(hi==0)wsf[r32]=f; resc=true; } } \
    SBAR(); \
    GAPB(o[0]=__builtin_amdgcn_mfma_f32_32x32x16_bf16(PAF(0),VFR(0),o[0],0,0,0), C0,0); \
    GAPB(o[1]=__builtin_amdgcn_mfma_f32_32x32x16_bf16(PAF(0),VFR(4),o[1],0,0,0), C0,4); \
    KRD(GL,0); GAPB(o[0]=__builtin_amdgcn_mfma_f32_32x32x16_bf16(PAF(1),VFR(1),o[0],0,0,0), C0,8); \
    KRD(GL,1); GAPB(o[1]=__builtin_amdgcn_mfma_f32_32x32x16_bf16(PAF(1),VFR(5),o[1],0,0,0), C0,12); \
    KRD(GL,2); GAPB(o[0]=__builtin_amdgcn_mfma_f32_32x32x16_bf16(PAF(2),VFR(2),o[0],0,0,0), C1,0); \
    KRD(GL,3); GAPB(o[1]=__builtin_amdgcn_mfma_f32_32x32x16_bf16(PAF(2),VFR(6),o[1],0,0,0), C1,4); \
    GAPB(o[0]=__builtin_amdgcn_mfma_f32_32x32x16_bf16(PAF(3),VFR(3),o[0],0,0,0), C1,8); \
    GAPB(o[1]=__builtin_amdgcn_mfma_f32_32x32x16_bf16(PAF(3),VFR(7),o[1],0,0,0), C1,12); \
    }while(0)
  int t=1;
  #undef CMASK
  #define CMASK(P0,P1,t) do{}while(0)
  for(;t+5<NT;t+=2){
    STEP(pB0,pB1,pA0,pA1,t,true,true,true);     WAIT_BAR(2); RESC(); ROT();
    STEP(pA0,pA1,pB0,pB1,t+1,true,true,true);   WAIT_BAR(2); RESC(); ROT();
  }
  #undef CMASK
  #define CMASK(P0,P1,t) do{int jb_=(t)-(NT-4); if(jb_>=0)cmask(P0,P1,jb_,qrel,hi);}while(0)
  #define ENDW(tt) do{ if((tt)+3<NT){WAIT_BAR(2);} else if((tt)+2<NT){WAIT_BAR(1);} else {WAIT_BAR(0);} }while(0)
  for(;t+1<NT;t+=2){
    STEP(pB0,pB1,pA0,pA1,t,(t+3<NT),(t+1<NT),(t+1<NT));       ENDW(t);   RESC(); ROT();
    STEP(pA0,pA1,pB0,pB1,t+1,(t+4<NT),(t+2<NT),(t+2<NT));     ENDW(t+1); RESC(); ROT();
  }
  STEP(pB0,pB1,pA0,pA1,NT-1,false,false,false); RESC();
  { float sacc=pB0[0]+pB0[1]; _Pragma("unroll") for(int r=2;r<16;++r)sacc+=pB0[r]; _Pragma("unroll") for(int r=0;r<16;++r)sacc+=pB1[r]; l_reg+=sacc;
    pw0=(u32x4){PKW(pB0,0),PKW(pB0,2),PKW(pB0,4),PKW(pB0,6)};pw1=(u32x4){PKW(pB0,8),PKW(pB0,10),PKW(pB0,12),PKW(pB0,14)};pw2=(u32x4){PKW(pB1,0),PKW(pB1,2),PKW(pB1,4),PKW(pB1,6)};pw3=(u32x4){PKW(pB1,8),PKW(pB1,10),PKW(pB1,12),PKW(pB1,14)};
    SBAR(); pv(o,vb0+sl_cur,PAF(0),PAF(1),PAF(2),PAF(3)); }
  #undef PKW
  #undef PAF
  #undef VFR
  #undef PIN
  #undef MX3
  #undef GAPA
  #undef GAPB
  #undef EX
  #undef VRD
  #undef KRD
  #undef STEP
  #undef ENDW
  {auto rr=__builtin_amdgcn_permlane32_swap(__float_as_uint(l_reg),__float_as_uint(l_reg),false,false);l_reg=__uint_as_float(rr[0])+__uint_as_float(rr[1]);}
  if(hi==0)wsf[32+r32]=l_reg;asm volatile("s_waitcnt lgkmcnt(0)":::"memory");
  float rli[16];
  #pragma unroll
  for(int r=0;r<16;++r)rli[r]=__builtin_amdgcn_rcpf(wsf[32+crow(r,hi)]);
  bf16*Ow=O+(rowbase+q0+wid*QBLK)*DM;
  { bf16*stg=(bf16*)(shm+LDS_OST)+wid*2048;
    #pragma unroll
    for(int r=0;r<16;++r){const int orow=crow(r,hi);
      #pragma unroll
      for(int d0=0;d0<2;++d0)stg[orow*64+d0*32+r32]=__float2bfloat16(o[d0][r]*rli[r]);}
    asm volatile("s_waitcnt lgkmcnt(0)":::"memory");
    #pragma unroll
    for(int i=0;i<4;++i){const int row=i*8+(lane>>3),ch=lane&7; const u32x4 v=*(const u32x4*)(stg+row*64+ch*8); ATTN_STORE16(Ow+(long)row*DM+ch*8,v);} }
  asm volatile("s_waitcnt lgkmcnt(0)\n\ts_barrier":::"memory");
  #undef DMA_K
  #undef DMA_V
  #undef CMASK
  #undef START
  #undef RESC
  #undef ROT
}
__device__ __forceinline__ void pv4(f32x16*o,int vb,bf16x8 pa0,bf16x8 pa1,bf16x8 pa2,bf16x8 pa3){
  #pragma unroll
  for(int d0=0;d0<4;++d0){s16x4 lo[4],hi[4];
    #pragma unroll
    for(int ks=0;ks<4;++ks){
      asm volatile("ds_read_b64_tr_b16 %0,%1 offset:%c2":"=&v"(lo[ks]):"v"(vb),"i"(d0*4096+ks*1024):"memory");
      asm volatile("ds_read_b64_tr_b16 %0,%1 offset:%c2":"=&v"(hi[ks]):"v"(vb),"i"(d0*4096+ks*1024+512):"memory");}
    asm volatile("s_waitcnt lgkmcnt(0)":::"memory");SBAR();
    #define PK(k) (bf16x8){lo[k][0],lo[k][1],lo[k][2],lo[k][3],hi[k][0],hi[k][1],hi[k][2],hi[k][3]}
    o[d0]=__builtin_amdgcn_mfma_f32_32x32x16_bf16(pa0,PK(0),o[d0],0,0,0);
    o[d0]=__builtin_amdgcn_mfma_f32_32x32x16_bf16(pa1,PK(1),o[d0],0,0,0);
    o[d0]=__builtin_amdgcn_mfma_f32_32x32x16_bf16(pa2,PK(2),o[d0],0,0,0);
    o[d0]=__builtin_amdgcn_mfma_f32_32x32x16_bf16(pa3,PK(3),o[d0],0,0,0);
    #undef PK
  }
}

template<int THRL,bool FUSE> __device__ __forceinline__ void attn_unit128(int b,int qb,const bf16*Q,const bf16*__restrict__ K,const bf16*__restrict__ V,bf16*O,char*shm,bf16*ON=nullptr,const float*subg=nullptr,float lam=0.f,float oscale=1.f,float eps=0.f){
  int tid_=threadIdx.x; asm volatile("":"+v"(tid_));
  const int tid=tid_,lane=tid&63,r32=lane&31,hi=lane>>5; const int wid=__builtin_amdgcn_readfirstlane(tid>>6);
  const long rowbase=(long)b*SEQ; const int q0=qb*QB;
  const bf16*Qw=Q+(rowbase+q0+wid*QBLK)*DM;
  const bf16*Kh=K+rowbase*DM,*Vh=V+rowbase*DM;
  const unsigned lds0=(unsigned)(uintptr_t)shm;
  constexpr int LDS_V2=NSLOT*SLOTB, VSLOT=2*SLOTB, LDS_WS2=LDS_V2+NSLOT*VSLOT, LDS_OST2=LDS_WS2+NW*64*4;
  float*wsf=(float*)(shm+LDS_WS2)+wid*64;
  const bf16*ksrc=Kh+(long)lane*DM+wid*8;
  const bf16*vsrc=Vh+(long)(16*(wid&3)+(lane>>2))*DM+(wid>>2)*32+(lane&3)*8;
  const unsigned kdst=lds0+LDS_K+wid*1024, vdst=lds0+LDS_V2+wid*1024;
  #define DMA_K(t,slot) glds16(ksrc+(long)(t)*KVBLK*DM,(unsigned)__builtin_amdgcn_readfirstlane(kdst+(slot)))
  #define DMA_V(t,slot) do{ glds16(vsrc+(long)(t)*KVBLK*DM,(unsigned)__builtin_amdgcn_readfirstlane(vdst+2*(slot))); glds16(vsrc+(long)(t)*KVBLK*DM+64,(unsigned)__builtin_amdgcn_readfirstlane(vdst+2*(slot)+8192)); }while(0)
  const int vb0=(int)(lds0+LDS_V2)+((lane>>4)&1)*32+(lane&3)*8+(4*hi+((lane&15)>>2))*64;
  const char*Kbase=shm+LDS_K; bf16x8 kf[8];
  const lds_cptr shm3=(lds_cptr)shm; const lds_cptr kp0=shm3+LDS_K+hi*1024+r32*16; const lds_cptr vp0=shm3+LDS_V2+((lane>>4)&1)*32+(lane&3)*8+(4*hi+((lane&15)>>2))*64;
  const int NT=(q0+QB)/KVBLK;
  DMA_K(0,0);DMA_V(0,0);DMA_K(1,SLOTB);
  bf16x8 qr[4];
  #pragma unroll
  for(int d0=0;d0<4;++d0)qr[d0]=*reinterpret_cast<const bf16x8*>(&Qw[(long)r32*DM+d0*16+hi*8]);
  float zz_=0.f; asm volatile("":"+v"(zz_)); const f32x16 zv_={zz_,zz_,zz_,zz_,zz_,zz_,zz_,zz_,zz_,zz_,zz_,zz_,zz_,zz_,zz_,zz_};
  float mhat=zz_,l_reg=zz_;f32x16 o[4];o[0]=zv_;o[1]=zv_;o[2]=zv_;o[3]=zv_;f32x16 negm=zv_;asm volatile("":"+v"(negm));
  const int qrel=wid*QBLK+r32;
  #define CMASK(P0,P1,t) do{int jb_=(t)-(NT-4); if(jb_>=0)cmask(P0,P1,jb_,qrel,hi);}while(0)
  bool resc=false;
  #define START(P0,P1) do{ const float rm=rowmax(P0,P1); resc=false; \
    { const float dl=rm; mhat=fadd_s(mhat,dl); \
      _Pragma("unroll") for(int r=0;r<16;++r){P0[r]=fsub_s(P0[r],dl);P1[r]=fsub_s(P1[r],dl);} \
      _Pragma("unroll") for(int r=0;r<16;++r)negm[r]=-mhat; asm volatile("":"+v"(negm)); } \
    _Pragma("unroll") for(int r=0;r<16;++r)P0[r]=__builtin_amdgcn_exp2f(P0[r]); }while(0)
  #define RESC() do{ if(resc){ asm volatile("s_waitcnt lgkmcnt(0)":::"memory"); \
      _Pragma("unroll") for(int d_=0;d_<4;++d_) _Pragma("unroll") for(int r=0;r<16;++r)o[d_][r]*=wsf[crow(r,hi)]; } }while(0)
  f32x16 pA0,pA1,pB0,pB1;
  int sl_prev=0,sl_cur=0,sl_next=SLOTB;
  #define ROT() do{sl_prev=sl_cur;sl_cur=sl_next;sl_next=(sl_next==(NSLOT-1)*SLOTB)?0:sl_next+SLOTB;}while(0)
  DMA_K(2,2*SLOTB);
  WAIT_BAR(4);
  qkt(pA0,pA1,Kbase,qr,negm,r32,hi);asm volatile("s_nop 15\n\ts_nop 7":"+v"(pA0),"+v"(pA1));CMASK(pA0,pA1,0);
  START(pA0,pA1);
  _Pragma("unroll") for(int r=0;r<16;++r)pA1[r]=__builtin_amdgcn_exp2f(pA1[r]);
  WAIT_BAR(0);
  DMA_K(3,0);DMA_V(1,SLOTB);
  ROT();
  kload8(kf,kp0+sl_cur);
  WAIT_BAR(3);
  s16x4 vlo[8],vhi[8]; u32x4 pw0,pw1,pw2,pw3;
  #define PKW(P,B) cvtpk_s(P[B],P[B+1])
  #define PAF(k) __builtin_bit_cast(bf16x8,pw##k)
  #define VFR(s) (bf16x8){vlo[s][0],vlo[s][1],vlo[s][2],vlo[s][3],vhi[s][0],vhi[s][1],vhi[s][2],vhi[s][3]}
  #define PIN(x) asm volatile("":"+v"(x))
  #define MX3(a,b,c) __builtin_fmaxf(__builtin_fmaxf((a),(b)),(c))
  #define GAPA(MF,A0,A1,A2,A3,W0,W1,PW) do{ MF; sacc+=A0; sacc+=A1; sacc+=A2; sacc+=A3; PIN(sacc); W0; W1; PIN(PW); SBAR(); }while(0)
  #define EX(v) __builtin_amdgcn_exp2f(v)
  #define GAPB(MF,X,B) do{ MF; X[B]=EX(X[B]); X[B+1]=EX(X[B+1]); PIN(X); SBAR(); }while(0)
  #define VRD(s,f) do{ vlo[s]=vtr(vp_+(((f)>>2)*4096+((f)&3)*1024)); vhi[s]=vtr(vp_+(((f)>>2)*4096+((f)&3)*1024+512)); }while(0)
  #define KRD(G,j) do{ if(G){ kload2(kf,kp0+sl_next,j); SBAR(); } }while(0)
  #define STEP(C0,C1,P0,P1,t,GK,GV,GL) do{ SBAR(); \
    const lds_cptr vp_=vp0+2*sl_prev; \
    VRD(0,0); SBAR(); float sacc=(P0[0]+P0[1]); \
    GAPA(C0=__builtin_amdgcn_mfma_f32_32x32x16_bf16(kf[0],qr[0],negm,0,0,0), P0[2],P0[3],P0[4],P0[5],     pw0[0]=PKW(P0,0), pw0[1]=PKW(P0,2), pw0); \
    VRD(1,4); SBAR(); GAPA(C1=__builtin_amdgcn_mfma_f32_32x32x16_bf16(kf[1],qr[0],negm,0,0,0), P0[6],P0[7],P0[8],P0[9],     pw0[2]=PKW(P0,4), pw0[3]=PKW(P0,6), pw0); \
    VRD(2,8); SBAR(); GAPA(C0=__builtin_amdgcn_mfma_f32_32x32x16_bf16(kf[2],qr[1],C0,0,0,0),   P0[10],P0[11],P0[12],P0[13], pw1[0]=PKW(P0,8), pw1[1]=PKW(P0,10), pw1); \
    VRD(3,12); SBAR(); GAPA(C1=__builtin_amdgcn_mfma_f32_32x32x16_bf16(kf[3],qr[1],C1,0,0,0),   P0[14],P0[15],P1[0],P1[1],   pw1[2]=PKW(P0,12),pw1[3]=PKW(P0,14), pw1); \
    VRD(4,1); SBAR(); GAPA(C0=__builtin_amdgcn_mfma_f32_32x32x16_bf16(kf[4],qr[2],C0,0,0,0),   P1[2],P1[3],P1[4],P1[5],     pw2[0]=PKW(P1,0), pw2[1]=PKW(P1,2), pw2); \
    VRD(5,5); SBAR(); GAPA(C1=__builtin_amdgcn_mfma_f32_32x32x16_bf16(kf[5],qr[2],C1,0,0,0),   P1[6],P1[7],P1[8],P1[9],     pw2[2]=PKW(P1,4), pw2[3]=PKW(P1,6), pw2); \
    VRD(6,9); SBAR(); GAPA(C0=__builtin_amdgcn_mfma_f32_32x32x16_bf16(kf[6],qr[3],C0,0,0,0),   P1[10],P1[11],P1[12],P1[13], pw3[0]=PKW(P1,8), pw3[1]=PKW(P1,10), pw3); \
    VRD(7,13); SBAR(); GAPA(C1=__builtin_amdgcn_mfma_f32_32x32x16_bf16(kf[7],qr[3],C1,0,0,0),   P1[14],P1[15],0.f,0.f,       pw3[2]=PKW(P1,12),pw3[3]=PKW(P1,14), pw3); \
    l_reg+=sacc; \
    if(GK){DMA_K((t)+3,sl_cur);} if(GV){DMA_V((t)+1,sl_next);} \
    CMASK(C0,C1,t); \
    { float a=MX3(C0[0],C0[1],C1[0]),b=MX3(C0[2],C0[3],C1[1]); a=MX3(a,C1[2],C1[3]); \
      _Pragma("unroll") for(int r=4;r<16;r+=4){a=MX3(a,C0[r],C0[r+1]);b=MX3(b,C0[r+2],C0[r+3]);a=MX3(a,C1[r],C1[r+1]);b=MX3(b,C1[r+2],C1[r+3]);} \
      float rm=__builtin_fmaxf(a,b); { auto rr=__builtin_amdgcn_permlane32_swap(__float_as_uint(rm),__float_as_uint(rm),false,false); rm=__builtin_fmaxf(__uint_as_float(rr[0]),__uint_as_float(rr[1])); } \
      resc=false; \
      if(__builtin_expect(__any(rm>(float)THRL),0)){ const float dl=__builtin_fmaxf(rm,0.f); mhat+=dl; \
        _Pragma("unroll") for(int r=0;r<16;++r){C0[r]-=dl;C1[r]-=dl;} \
        _Pragma("unroll") for(int r=0;r<16;++r)negm[r]=-mhat; asm volatile("":"+v"(negm)); \
        const float f=__builtin_amdgcn_exp2f(-dl); l_reg*=f; if(hi==0)wsf[r32]=f; resc=true; } } \
    SBAR(); \
    GAPB(o[0]=__builtin_amdgcn_mfma_f32_32x32x16_bf16(PAF(0),VFR(0),o[0],0,0,0), C0,0); VRD(0,2); SBAR(); \
    GAPB(o[1]=__builtin_amdgcn_mfma_f32_32x32x16_bf16(PAF(0),VFR(1),o[1],0,0,0), C0,2); VRD(1,6); SBAR(); \
    GAPB(o[2]=__builtin_amdgcn_mfma_f32_32x32x16_bf16(PAF(0),VFR(2),o[2],0,0,0), C0,4); VRD(2,10); SBAR(); \
    GAPB(o[3]=__builtin_amdgcn_mfma_f32_32x32x16_bf16(PAF(0),VFR(3),o[3],0,0,0), C0,6); VRD(3,14); SBAR(); \
    GAPB(o[0]=__builtin_amdgcn_mfma_f32_32x32x16_bf16(PAF(1),VFR(4),o[0],0,0,0), C0,8); VRD(4,3); SBAR(); \
    GAPB(o[1]=__builtin_amdgcn_mfma_f32_32x32x16_bf16(PAF(1),VFR(5),o[1],0,0,0), C0,10); VRD(5,7); SBAR(); \
    GAPB(o[2]=__builtin_amdgcn_mfma_f32_32x32x16_bf16(PAF(1),VFR(6),o[2],0,0,0), C0,12); VRD(6,11); SBAR(); \
    GAPB(o[3]=__builtin_amdgcn_mfma_f32_32x32x16_bf16(PAF(1),VFR(7),o[3],0,0,0), C0,14); VRD(7,15); SBAR(); \
    KRD(GL,0); GAPB(o[0]=__builtin_amdgcn_mfma_f32_32x32x16_bf16(PAF(2),VFR(0),o[0],0,0,0), C1,0); \
    KRD(GL,1); GAPB(o[1]=__builtin_amdgcn_mfma_f32_32x32x16_bf16(PAF(2),VFR(1),o[1],0,0,0), C1,2); \
    KRD(GL,2); GAPB(o[2]=__builtin_amdgcn_mfma_f32_32x32x16_bf16(PAF(2),VFR(2),o[2],0,0,0), C1,4); \
    KRD(GL,3); GAPB(o[3]=__builtin_amdgcn_mfma_f32_32x32x16_bf16(PAF(2),VFR(3),o[3],0,0,0), C1,6); \
    GAPB(o[0]=__builtin_amdgcn_mfma_f32_32x32x16_bf16(PAF(3),VFR(4),o[0],0,0,0), C1,8); \
    GAPB(o[1]=__builtin_amdgcn_mfma_f32_32x32x16_bf16(PAF(3),VFR(5),o[1],0,0,0), C1,10); \
    GAPB(o[2]=__builtin_amdgcn_mfma_f32_32x32x16_bf16(PAF(3),VFR(6),o[2],0,0,0), C1,12); \
    GAPB(o[3]=__builtin_amdgcn_mfma_f32_32x32x16_bf16(PAF(3),VFR(7),o[3],0,0,0), C1,14); \
    }while(0)
  int t=1;
  #undef CMASK
  #define CMASK(P0,P1,t) do{}while(0)
  for(;t+5<NT;t+=2){
    STEP(pB0,pB1,pA0,pA1,t,true,true,true);     WAIT_BAR(3); RESC(); ROT();
    STEP(pA0,pA1,pB0,pB1,t+1,true,true,true);   WAIT_BAR(3); RESC(); ROT();
  }
  #undef CMASK
  #define CMASK(P0,P1,t) do{int jb_=(t)-(NT-4); if(jb_>=0)cmask(P0,P1,jb_,qrel,hi);}while(0)
  #define ENDW(tt) do{ if((tt)+3<NT){WAIT_BAR(3);} else if((tt)+2<NT){WAIT_BAR(2);} else {WAIT_BAR(0);} }while(0)
  for(;t+1<NT;t+=2){
    STEP(pB0,pB1,pA0,pA1,t,(t+3<NT),(t+1<NT),(t+1<NT));       ENDW(t);   RESC(); ROT();
    STEP(pA0,pA1,pB0,pB1,t+1,(t+4<NT),(t+2<NT),(t+2<NT));     ENDW(t+1); RESC(); ROT();
  }
  STEP(pB0,pB1,pA0,pA1,NT-1,false,false,false); RESC();
  { float sacc=pB0[0]+pB0[1]; _Pragma("unroll") for(int r=2;r<16;++r)sacc+=pB0[r]; _Pragma("unroll") for(int r=0;r<16;++r)sacc+=pB1[r]; l_reg+=sacc;
    pw0=(u32x4){PKW(pB0,0),PKW(pB0,2),PKW(pB0,4),PKW(pB0,6)};pw1=(u32x4){PKW(pB0,8),PKW(pB0,10),PKW(pB0,12),PKW(pB0,14)};pw2=(u32x4){PKW(pB1,0),PKW(pB1,2),PKW(pB1,4),PKW(pB1,6)};pw3=(u32x4){PKW(pB1,8),PKW(pB1,10),PKW(pB1,12),PKW(pB1,14)};
    SBAR(); pv4(o,vb0+2*sl_cur,PAF(0),PAF(1),PAF(2),PAF(3)); }
  #undef PKW
  #undef PAF
  #undef VFR
  #undef PIN
  #undef MX3
  #undef GAPA
  #undef GAPB
  #undef EX
  #undef VRD
  #undef KRD
  #undef STEP
  #undef ENDW
  {auto rr=__builtin_amdgcn_permlane32_swap(__float_as_uint(l_reg),__float_as_uint(l_reg),false,false);l_reg=__uint_as_float(rr[0])+__uint_as_float(rr[1]);}
  if(hi==0)wsf[32+r32]=l_reg;asm volatile("s_waitcnt lgkmcnt(0)":::"memory");
  float rli[16];
  #pragma unroll
  for(int r=0;r<16;++r)rli[r]=__builtin_amdgcn_rcpf(wsf[32+crow(r,hi)]);
  bf16*Ow=O+(rowbase+q0+wid*QBLK)*DM;
  { bf16*stg=(bf16*)(shm+LDS_OST2)+wid*2048;
    float dv[2][4][8]; float ssq[4]={0.f,0.f,0.f,0.f};
    #pragma unroll
    for(int hf=0;hf<2;++hf){
      #pragma unroll
      for(int r=0;r<16;++r){const int orow=crow(r,hi);
        #pragma unroll
        for(int d0=0;d0<2;++d0)stg[orow*64+d0*32+r32]=__float2bfloat16(o[2*hf+d0][r]*rli[r]);}
      asm volatile("s_waitcnt lgkmcnt(0)":::"memory");
      #pragma unroll
      for(int i=0;i<4;++i){const int row=i*8+(lane>>3),ch=lane&7; const u32x4 v=*(const u32x4*)(stg+row*64+ch*8);
        if constexpr(!FUSE){ ATTN_STORE16(Ow+(long)row*DM+hf*64+ch*8,v); }
        else{ const u32x4 v0=*(const u32x4*)(Ow+(long)row*DM+hf*64+ch*8);
          #pragma unroll
          for(int e=0;e<4;++e){ const float a0=__uint_as_float(v0[e]<<16),a1=__uint_as_float(v0[e]&0xffff0000u),b0=__uint_as_float(v[e]<<16),b1=__uint_as_float(v[e]&0xffff0000u);
            const float d0_=a0-lam*b0,d1_=a1-lam*b1; dv[hf][i][2*e]=d0_; dv[hf][i][2*e+1]=d1_; ssq[i]+=d0_*d0_+d1_*d1_; } } }
      asm volatile("s_waitcnt lgkmcnt(0)":::"memory"); }
    if constexpr(FUSE){
      bf16*Nw=ON+(rowbase+q0+wid*QBLK)*DM;
      #pragma unroll
      for(int i=0;i<4;++i){ float s_=ssq[i]; s_+=__shfl_xor(s_,1); s_+=__shfl_xor(s_,2); s_+=__shfl_xor(s_,4); ssq[i]=__builtin_amdgcn_rsqf(s_*(1.f/128.f)+eps)*oscale; }
      #pragma unroll
      for(int hf=0;hf<2;++hf){ const int ch=lane&7; float g_[8];
        #pragma unroll
        for(int e=0;e<8;++e)g_[e]=subg[hf*64+ch*8+e];
        #pragma unroll
        for(int i=0;i<4;++i){const int row=i*8+(lane>>3); u32x4 w;
          #pragma unroll
          for(int e=0;e<4;++e)w[e]=cvtpk_s(dv[hf][i][2*e]*ssq[i]*g_[2*e],dv[hf][i][2*e+1]*ssq[i]*g_[2*e+1]);
          *(u32x4*)(Nw+(long)row*DM+hf*64+ch*8)=w; } } } }
  asm volatile("s_waitcnt lgkmcnt(0)\n\ts_barrier":::"memory");
  #undef DMA_K
  #undef DMA_V
  #undef CMASK
  #undef START
  #undef RESC
  #undef ROT
}
constexpr int ATTN_LDS_BYTES=LDS_BYTES, ATTN128_LDS_BYTES=NSLOT*SLOTB+NSLOT*2*SLOTB+NW*64*4+NW*4096;
#undef SBAR
#undef WAIT_BAR
}
#define GAS __attribute__((address_space(1)))
#define LAS __attribute__((address_space(3)))
typedef unsigned short bf16;
typedef unsigned v4u __attribute__((ext_vector_type(4)));
typedef float f32x4 __attribute__((ext_vector_type(4)));
typedef short bf16x8 __attribute__((ext_vector_type(8)));
typedef GAS unsigned gu32;
typedef GAS unsigned long long gu64;
#define RLX_AGENT __ATOMIC_RELAXED, __HIP_MEMORY_SCOPE_AGENT
#define LDS_WAIT() asm volatile("s_waitcnt lgkmcnt(0)" ::: "memory")
#define VM_WAIT() asm volatile("s_waitcnt vmcnt(0)" ::: "memory")
__device__ __forceinline__ unsigned long long rt() { return __builtin_amdgcn_s_memrealtime(); }
__device__ __forceinline__ unsigned f2bf(float f) { unsigned u = __builtin_bit_cast(unsigned, f); return (u + 0x7fffu + ((u >> 16) & 1u)) >> 16; }
__device__ __forceinline__ unsigned pk2(float lo, float hi) { return f2bf(lo) | (f2bf(hi) << 16); }

#define XB_TMO      128
#define XB_XCNT(j)  (256  + 64 * (j))
#define XB_XSUB(j)  (1280 + 64 * (j))
#define XB_XGEN(j)  (2304 + 64 * (j))
#define XB_TOP      3328
#define XB_TOPGEN   3392
#define XCD_BAR_WORDS 3456
#define XB_SPIN_CAP (1u << 18)

__device__ __forceinline__ unsigned xb_ld(unsigned* p)              { return __hip_atomic_load(p, __ATOMIC_RELAXED, __HIP_MEMORY_SCOPE_AGENT); }
__device__ __forceinline__ unsigned xb_add(unsigned* p, unsigned v) { return __hip_atomic_fetch_add(p, v, __ATOMIC_RELAXED, __HIP_MEMORY_SCOPE_AGENT); }
__device__ __forceinline__ unsigned xb_xcc_id() { return (unsigned)__builtin_amdgcn_s_getreg((3 << 11) | 20) & 0xFu; }
#define XB_SPIN(cond, bar) do { unsigned _sp = 0; while (cond) { __builtin_amdgcn_s_sleep(1); \
    if ((++_sp & 255u) == 0u) { if (xb_ld(&(bar)[XB_TMO])) break; if (_sp > XB_SPIN_CAP) { atomicAdd(&(bar)[XB_TMO], 1u); break; } } } } while (0)

struct XcdBarrier {
    unsigned* bar; unsigned x;
    volatile LAS unsigned* st;
};

__device__ __forceinline__ XcdBarrier xcd_barrier_post(unsigned* bar, volatile LAS unsigned* st) {
    XcdBarrier b; b.bar = bar; b.x = xb_xcc_id(); b.st = st;
    if (threadIdx.x == 0) (void)xb_add(&bar[XB_XCNT(b.x)], 1u);
    return b;
}
__device__ __forceinline__ void xcd_barrier_complete(unsigned* bar, unsigned x, unsigned& nloc, unsigned& nx) {
    const unsigned G = gridDim.x * gridDim.y * gridDim.z;
    unsigned sum, cnt, mine, sp = 0u;
    for (;;) {
        sum = 0u; cnt = 0u; mine = 0u;
#pragma unroll
        for (unsigned j = 0; j < 16; ++j) { const unsigned c = xb_ld(&bar[XB_XCNT(j)]); sum += c; cnt += (c > 0u) ? 1u : 0u; mine = (j == x) ? c : mine; }
        if (sum == G) break;
        __builtin_amdgcn_s_sleep(1);
        if ((++sp & 255u) == 0u) { if (xb_ld(&bar[XB_TMO])) break; if (sp > XB_SPIN_CAP) { atomicAdd(&bar[XB_TMO], 1u); break; } }
    }
    nloc = mine > 0u ? mine : 1u; nx = cnt > 0u ? cnt : 1u;
}

__device__ __forceinline__ void xcd_barrier(const XcdBarrier& b) {
    asm volatile("s_waitcnt vmcnt(0)" ::: "memory");
    __syncthreads();
    if (threadIdx.x == 0) {
        unsigned* bar = b.bar;
        __builtin_amdgcn_s_waitcnt(0);
        unsigned nloc = b.st[0], nx = b.st[1];
        if (nloc == 0u) { xcd_barrier_complete(bar, b.x, nloc, nx); b.st[0] = nloc; b.st[1] = nx; }
        const unsigned old = xb_add(&bar[XB_XSUB(b.x)], 1u);
        const unsigned gen = old / nloc;
        if (old + 1u == (gen + 1u) * nloc) {
            __builtin_amdgcn_fence(__ATOMIC_RELEASE, "agent");
            asm volatile("s_waitcnt vmcnt(0)" ::: "memory");
            const unsigned og = xb_add(&bar[XB_TOP], 1u);
            const unsigned tg = og / nx;
            if (og + 1u == (tg + 1u) * nx) xb_add(&bar[XB_TOPGEN], 1u);
            else XB_SPIN(xb_ld(&bar[XB_TOPGEN]) == tg, bar);
            __builtin_amdgcn_fence(__ATOMIC_ACQUIRE, "agent");
            xb_add(&bar[XB_XGEN(b.x)], 1u);
            asm volatile("s_waitcnt vmcnt(0)" ::: "memory");
        } else {
            XB_SPIN(xb_ld(&bar[XB_XGEN(b.x)]) == gen, bar);
            __builtin_amdgcn_fence(__ATOMIC_ACQUIRE, "agent");
            asm volatile("s_waitcnt vmcnt(0)" ::: "memory");
        }
    }
    __syncthreads();
}
constexpr int NWAVES = 8;
constexpr int D = 1024, NB = 8, S = 2048, M = NB * S, PLE = 256, QKVW = 3072, DFF = 2816, NE = 8, DFE = 3584;
constexpr float EPS = 1e-6f, LAM_INIT0 = 0.2f;
constexpr int N_PHASES = 17;
#ifndef WGM_P1
#define WGM_P1 2
#endif
#ifndef WGM_P5
#define WGM_P5 2
#endif
#ifndef WGM_P11
#define WGM_P11 2
#endif
#ifndef WGM_1U
#define WGM_1U 8
#endif
#ifndef MK_N_LAUNCHES
#define MK_N_LAUNCHES 1
#endif
#ifndef MEGA_END
#define MEGA_END N_PHASES
#endif

constexpr size_t MiB = 1u << 20;
constexpr size_t WS_CTL = 0, CTL_ZERO_BYTES = 1 * MiB;
constexpr size_t WS_COS = 1 * MiB, WS_SIN = WS_COS + 256 * 1024, WS_TOKSLOT = WS_COS + 512 * 1024, WS_QKN = WS_TOKSLOT + 256 * 1024, WS_RSTL = 7 * MiB + 512 * 1024  , WS_RSTD1 = WS_QKN + 64 * 1024, WS_RSTD2 = WS_RSTD1 + 64 * 1024;
constexpr size_t WS_LISTS = 2 * MiB, WS_GWL = WS_LISTS + 512 * 1024;
constexpr size_t WS_WPOOL = 4 * MiB, WS_WPG1 = 5 * MiB, WS_WPP1 = 7 * MiB;
constexpr size_t WS_WGU = 8 * MiB, WS_WD = 120 * MiB;
constexpr size_t WS_YS = 8 * MiB;
constexpr size_t WS_XN = 176 * MiB, WS_PROJ1 = 208 * MiB, WS_BIG = 240 * MiB;
constexpr size_t WS_WQKV = 240 * MiB, WS_WO = 246 * MiB, WS_WGU0 = 248 * MiB, WS_WD0 = 259 * MiB, WS_WPG0 = 265 * MiB, WS_WPP0 = 267 * MiB;
constexpr size_t WS_Q = 268 * MiB, WS_K = 300 * MiB, WS_V = 332 * MiB, WS_O = 364 * MiB;
constexpr size_t WS_HFF = 268 * MiB, WS_PROJ0 = 364 * MiB, WS_PB = 428 * MiB;
constexpr size_t WS_HM = 240 * MiB;
constexpr size_t WS_XNB = 396 * MiB;
constexpr size_t WS_SSQA = 3 * MiB, WS_SSQB = 460 * MiB, WS_SSQC = 461 * MiB;
constexpr size_t WS_END = 466 * MiB;
static_assert(WS_WD0 + (size_t)D * DFF * 2 <= WS_WPG0 && WS_WGU0 + (size_t)2 * DFF * D * 2 <= WS_WD0 && WS_HFF + (size_t)M * DFF * 2 <= WS_PROJ0 && WS_HM + (size_t)(2 * M + 256) * DFE * 2 <= WS_END, "d_ws map");
constexpr int CW_TMO = 0, CW_CODE = 1, CW_BAR = 4096, CW_MOECNT = 65536, CW_STEAL = 98304;

constexpr int RING_OFF = 0, RING_BYTES = 131072, LDSCTL_OFF = RING_BYTES, MISC_OFF = LDSCTL_OFF + 320, LDS_BYTES = 147456;

struct Frame { LAS unsigned char* lds; volatile LAS unsigned* MISC; gu32* ctl; int tid, lane, wave, vcu, G; };

__device__ __forceinline__ float wave_sum(float v) {
#pragma unroll
    for (int o = 1; o < 64; o <<= 1) v += __shfl_xor(v, o);
    return v;
}
__device__ __forceinline__ unsigned cvtpk(float lo, float hi) { unsigned r; asm volatile("v_cvt_pk_bf16_f32 %0, %1, %2" : "=v"(r) : "v"(lo), "v"(hi)); return r; }
__device__ __forceinline__ float bflo(unsigned w) { return __uint_as_float(w << 16); }
__device__ __forceinline__ float bfhi(unsigned w) { return __uint_as_float(w & 0xffff0000u); }

__device__ __forceinline__ int map_row(int map, int n) {
    if (map == 1) return (n & ~255) + ((n >> 5) & 1) * 128 + ((n >> 6) & 3) * 32 + (n & 31);
    if (map == 2) return ((n >> 7) << 8) + (n & 127);
    if (map == 3) return ((n >> 7) << 8) + 128 + (n & 127);
    return n;
}
typedef float f32x2g __attribute__((ext_vector_type(2)));
__device__ __forceinline__ void tr_load(f32x4 (&v)[16], f32x2g (&g)[8], const float* W, int N, int k0, int n0, int lane, const float* gk) {
    const int ksub = lane >> 4, n4 = (lane & 15) * 4;
#pragma unroll
    for (int it = 0; it < 8; ++it)
#pragma unroll
        for (int h = 0; h < 2; ++h) v[2 * it + h] = __builtin_nontemporal_load((const GAS f32x4*)(W + (size_t)(k0 + it * 8 + 2 * ksub + h) * N + n0 + n4));
    const float* gp = gk ? gk : W;
#pragma unroll
    for (int it = 0; it < 8; ++it) g[it] = *(const GAS f32x2g*)(gp + k0 + it * 8 + 2 * ksub);
}
__device__ __forceinline__ void tr_store(const f32x4 (&v)[16], bf16* dst, int ldd, int map, int k0, int n0, LAS unsigned* tile, int lane, const f32x2g (&graw)[8], float sel) {
    const int ksub = lane >> 4, q = lane & 15;
    f32x2g g[8];
#pragma unroll
    for (int it = 0; it < 8; ++it) g[it] = graw[it] * sel + (1.f - sel);
#pragma unroll
    for (int it = 0; it < 8; ++it)
#pragma unroll
        for (int j = 0; j < 4; ++j) tile[(4 * q + j) * 32 + ((4 * it + ksub) ^ ((q & 7) * 4))] = cvtpk(v[2 * it][j] * g[it].x, v[2 * it + 1][j] * g[it].y);
    LDS_WAIT(); asm volatile("" ::: "memory");
    const int c = lane & 7;
#pragma unroll
    for (int j2 = 0; j2 < 8; ++j2) { const int n = (lane >> 3) + 8 * j2, fz = ((n >> 2) & 7) * 4; const v4u w = *(const LAS v4u*)(tile + n * 32 + ((4 * c) ^ fz));
        *(GAS v4u*)(dst + (size_t)map_row(map, n0 + n) * ldd + k0 + 8 * c) = w; }
    LDS_WAIT(); asm volatile("" ::: "memory");
}
struct TItem { const float* W; bf16* dst; const float* g; int K, N, map, kb, nb; };
enum { A_X = 0, A_P, A_NORM_MIX, A_NORM_FFN, A_NORM_PLE, A_WQKV, A_WO, A_QNORM, A_KNORM, A_LQ1, A_LK1, A_LQ2, A_LK2, A_SUBLN, A_POOLW, A_POOLB, A_POOLS, A_FFNG, A_FFNU, A_FFND, A_ROUTER, A_MOEG, A_MOEU, A_MOED, A_PLEP, A_PLEG };
__device__ __forceinline__ const float* arg_ptr(int i) {
    const __attribute__((address_space(4))) char* kp = (const __attribute__((address_space(4))) char*)__builtin_amdgcn_kernarg_segment_ptr();
    unsigned off = (unsigned)i * 8u; asm volatile("" : "+s"(off));
    return *(const float* const __attribute__((address_space(4)))*)(kp + off);
}
constexpr int TI_QKV = 768, TI_O = 256, TI_FF = 704, TI_PG = 256, TI_PP = 64, TI_POOL = 64, TI_MOE = 7168;
constexpr int TI_TOTAL = TI_QKV + TI_O + 3 * TI_FF + 2 * TI_PG + 2 * TI_PP + TI_POOL + 3 * TI_MOE;
__device__ __forceinline__ void decode_item(unsigned char* ws, int r, TItem& t) {
    int ai = 0, gi = -1, gofs = 0; size_t wofs = 0;
    do {
#define TJOB(cnt, Ai, Wofs, Kp, Np, dstp, mapp, Gi, Gofs) if (r < (cnt)) { ai = (Ai); wofs = (Wofs); gi = (Gi); gofs = (Gofs); t.K = (Kp); t.N = (Np); t.dst = (bf16*)(dstp); t.map = (mapp); t.kb = r / ((Np) / 64); t.nb = r % ((Np) / 64); break; } r -= (cnt);
        if (r < TI_MOE) { const int e = r / 896; r -= e * 896; ai = A_MOEG; gi = A_NORM_FFN; gofs = D; wofs = (size_t)e * D * DFE; t.K = D; t.N = DFE; t.dst = (bf16*)(ws + WS_WGU) + (size_t)e * 2 * DFE * D; t.map = 2; t.kb = r / 56; t.nb = r % 56; break; } r -= TI_MOE;
        if (r < TI_MOE) { const int e = r / 896; r -= e * 896; ai = A_MOEU; gi = A_NORM_FFN; gofs = D; wofs = (size_t)e * D * DFE; t.K = D; t.N = DFE; t.dst = (bf16*)(ws + WS_WGU) + (size_t)e * 2 * DFE * D; t.map = 3; t.kb = r / 56; t.nb = r % 56; break; } r -= TI_MOE;
        if (r < TI_MOE) { const int e = r / 896; r -= e * 896; ai = A_MOED; wofs = (size_t)e * DFE * D; t.K = DFE; t.N = D; t.dst = (bf16*)(ws + WS_WD) + (size_t)e * D * DFE; t.map = 0; t.kb = r / 16; t.nb = r % 16; break; } r -= TI_MOE;
        TJOB(TI_QKV, A_WQKV, 0, D, QKVW, ws + WS_WQKV, 1, -1, 0)
        TJOB(TI_O, A_WO, 0, D, D, ws + WS_WO, 0, -1, 0)
        TJOB(TI_FF, A_FFNG, 0, D, DFF, ws + WS_WGU0, 2, A_NORM_FFN, 0)
        TJOB(TI_FF, A_FFNU, 0, D, DFF, ws + WS_WGU0, 3, A_NORM_FFN, 0)
        TJOB(TI_FF, A_FFND, 0, DFF, D, ws + WS_WD0, 0, -1, 0)
        TJOB(TI_PG, A_PLEG, 0, D, D, ws + WS_WPG0, 0, A_NORM_PLE, 0)
        TJOB(TI_PG, A_PLEG, (size_t)D * D, D, D, ws + WS_WPG1, 0, A_NORM_PLE, D)
        TJOB(TI_PP, A_PLEP, 0, PLE, D, ws + WS_WPP0, 0, -1, 0)
        TJOB(TI_PP, A_PLEP, (size_t)PLE * D, PLE, D, ws + WS_WPP1, 0, -1, 0)
        { const int g = r / 16; r -= g * 16; ai = A_POOLW; gi = A_NORM_MIX; gofs = D + g * 256; wofs = (size_t)g * 256 * 256; t.K = 256; t.N = 256; t.dst = (bf16*)(ws + WS_WPOOL) + (size_t)g * 256 * 256; t.map = 0; t.kb = r / 4; t.nb = r % 4; }
#undef TJOB
    } while (0);
    t.W = arg_ptr(ai) + wofs; t.g = nullptr; if (gi >= 0) t.g = arg_ptr(gi) + gofs;
}
__device__ __forceinline__ void rms_row_to_bf16(const float* xrow, const float* gain, bf16* orow, int lane) {
    const GAS f32x4* xr = (const GAS f32x4*)xrow + lane;
    f32x4 v[4]; float s = 0.f;
#pragma unroll
    for (int j = 0; j < 4; ++j) { v[j] = xr[64 * j]; s += (v[j].x * v[j].x + v[j].y * v[j].y) + (v[j].z * v[j].z + v[j].w * v[j].w); }
    const float rstd = __builtin_amdgcn_rsqf(wave_sum(s) * (1.f / D) + EPS);
    GAS unsigned long long* o8 = (GAS unsigned long long*)orow + lane;
#pragma unroll
    for (int j = 0; j < 4; ++j) { const f32x4 g = ((const GAS f32x4*)gain)[lane + 64 * j];
        o8[64 * j] = (unsigned long long)cvtpk(v[j].x * rstd * g.x, v[j].y * rstd * g.y) | ((unsigned long long)cvtpk(v[j].z * rstd * g.z, v[j].w * rstd * g.w) << 32); }
}
__device__ __forceinline__ void p_norm(Frame& F, const float* H, const float* gain, bf16* XN) {
    const int gw = F.vcu * NWAVES + F.wave, NGW = F.G * NWAVES, lane = F.lane;
    for (int m0 = gw * 4; m0 < M; m0 += NGW * 4) {
        f32x4 v[4][4];
#pragma unroll
        for (int r = 0; r < 4; ++r) { const GAS f32x4* xr = (const GAS f32x4*)(H + (size_t)(m0 + r) * D) + lane;
#pragma unroll
            for (int j = 0; j < 4; ++j) v[r][j] = xr[64 * j]; }
#pragma unroll
        for (int r = 0; r < 4; ++r) { float s = 0.f;
#pragma unroll
            for (int j = 0; j < 4; ++j) s += (v[r][j].x * v[r][j].x + v[r][j].y * v[r][j].y) + (v[r][j].z * v[r][j].z + v[r][j].w * v[r][j].w);
            const float rstd = __builtin_amdgcn_rsqf(wave_sum(s) * (1.f / D) + EPS);
            GAS unsigned long long* o8 = (GAS unsigned long long*)(XN + (size_t)(m0 + r) * D) + lane;
#pragma unroll
            for (int j = 0; j < 4; ++j) { const f32x4 g = ((const GAS f32x4*)gain)[lane + 64 * j];
                o8[64 * j] = (unsigned long long)cvtpk(v[r][j].x * rstd * g.x, v[r][j].y * rstd * g.y) | ((unsigned long long)cvtpk(v[r][j].z * rstd * g.z, v[r][j].w * rstd * g.w) << 32); } }
    }
}
__device__ __forceinline__ void conv_range(unsigned char* ws, LAS unsigned* tile, int lane_in, int it0, int step, int nmax, int it_end) {
    int lane = lane_in; asm volatile("" : "+v"(lane));
    for (int it = it0, n = 0; it < it_end && n < nmax; it += 2 * step, n += 2) {
        const bool hasb = (it + step < it_end) && (n + 1 < nmax); const int itb = hasb ? it + step : it;
        TItem ta, tb; f32x4 va[16], vb[16]; f32x2g ga[8], gb[8];
        decode_item(ws, it, ta); tr_load(va, ga, ta.W, ta.N, ta.kb * 64, ta.nb * 64, lane, ta.g);
        decode_item(ws, itb, tb); tr_load(vb, gb, tb.W, tb.N, tb.kb * 64, tb.nb * 64, lane, tb.g);
        tr_store(va, ta.dst, ta.K, ta.map, ta.kb * 64, ta.nb * 64, tile, lane, ga, ta.g ? 1.f : 0.f);
        tr_store(vb, tb.dst, tb.K, tb.map, tb.kb * 64, tb.nb * 64, tile, lane, gb, tb.g ? 1.f : 0.f);
    }
}
__device__ __forceinline__ void p0_prologue(Frame& F, unsigned char* ws) {
    const int gw = F.vcu * NWAVES + F.wave, NGW = F.G * NWAVES, gt = gw * 64 + F.lane, NGT = NGW * 64;
    for (int idx = gt; idx < S * 32; idx += NGT) {
        const int pos = idx >> 5, i = idx & 31;
        const float inv = 1.0f / __builtin_amdgcn_exp2f((float)i * (13.287712379549449f / 32.f));
        const float ang = (float)pos * inv; const double a = (double)ang * 0.15915494309189535; const float f = (float)(a - __builtin_rint(a));
        ((float*)(ws + WS_COS))[idx] = __builtin_amdgcn_cosf(f); ((float*)(ws + WS_SIN))[idx] = __builtin_amdgcn_sinf(f);
    }
    if (gt < 128) ((float*)(ws + WS_QKN))[gt] = gt < 64 ? arg_ptr(A_QNORM)[gt] : arg_ptr(A_KNORM)[gt - 64];
    { const float* pp = arg_ptr(A_P);
#pragma unroll 4
    for (int i = gt; i < 2 * M * PLE / 8; i += NGT) { const f32x4 a = ((const GAS f32x4*)pp)[2 * i], b = ((const GAS f32x4*)pp)[2 * i + 1];
        v4u w; w.x = cvtpk(a.x, a.y); w.y = cvtpk(a.z, a.w); w.z = cvtpk(b.x, b.y); w.w = cvtpk(b.z, b.w); ((GAS v4u*)(ws + WS_PB))[i] = w; } }
    p_norm(F, arg_ptr(A_X), arg_ptr(A_NORM_MIX), (bf16*)(ws + WS_XN));
    conv_range(ws, (LAS unsigned*)(F.lds + RING_OFF + F.wave * 8192), F.lane, 3 * TI_MOE + gw, NGW, 1 << 30, TI_TOTAL);
}
__device__ __forceinline__ void p_subln(Frame& F, const bf16* O, bf16* XN) {
    const int gw = F.vcu * NWAVES + F.wave, NGW = F.G * NWAVES, lane = F.lane;
    const float lam = __expf(wave_sum(arg_ptr(A_LQ1)[lane] * arg_ptr(A_LK1)[lane])) - __expf(wave_sum(arg_ptr(A_LQ2)[lane] * arg_ptr(A_LK2)[lane])) + LAM_INIT0;
    const float* subln_g = arg_ptr(A_SUBLN);
    float sg[16];
#pragma unroll
    for (int i = 0; i < 4; ++i) { const f32x4 g = *(const GAS f32x4*)(subln_g + (lane & 7) * 16 + 4 * i); sg[4 * i] = g.x; sg[4 * i + 1] = g.y; sg[4 * i + 2] = g.z; sg[4 * i + 3] = g.w; }
    for (int m = gw; m < M; m += NGW) {
        const GAS v4u* o0 = (const GAS v4u*)(O + (size_t)m * D) + 2 * lane; const GAS v4u* o1 = (const GAS v4u*)(O + (size_t)M * D + (size_t)m * D) + 2 * lane;
        const v4u a0 = o0[0], a1 = o0[1], b0 = o1[0], b1 = o1[1];
        const unsigned aw[8] = {a0.x, a0.y, a0.z, a0.w, a1.x, a1.y, a1.z, a1.w}, bw[8] = {b0.x, b0.y, b0.z, b0.w, b1.x, b1.y, b1.z, b1.w};
        float v[16]; float ss = 0.f;
#pragma unroll
        for (int i = 0; i < 8; ++i) { v[2 * i] = bflo(aw[i]) - lam * bflo(bw[i]); v[2 * i + 1] = bfhi(aw[i]) - lam * bfhi(bw[i]); ss += v[2 * i] * v[2 * i] + v[2 * i + 1] * v[2 * i + 1]; }
        ss += __shfl_xor(ss, 1); ss += __shfl_xor(ss, 2); ss += __shfl_xor(ss, 4);
        const float r = __builtin_amdgcn_rsqf(ss * (1.f / 128.f) + EPS) * (1.f - LAM_INIT0);
        v4u w0, w1;
        w0.x = cvtpk(v[0] * r * sg[0], v[1] * r * sg[1]); w0.y = cvtpk(v[2] * r * sg[2], v[3] * r * sg[3]); w0.z = cvtpk(v[4] * r * sg[4], v[5] * r * sg[5]); w0.w = cvtpk(v[6] * r * sg[6], v[7] * r * sg[7]);
        w1.x = cvtpk(v[8] * r * sg[8], v[9] * r * sg[9]); w1.y = cvtpk(v[10] * r * sg[10], v[11] * r * sg[11]); w1.z = cvtpk(v[12] * r * sg[12], v[13] * r * sg[13]); w1.w = cvtpk(v[14] * r * sg[14], v[15] * r * sg[15]);
        GAS v4u* o = (GAS v4u*)(XN + (size_t)m * D) + 2 * lane; o[0] = w0; o[1] = w1;
    }
}
__device__ __forceinline__ void p_pool(Frame& F, const bf16* H, bf16* XN, const float* ssqp) {
    LAS float* rs = (LAS float*)(F.lds + RING_OFF);
    for (int blk = F.vcu; blk < M / 64; blk += F.G) {
        const int r0 = blk * 64, t0 = r0 & (S - 1);
        if (F.tid < 80) { const int row = r0 - 16 + F.tid; float r = 0.f; if (F.tid >= 16 || t0 != 0) r = pg8::row_rstd(ssqp, row, EPS); rs[F.tid] = r; }
        __syncthreads();
        typedef float f32x2v __attribute__((ext_vector_type(2)));
        const int col = 2 * F.tid, g = col >> 8, w = 2 << g;
        const bf16* Hc = H + (size_t)r0 * D + col;
#define LD2(p) ({ const unsigned w_ = *(const GAS unsigned*)(p); (f32x2v){bflo(w_), bfhi(w_)}; })
        float s0 = 0.f, s1 = 0.f;
        if (t0 != 0) for (int k = 1; k <= w; ++k) { const f32x2v hv = LD2(Hc - (long)k * D); const float r = rs[16 - k]; s0 += hv.x * r; s1 += hv.y * r; }
        for (int rb = 0; rb < 64; rb += 8) {
            f32x2v nv[8], ov[8];
#pragma unroll
            for (int j = 0; j < 8; ++j) nv[j] = LD2(Hc + (long)(rb + j) * D);
#pragma unroll
            for (int j = 0; j < 8; ++j) { ov[j] = (f32x2v){0.f, 0.f}; if (t0 + rb + j >= w) ov[j] = LD2(Hc + (long)(rb + j - w) * D); }
#pragma unroll
            for (int j = 0; j < 8; ++j) { const int rl = rb + j, t = t0 + rl; const float rn = rs[16 + rl]; const float a0 = nv[j].x * rn, a1 = nv[j].y * rn;
                s0 += a0; s1 += a1;
                if (t >= w) { const float ro = rs[16 + rl - w]; s0 -= ov[j].x * ro; s1 -= ov[j].y * ro; }
                const int cnt = (t + 1 < w) ? t + 1 : w; const float ic = 1.f / (float)cnt;
                *(GAS unsigned*)(XN + (size_t)(r0 + rl) * D + col) = cvtpk(s0 * ic - a0, s1 * ic - a1); }
        }
#undef LD2
        __syncthreads();
    }
}
__device__ __forceinline__ void p_router(Frame& F, const bf16* H, const float* gain, const float* Wr, float* rstl, int* lists, float* gwl, int* tokslot, gu32* cntw) {
    LAS float* rec = (LAS float*)(F.lds + RING_OFF);
    const int lane = F.lane;
    float wr[4][4][8];
#pragma unroll
    for (int j = 0; j < 4; ++j)
#pragma unroll
        for (int i = 0; i < 4; ++i) { const int k = 4 * lane + 256 * j + i; const f32x4 a = *(const GAS f32x4*)(Wr + k * 8), b = *(const GAS f32x4*)(Wr + k * 8 + 4);
            wr[j][i][0] = a.x; wr[j][i][1] = a.y; wr[j][i][2] = a.z; wr[j][i][3] = a.w; wr[j][i][4] = b.x; wr[j][i][5] = b.y; wr[j][i][6] = b.z; wr[j][i][7] = b.w; }
    f32x4 gn[4];
#pragma unroll
    for (int j = 0; j < 4; ++j) gn[j] = ((const GAS f32x4*)gain)[lane + 64 * j];
    for (int blk = F.vcu; blk < M / 64; blk += F.G) {
        unsigned long long raw[8][4];
#pragma unroll
        for (int rr = 0; rr < 8; ++rr) { const GAS unsigned long long* xr = (const GAS unsigned long long*)(H + (size_t)(blk * 64 + F.wave * 8 + rr) * D) + lane;
#pragma unroll
            for (int j = 0; j < 4; ++j) raw[rr][j] = xr[64 * j]; }
#pragma unroll
        for (int rr = 0; rr < 8; ++rr) {
            const int rl = F.wave * 8 + rr;
            f32x4 v[4]; float s = 0.f;
#pragma unroll
            for (int j = 0; j < 4; ++j) { const unsigned long long a = raw[rr][j]; v[j] = (f32x4){bflo((unsigned)a), bfhi((unsigned)a), bflo((unsigned)(a >> 32)), bfhi((unsigned)(a >> 32))}; s += (v[j].x * v[j].x + v[j].y * v[j].y) + (v[j].z * v[j].z + v[j].w * v[j].w); }
            const float rstd = __builtin_amdgcn_rsqf(wave_sum(s) * (1.f / D) + EPS);
            float lg[8];
#pragma unroll
            for (int e = 0; e < 8; ++e) lg[e] = 0.f;
#pragma unroll
            for (int j = 0; j < 4; ++j) { const float xu[4] = {v[j].x * rstd, v[j].y * rstd, v[j].z * rstd, v[j].w * rstd};
                const float xv[4] = {xu[0] * gn[j].x, xu[1] * gn[j].y, xu[2] * gn[j].z, xu[3] * gn[j].w};
#pragma unroll
                for (int i = 0; i < 4; ++i)
#pragma unroll
                    for (int e = 0; e < 8; ++e) lg[e] = __builtin_fmaf(xv[i], wr[j][i][e], lg[e]); }
#pragma unroll
            for (int e = 0; e < 8; ++e) lg[e] = wave_sum(lg[e]);
            int i0 = 0; float v0 = lg[0];
#pragma unroll
            for (int e = 1; e < 8; ++e) if (lg[e] > v0) { v0 = lg[e]; i0 = e; }
            int i1 = 0; float v1 = -INFINITY;
#pragma unroll
            for (int e = 0; e < 8; ++e) if (e != i0 && lg[e] > v1) { v1 = lg[e]; i1 = e; }
            const float g1 = 1.f / (1.f + __expf(v0 - v1)), g0 = 1.f - g1;
            if (lane == 0) { rec[rl * 8 + 0] = __int_as_float(i0); rec[rl * 8 + 1] = __int_as_float(i1); rec[rl * 8 + 2] = g0; rec[rl * 8 + 3] = g1; rec[rl * 8 + 4] = rstd; }
        }
        __syncthreads();
        {
            const int ex = F.wave, rl = lane; const int a = __float_as_int(rec[rl * 8]), b = __float_as_int(rec[rl * 8 + 1]);
            const bool sel = (a == ex) || (b == ex); const unsigned long long bal = __ballot(sel);
            const int n = __popcll(bal), pre = __popcll(bal & ((1ull << lane) - 1ull));
            int base = 0; if (lane == 0) base = (int)__hip_atomic_fetch_add(cntw + 64 * ex, (unsigned)n, RLX_AGENT);
            base = __builtin_amdgcn_readfirstlane(base);
            if (sel) { const int k = (a == ex) ? 0 : 1, tok = blk * 64 + rl, pos = base + pre;
                lists[ex * M + pos] = tok; gwl[ex * M + pos] = rec[rl * 8 + 2 + k]; rstl[ex * M + pos] = rec[rl * 8 + 4]; tokslot[tok * 2 + k] = (ex << 16) | pos; }
        }
        __syncthreads();
    }
}
__device__ __forceinline__ void p_combine(Frame& F, bf16* HB, const bf16* Ys, const int* tokslot, float* rstd_out) {
    const int gw = F.vcu * NWAVES + F.wave, NGW = F.G * NWAVES, lane = F.lane;
    int off[8]; { int a = 0;
#pragma unroll
        for (int e = 0; e < 8; ++e) { off[e] = a; a += (int)__hip_atomic_load(F.ctl + CW_MOECNT + 64 * e, RLX_AGENT); } }
    constexpr int RPW = 8;
    for (int m0 = gw * RPW; m0 < M; m0 += NGW * RPW) {
        const int ts = (lane < 2 * RPW) ? tokslot[2 * m0 + lane] : 0;
#pragma unroll
        for (int g = 0; g < RPW; g += 4) {
            unsigned long long ya[4][4], yb[4][4], hh[4][4];
#pragma unroll
            for (int r = 0; r < 4; ++r) {
                const int ts0 = __builtin_amdgcn_readlane(ts, 2 * (g + r)), ts1 = __builtin_amdgcn_readlane(ts, 2 * (g + r) + 1);
                int s0 = ts0 & 0xffff, s1 = ts1 & 0xffff;
#pragma unroll
                for (int e = 0; e < 8; ++e) { if ((ts0 >> 16) == e) s0 += off[e]; if ((ts1 >> 16) == e) s1 += off[e]; }
                const GAS unsigned long long* hr = (const GAS unsigned long long*)(HB + (size_t)(m0 + g + r) * D) + lane;
                const GAS unsigned long long* y0 = (const GAS unsigned long long*)(Ys + (size_t)s0 * D) + lane; const GAS unsigned long long* y1 = (const GAS unsigned long long*)(Ys + (size_t)s1 * D) + lane;
#pragma unroll
                for (int j = 0; j < 4; ++j) { ya[r][j] = y0[64 * j]; yb[r][j] = y1[64 * j]; hh[r][j] = hr[64 * j]; }
            }
#pragma unroll
            for (int r = 0; r < 4; ++r) {
                GAS unsigned long long* hw = (GAS unsigned long long*)(HB + (size_t)(m0 + g + r) * D) + lane; float s = 0.f;
#pragma unroll
                for (int j = 0; j < 4; ++j) { const unsigned al = (unsigned)ya[r][j], ah = (unsigned)(ya[r][j] >> 32), bl = (unsigned)yb[r][j], bh = (unsigned)(yb[r][j] >> 32), hl = (unsigned)hh[r][j], hu = (unsigned)(hh[r][j] >> 32);
                    const unsigned w0 = cvtpk(bflo(hl) + (bflo(al) + bflo(bl)), bfhi(hl) + (bfhi(al) + bfhi(bl))), w1 = cvtpk(bflo(hu) + (bflo(ah) + bflo(bh)), bfhi(hu) + (bfhi(ah) + bfhi(bh)));
                    hw[64 * j] = (unsigned long long)w0 | ((unsigned long long)w1 << 32);
                    s += (bflo(w0) * bflo(w0) + bfhi(w0) * bfhi(w0)) + (bflo(w1) * bflo(w1) + bfhi(w1) * bfhi(w1)); }
                const float rstd = __builtin_amdgcn_rsqf(wave_sum(s) * (1.f / D) + EPS);
                if (lane == 0) rstd_out[m0 + g + r] = rstd;
            }
        }
    }
}

struct Args { const float* in[26]; float* out; unsigned char* ws; int ph_lo, ph_hi, li, pad; };
__global__ void __launch_bounds__(NWAVES * 64, 2) mega_fwd(Args args) {
    extern __shared__ __attribute__((aligned(16))) unsigned char lds[];
    Frame F;
    F.lds = (LAS unsigned char*)lds;
    F.MISC = (volatile LAS unsigned*)(F.lds + MISC_OFF);
    F.tid = threadIdx.x; F.lane = F.tid & 63; F.wave = __builtin_amdgcn_readfirstlane(F.tid >> 6);
    F.G = gridDim.x; { const int bx = blockIdx.x; F.vcu = (F.G % 8 == 0) ? (bx % 8) * (F.G / 8) + bx / 8 : bx; }
    unsigned char* ws = args.ws;
    F.ctl = (gu32*)(ws + WS_CTL);
    float* const Hout = args.out;
    for (int u = F.tid; u < (LDS_BYTES - LDSCTL_OFF) / 4; u += NWAVES * 64) ((LAS unsigned*)(F.lds + LDSCTL_OFF))[u] = 0u;
    __syncthreads();
    XcdBarrier bar; bar.bar = (unsigned*)(F.ctl + CW_BAR) + args.li * XCD_BAR_WORDS; bar.x = 0; bar.st = nullptr;
    const int lo = args.ph_lo, hi = args.ph_hi;
    if (hi - lo > 1) bar = xcd_barrier_post((unsigned*)(F.ctl + CW_BAR) + args.li * XCD_BAR_WORDS, F.MISC + 8);
#ifndef PHASE_MASK
#define PHASE_MASK 0x1ffff
#endif
#define IN(k) (((PHASE_MASK >> (k)) & 1) && lo <= (k) && (k) < hi)
#define SEAM(k) do { if (IN(k) && IN((k) + 1)) xcd_barrier(bar); } while (0)
#ifndef REP_MASK
#define REP_MASK 0
#endif
#define REPS(k) (((REP_MASK >> (k)) & 1) ? 2 : 1)
#define REPEAT(k) _Pragma("unroll 1") for (int rep_ = 0; rep_ < REPS(k); (++rep_ < REPS(k)) ? xcd_barrier(bar) : (void)0)
    bf16* XN = (bf16*)(ws + WS_XN);
    const int bx = (int)blockIdx.x;
    const long TS1024 = 256L * 1024 * 2;

    float* SSQA = (float*)(ws + WS_SSQA); float* SSQB = (float*)(ws + WS_SSQB); float* SSQC = (float*)(ws + WS_SSQC);
    if (IN(0)) REPEAT(0) { p0_prologue(F, ws); } SEAM(0);
    if (IN(1)) REPEAT(1) {
        pg8::DenseSched Sd{(const char*)XN, (const char*)(ws + WS_WQKV), 64, 12, F.G, bx, TS1024, 0, TS1024, WGM_P1};
        pg8::EpiQKV E{(bf16*)(ws + WS_Q), (size_t)(WS_K - WS_Q) / 2, (const float*)(ws + WS_QKN), (const float*)(ws + WS_COS), (const float*)(ws + WS_SIN), attn_body::C2, EPS};
        pg8::gemm_phase<pg8::EpiQKV, pg8::DenseSched, false, true>(F.lds + RING_OFF, D, D, D, Sd, E);
    } SEAM(1);
    if (IN(2)) REPEAT(2) {
        static_assert(attn_body::ATTN128_LDS_BYTES <= RING_BYTES, "attention LDS");
        const float lam = __expf(wave_sum(arg_ptr(A_LQ1)[F.lane] * arg_ptr(A_LK1)[F.lane])) - __expf(wave_sum(arg_ptr(A_LQ2)[F.lane] * arg_ptr(A_LK2)[F.lane])) + LAM_INIT0;
        const float* subg = arg_ptr(A_SUBLN);
        const int hgrp = (F.vcu * 3) / F.G; const int hkpos = (hgrp == 0) ? -1 : (hgrp == 1) ? 0 : 2; bool conv_done = false;
        for (int hc = F.vcu; hc < NB * 8 * 4; hc += F.G) {
            const int bh = hc >> 2, s_ = hc & 3, b = bh >> 3, h = bh & 7;
            const attn_body::bf16* Vp = (const attn_body::bf16*)(ws + WS_V) + h * 128; attn_body::bf16* Op = (attn_body::bf16*)(ws + WS_O) + h * 128;
            _Pragma("unroll 1") for (int qi = -1; qi < 4; ++qi) {
                if (qi >= 0) { int qb = (qi & 2) ? s_ : 7 - s_; asm volatile("" : "+s"(qb)); const int c = qi & 1;
                    const attn_body::bf16* Qp = (const attn_body::bf16*)(ws + WS_Q) + (h * 2 + c) * 64; const attn_body::bf16* Kp = (const attn_body::bf16*)(ws + WS_K) + (h * 2 + c) * 64;
                    if (c == 0) attn_body::attn_unit128<8, false>(b, qb, Qp, Kp, Vp, Op, (char*)lds + RING_OFF);
                    else attn_body::attn_unit128<8, true>(b, qb, Qp, Kp, Vp, Op, (char*)lds + RING_OFF, (attn_body::bf16*)XN + h * 128, subg, lam, 1.f - LAM_INIT0, EPS); }
                if (qi == hkpos && !conv_done) {
                    conv_range(ws, (LAS unsigned*)(F.lds + RING_OFF + F.wave * 8192), F.lane, F.vcu * NWAVES + F.wave, F.G * NWAVES, 1 << 30, 2 * TI_MOE); conv_done = true;
                    asm volatile("s_waitcnt lgkmcnt(0)" ::: "memory"); __builtin_amdgcn_s_barrier(); asm volatile("" ::: "memory"); }
            }
        }
    } SEAM(2);
    bf16* HB0 = (bf16*)Hout;
    bf16* HB1 = XN;
    bf16* PL = (bf16*)(ws + WS_Q);
    if (IN(4)) REPEAT(4) {
        pg8::DenseSched Sd{(const char*)XN, (const char*)(ws + WS_WO), 64, 4, F.G, bx, TS1024, 0, TS1024, WGM_1U};
        pg8::EpiResNorm<false> E{arg_ptr(A_X), HB0, SSQA};
        pg8::gemm_phase<pg8::EpiResNorm<false>, pg8::DenseSched, false, true>(F.lds + RING_OFF, D, D, D, Sd, E);
    } SEAM(4);
    if (IN(5)) REPEAT(5) {
        { pg8::DenseSched Sd{(const char*)HB0, (const char*)(ws + WS_WGU0), 64, 22, F.G, bx, TS1024, 0, TS1024, WGM_P5};
          pg8::EpiSwiGLU<1> E{(bf16*)(ws + WS_HFF), DFF, EPS, SSQA, nullptr};
          pg8::gemm_phase<pg8::EpiSwiGLU<1>, pg8::DenseSched, false, true>(F.lds + RING_OFF, D, D, D, Sd, E); }
        { const bool split = (F.G == 256);
          pg8::ProjSched Sp{(const char*)(ws + WS_PB), (const char*)(ws + WS_WPP0), (long)M * PLE * 2, (long)WS_WPP1 - (long)WS_WPP0, split ? 128 : F.G, split ? bx - 128 : bx};
          pg8::EpiProj E{(bf16*)(ws + WS_PROJ0), ((long)WS_PROJ1 - (long)WS_PROJ0) / 2};
          pg8::gemm_phase<pg8::EpiProj, pg8::ProjSched, false, true>(F.lds + RING_OFF, PLE, PLE, PLE, Sp, E); }
    } SEAM(5);
    if (IN(6)) {
        pg8::DenseSched Sd{(const char*)(ws + WS_HFF), (const char*)(ws + WS_WD0), 64, 4, F.G, bx, 256L * DFF * 2, 0, 256L * DFF * 2, WGM_1U};
        pg8::EpiResNorm<true> E{HB0, HB0, SSQB};
        pg8::gemm_phase<pg8::EpiResNorm<true>, pg8::DenseSched, false, true>(F.lds + RING_OFF, DFF, DFF, DFF, Sd, E);
    } SEAM(6);
    if (IN(7)) {
        pg8::DenseSched Sd{(const char*)HB0, (const char*)(ws + WS_WPG0), 64, 4, F.G, bx, TS1024, 0, TS1024, WGM_1U};
        pg8::EpiPle<1, false> E{HB0, (const bf16*)(ws + WS_PROJ0), HB1, SSQB, SSQC, EPS, 0};
        pg8::gemm_phase<pg8::EpiPle<1, false>, pg8::DenseSched, false, true>(F.lds + RING_OFF, D, D, D, Sd, E);
    } SEAM(7);
    if (IN(8)) REPEAT(8) { p_pool(F, HB1, PL, SSQC); } SEAM(8);
    if (IN(9)) {
        pg8::DenseSched Sd{(const char*)PL, (const char*)(ws + WS_WPOOL), 64, 4, F.G, bx, TS1024, 256L * 2, 256L * 256 * 2, WGM_1U};
        pg8::EpiPool E{HB1, arg_ptr(A_POOLB), arg_ptr(A_POOLS)};
        pg8::gemm_phase<pg8::EpiPool, pg8::DenseSched, false, true>(F.lds + RING_OFF, 256, D, 256, Sd, E);
    } SEAM(9);
    if (IN(10)) REPEAT(10) { const bool dmy = rep_ + 1 < REPS(10); unsigned char* wd = dmy ? ws + 300 * MiB : ws;
        p_router(F, HB1, arg_ptr(A_NORM_FFN) + D, arg_ptr(A_ROUTER), (float*)(wd + WS_RSTL), (int*)(wd + WS_LISTS), (float*)(wd + WS_GWL), (int*)(wd + WS_TOKSLOT), F.ctl + CW_MOECNT + (dmy ? 1024 : 0)); } SEAM(10);
    if (IN(11)) REPEAT(11) {
        pg8::MoeSched Sm; Sm.A = (const char*)HB1; Sm.B = (const char*)(ws + WS_WGU); Sm.lists = (const int*)(ws + WS_LISTS);
#pragma unroll
        for (int e = 0; e < 8; ++e) Sm.cnt[e] = __builtin_amdgcn_readfirstlane((int)__hip_atomic_load(F.ctl + CW_MOECNT + 64 * e, RLX_AGENT));
        Sm.nN = 28; Sm.G = F.G; Sm.c = bx; Sm.b_e = 2L * DFE * D * 2; Sm.b_pn = TS1024; Sm.a_row = 0; Sm.list_stride = M; Sm.gather = true; Sm.WGM = WGM_P11; Sm.lim = Sm.total();
        pg8::EpiSwiGLU<2> E{(bf16*)(ws + WS_HM), DFE, EPS, (const float*)(ws + WS_RSTL), (const int*)(ws + WS_LISTS)};
        pg8::gemm_phase<pg8::EpiSwiGLU<2>, pg8::MoeSched, true, true>(F.lds + RING_OFF, D, D, D, Sm, E);
        if (rep_ == 0) {
            volatile LAS int* bw = (volatile LAS int*)(F.lds + MISC_OFF + 96);
            for (;;) {
                if (F.tid == 0) bw[0] = (int)__hip_atomic_fetch_add(F.ctl + CW_STEAL, 1u, RLX_AGENT);
                __syncthreads();
                const int batch = __builtin_amdgcn_readfirstlane(bw[0]);
                __syncthreads();
                if (batch * 16 >= TI_MOE) break;
                conv_range(ws, (LAS unsigned*)(F.lds + RING_OFF + F.wave * 8192), F.lane, 2 * TI_MOE + batch * 16 + F.wave * 2, 1, 2, 3 * TI_MOE);
            }
        }
    } SEAM(11);
    pg8::MoeSched Sdn; Sdn.A = (const char*)(ws + WS_HM); Sdn.B = (const char*)(ws + WS_WD); Sdn.lists = (const int*)(ws + WS_GWL);
    Sdn.nN = 4; Sdn.G = F.G; Sdn.c = bx; Sdn.b_e = (long)D * DFE * 2; Sdn.b_pn = 256L * DFE * 2; Sdn.a_row = (long)DFE * 2; Sdn.list_stride = M; Sdn.gather = false; Sdn.WGM = 8; Sdn.lim = 0;
    int dn_R = 0, dn_P = 1;
    if (IN(12) || IN(13) || IN(14)) {
#pragma unroll
        for (int e = 0; e < 8; ++e) Sdn.cnt[e] = __builtin_amdgcn_readfirstlane((int)__hip_atomic_load(F.ctl + CW_MOECNT + 64 * e, RLX_AGENT));
        const int tot = Sdn.total(), whole = (tot / F.G) * F.G;
        dn_R = tot - whole; Sdn.lim = whole;
        dn_P = (dn_R * 14 <= 192 && dn_R * 14 <= F.G) ? 14 : (dn_R * 7 <= 192 && dn_R * 7 <= F.G) ? 7 : (dn_R * 4 <= 192 && dn_R * 4 <= F.G) ? 4 : (dn_R * 2 <= 192 && dn_R * 2 <= F.G) ? 2 : 1;
        if (dn_R * dn_P > 192 || dn_R * dn_P > F.G) { Sdn.lim = tot; dn_R = 0; }
    }
    float* PART = (float*)(ws + 72 * MiB);
    if (IN(12)) REPEAT(12) {
        pg8::EpiMoeDown E{(bf16*)(ws + WS_YS)};
        pg8::gemm_phase<pg8::EpiMoeDown, pg8::MoeSched, false, true>(F.lds + RING_OFF, DFE, DFE, DFE, Sdn, E);
    }
    if (IN(13) && dn_R > 0) {
        pg8::PieceSched Sp{Sdn, Sdn.lim, dn_R, dn_P, (long)(DFE / dn_P) * 2};
        pg8::EpiPart E{PART};
        pg8::gemm_phase<pg8::EpiPart, pg8::PieceSched, false, true>(F.lds + RING_OFF, DFE / dn_P, DFE, DFE, Sp, E);
    }
    if (IN(13) && IN(14) && dn_R > 0) xcd_barrier(bar);
    if (IN(14) && dn_R > 0) {
        for (int w = F.vcu; w < dn_R * 16; w += F.G) {
            const int j = w >> 4, rl = (w & 15) * 16 + (F.tid >> 5), cl = (F.tid & 31) * 8;
            pg8::Unit u; Sdn.decode(Sdn.lim + j, u);
            if (rl < u.nvalid) {
                const float* pp = PART + (size_t)(j * dn_P) * 65536 + (size_t)rl * 256 + cl;
                f32x4 a = (f32x4){0.f, 0.f, 0.f, 0.f}, b = a;
                for (int p = 0; p < dn_P; ++p) { a += *(const GAS f32x4*)(pp + (size_t)p * 65536); b += *(const GAS f32x4*)(pp + (size_t)p * 65536 + 4); }
                const float gwt = ((const float*)u.list)[rl];
                v4u o; o.x = cvtpk(a.x * gwt, a.y * gwt); o.y = cvtpk(a.z * gwt, a.w * gwt); o.z = cvtpk(b.x * gwt, b.y * gwt); o.w = cvtpk(b.z * gwt, b.w * gwt);
                *(GAS v4u*)((bf16*)(ws + WS_YS) + (size_t)(u.r0 + rl) * D + u.c0 + cl) = o;
            }
        }
    }
    if ((IN(12) || IN(13) || IN(14)) && IN(15)) xcd_barrier(bar);
    if (IN(15)) { p_combine(F, HB1, (const bf16*)(ws + WS_YS), (const int*)(ws + WS_TOKSLOT), (float*)(ws + WS_RSTD2)); } SEAM(15);
    if (IN(16)) {
        pg8::DenseSched Sd{(const char*)HB1, (const char*)(ws + WS_WPG1), 64, 4, F.G, bx, TS1024, 0, TS1024, WGM_1U};
        pg8::EpiPle<2, true> E{HB1, (const bf16*)(ws + WS_PROJ1), Hout, (const float*)(ws + WS_RSTD2), nullptr, EPS, 0};
        pg8::gemm_phase<pg8::EpiPle<2, true>, pg8::DenseSched, false, true>(F.lds + RING_OFF, D, D, D, Sd, E);
    }
#undef IN
#undef SEAM
}
extern "C" void kernel_launch(void* const* d_in, const int* in_sizes, int n_in, void* d_out, int out_size, void* d_ws, size_t ws_size, hipStream_t stream) {
    static int grid = 0;
    if (grid == 0) {
        if (n_in != 26 || in_sizes[0] != M * D || out_size != M * D || ws_size < WS_END) { fprintf(stderr, "kernel_launch: unexpected shapes / workspace (%zu)\n", ws_size); grid = -1; return; }
        int dev = 0, cus = 0, per_cu = 0;
        if (hipGetDevice(&dev) != hipSuccess || hipDeviceGetAttribute(&cus, hipDeviceAttributeMultiprocessorCount, dev) != hipSuccess) { grid = -1; return; }
        if (hipFuncSetAttribute((const void*)mega_fwd, hipFuncAttributeMaxDynamicSharedMemorySize, LDS_BYTES) != hipSuccess) { fprintf(stderr, "kernel_launch: hipFuncSetAttribute failed\n"); grid = -1; return; }
        if (hipOccupancyMaxActiveBlocksPerMultiprocessor(&per_cu, (const void*)mega_fwd, NWAVES * 64, LDS_BYTES) != hipSuccess || per_cu < 1) { fprintf(stderr, "kernel_launch: occupancy query says %d\n", per_cu); }
        (void)hipGetLastError();
        grid = cus;
    }
    if (grid < 0) return;
    if (hipMemsetAsync((char*)d_ws + WS_CTL, 0, CTL_ZERO_BYTES, stream) != hipSuccess) return;
    Args a{};
    for (int i = 0; i < 26; ++i) a.in[i] = (const float*)d_in[i];
    a.out = (float*)d_out; a.ws = (unsigned char*)d_ws;
#if MK_N_LAUNCHES == 1
    a.ph_lo = 0; a.ph_hi = MEGA_END; a.li = 0; a.pad = 0;
    hipLaunchKernelGGL(mega_fwd, dim3(grid), dim3(NWAVES * 64), LDS_BYTES, stream, a);
#else
    for (int ph = 0; ph < MEGA_END; ++ph) { a.ph_lo = ph; a.ph_hi = ph + 1; a.li = 0; a.pad = 0; hipLaunchKernelGGL(mega_fwd, dim3(grid), dim3(NWAVES * 64), LDS_BYTES, stream, a); }
#endif
#if MEGA_END < 17
    nv::naive_suffix(MEGA_END <= 5 ? 0 : MEGA_END <= 7 ? 1 : MEGA_END <= 8 ? 2 : MEGA_END <= 10 ? 3 : 4, d_in, (float*)d_out, (char*)d_ws, stream);
#endif
}
```

```cpp
#define MEGA_END 17
#define MK_N_LAUNCHES 1
#include <hip/hip_runtime.h>
#include <cstdio>
#include <cstdint>
namespace pg8 {
#define PG8_LAS __attribute__((address_space(3)))
typedef unsigned short bf16_t;
typedef short bf16x8 __attribute__((ext_vector_type(8)));
typedef float f32x4 __attribute__((ext_vector_type(4)));
typedef float f32x2 __attribute__((ext_vector_type(2)));
typedef unsigned u32x4 __attribute__((ext_vector_type(4)));
typedef unsigned u32x2 __attribute__((ext_vector_type(2)));
constexpr int BM = 256, BK = 64, HALF = 128, HTB = HALF * BK * 2  , STAGE_BYTES = 8 * HTB, NXCD = 8;

__host__ __device__ __forceinline__ int lds_byte(int r, int c) { const int st = (r >> 4) * 2 + (c >> 5), rr = r & 15, cc = c & 31, ob = rr * 64 + cc * 2; return st * 1024 + (ob ^ (((ob >> 9) & 1) << 5)); }
__host__ __device__ __forceinline__ void stage_rc(int b, int& R, int& C) { const int st = b / 1024, sb = b % 1024, swz = sb ^ (((sb >> 9) & 1) << 5); R = (st >> 1) * 16 + swz / 64; C = (st & 1) * 32 + (swz % 64) / 2; }
__host__ __device__ __forceinline__ int perm32(int rho) { const int n = rho >> 4, i = rho & 15; return 8 * (i >> 2) + 4 * n + (i & 3); }

struct Unit { const char* A; const char* B; const int* list; int r0, c0, nvalid, ex; };
struct Pre { float rs[2][4]; };

__device__ __forceinline__ unsigned cvt_pk_bf16(float lo, float hi) { unsigned r; asm volatile("v_cvt_pk_bf16_f32 %0, %1, %2" : "=v"(r) : "v"(lo), "v"(hi)); return r; }
__device__ __forceinline__ float bf_lo(unsigned w) { return __uint_as_float(w << 16); }
__device__ __forceinline__ float bf_hi(unsigned w) { return __uint_as_float(w & 0xffff0000u); }

__device__ __forceinline__ void tile_of(int L, int nM, int nN, int& pm, int& pn, int WGM = 8) {
    const int nwg = nM * nN; int wgid = L; { const int q = nwg / NXCD, r = nwg % NXCD, xcd = wgid % NXCD, off = wgid / NXCD; wgid = (xcd < r ? xcd * (q + 1) : r * (q + 1) + (xcd - r) * q) + off; }
    const int nig = WGM * nN, gid = wgid / nig, fm = gid * WGM, gsz = (nM - fm) < WGM ? (nM - fm) : WGM;
    pm = fm + ((wgid % nig) % gsz); pn = (wgid % nig) / gsz;
}
struct DenseSched {
    const char* A; const char* B; int nM, nN, G, c; long a_pm, a_pn, b_pn; int wgm;
    __device__ __forceinline__ bool next(int i, Unit& u) const {
        if (c < 0) return false; const long L = (long)i * G + c; if (L >= (long)nM * nN) return false;
        int pm, pn; tile_of((int)L, nM, nN, pm, pn, wgm);
        u.A = A + pm * a_pm + pn * a_pn; u.B = B + pn * b_pn; u.list = nullptr; u.r0 = pm * BM; u.c0 = pn * BM; u.nvalid = BM; u.ex = 0; return true;
    }
};
struct ProjSched {
    const char* A0; const char* B0; long dA, dB; int G, c;
    __device__ __forceinline__ bool next(int i, Unit& u) const {
        if (c < 0) return false; const long L = (long)i * G + c; if (L >= 64 * 8) return false;
        int pm, pn; tile_of((int)L, 64, 8, pm, pn, 8); const int layer = pn >> 2, pc = pn & 3;
        u.A = A0 + layer * dA + (long)pm * (256 * 256 * 2); u.B = B0 + layer * dB + (long)pc * (256 * 256 * 2); u.list = nullptr; u.r0 = pm * BM; u.c0 = pc * BM; u.nvalid = BM; u.ex = layer; return true;
    }
};
struct MoeSched {
    const char* A; const char* B; const int* lists; int cnt[8]; int nN, G, c; long b_e, b_pn, a_row; int list_stride; bool gather; int lim; int WGM;
    __device__ __forceinline__ int total() const { int tot = 0;
#pragma unroll
        for (int e = 0; e < 8; ++e) tot += ((cnt[e] + 255) >> 8) * nN;
        return tot; }
    __device__ __forceinline__ void decode(int L, Unit& u) const {
        const int tot = total();
        int w = L; { const int q = tot / NXCD, r = tot % NXCD, xcd = w % NXCD, off = w / NXCD; w = (xcd < r ? xcd * (q + 1) : r * (q + 1) + (xcd - r) * q) + off; }
        int ex = 0, off_rows = 0, tiles = 0, ce = 0; bool found = false;
#pragma unroll
        for (int e = 0; e < 8; ++e) { const int t = (cnt[e] + 255) >> 8, ue = t * nN; if (!found) { if (w < ue) { found = true; ex = e; tiles = t; ce = cnt[e]; } else { w -= ue; off_rows += cnt[e]; } } }
        const int nig = WGM * nN, gid = w / nig, fm = gid * WGM, gsz = (tiles - fm) < WGM ? (tiles - fm) : WGM;
        const int pm = fm + ((w % nig) % gsz), pn = (w % nig) / gsz;
        u.r0 = off_rows + pm * BM; u.c0 = pn * BM; u.nvalid = (ce - pm * BM) < BM ? (ce - pm * BM) : BM; u.ex = ex;
        u.B = B + ex * b_e + pn * b_pn;
        u.list = lists + (long)ex * list_stride + pm * BM;
        u.A = gather ? A : A + (long)u.r0 * a_row;
    }
    __device__ __forceinline__ bool next(int i, Unit& u) const {
        const long L0 = (long)i * G + c; if (L0 >= lim) return false;
        decode((int)L0, u); return true;
    }
};
struct PieceSched {
    MoeSched S; int L0, R, P; long kbytes;
    __device__ __forceinline__ bool next(int i, Unit& u) const {
        if (i != 0 || S.c >= R * P) return false;
        const int q = S.c, j = q / P, p = q - j * P;
        S.decode(L0 + j, u); u.A += p * kbytes; u.B += p * kbytes; u.ex = q; return true;
    }
};

template <class Epi, class Sched, bool GATHER, bool ALIGN_EPI>
__device__ __forceinline__ void gemm_phase(PG8_LAS unsigned char* lds, const int K, const int lda, const int ldb, const Sched& S, const Epi& E) {
    int tid_ = threadIdx.x; asm volatile("" : "+v"(tid_));
    const int tid = tid_, wid = __builtin_amdgcn_readfirstlane(tid >> 6), lane = tid & 63, wr = wid >> 2, wc = wid & 3, fr = lane & 15, fq = lane >> 4;
    int Kr_ = K; asm volatile("" : "+s"(Kr_));
    const int nt = Kr_ / BK;
    int RA[2], CA[2]; unsigned voffB[2];
#pragma unroll
    for (int i = 0; i < 2; ++i) { int R, C; stage_rc(tid * 16 + i * 8192, R, C); RA[i] = R; CA[i] = C; const int Rb = Epi::PERM ? ((R & ~31) + perm32(R & 31)) : R; voffB[i] = (unsigned)(Rb * ldb + C) * 2u; }
    const size_t kstep = (size_t)(BK * 2);
    const size_t hstep = (size_t)HALF * ldb * 2;
    const unsigned ldsw = (unsigned)wid * 1024u;
    const int aoff = lds_byte(wr * 64 + fr, fq * 8), boff = lds_byte(wc * 32 + fr, fq * 8);
#define PG8_SA(b, h) (((b) * 2 + (h)) * HTB)
#define PG8_SB(b, h) ((4 + (b) * 2 + (h)) * HTB)
#define PG8_STAGE(bufoff, gbase, voff) do { _Pragma("unroll") for (int _i = 0; _i < 2; ++_i) \
        __builtin_amdgcn_global_load_lds((const unsigned*)((const char*)(gbase) + (voff)[_i]), (PG8_LAS unsigned*)(lds + (bufoff) + ldsw + _i * 8192), 16, 0, 0); } while (0)
#define PG8_SETOFF(v, u) do { _Pragma("unroll") for (int _h = 0; _h < 2; ++_h) _Pragma("unroll") for (int _i = 0; _i < 2; ++_i) { const int _r = _h * HALF + RA[_i]; \
        if constexpr (GATHER) { const int _rr = _r < (u).nvalid ? _r : (u).nvalid - 1; v[_h][_i] = (unsigned)(u).list[_rr] * (unsigned)(lda * 2) + (unsigned)(CA[_i] * 2); } \
        else { v[_h][_i] = (unsigned)(_r * lda + CA[_i]) * 2u; } } } while (0)
#define PG8_LDA(dst, b, h) do { _Pragma("unroll") for (int m = 0; m < 4; ++m) _Pragma("unroll") for (int k = 0; k < 2; ++k) dst[m][k] = *(const PG8_LAS bf16x8*)(lds + PG8_SA(b, h) + aoff + m * 2048 + k * 1024); } while (0)
#define PG8_LDB(dst, b, h) do { _Pragma("unroll") for (int n = 0; n < 2; ++n) _Pragma("unroll") for (int k = 0; k < 2; ++k) dst[n][k] = *(const PG8_LAS bf16x8*)(lds + PG8_SB(b, h) + boff + n * 2048 + k * 1024); } while (0)
#define PG8_MMA(ai, bj, At, Bt) do { __builtin_amdgcn_s_setprio(1); _Pragma("unroll") for (int m = 0; m < 4; ++m) _Pragma("unroll") for (int n = 0; n < 2; ++n) _Pragma("unroll") for (int k = 0; k < 2; ++k) \
        acc[ai][bj][m][n] = __builtin_amdgcn_mfma_f32_16x16x32_bf16(Bt[n][k], At[m][k], acc[ai][bj][m][n], 0, 0, 0); __builtin_amdgcn_s_setprio(0); } while (0)
#define PG8_WAIT_V(n) asm volatile("s_waitcnt vmcnt(" #n ")" ::: "memory")
#define PG8_WAIT_L(n) asm volatile("s_waitcnt lgkmcnt(" #n ")" ::: "memory")
#define PG8_BAR __builtin_amdgcn_s_barrier()
#define PG8_SCHED __builtin_amdgcn_sched_barrier(0)
    Unit cur, nxt; int ui = 0;
    if (!S.next(0, cur)) return;
    unsigned va[2][2], vn[2][2];
    PG8_SETOFF(va, cur);
    Pre pre; E.prefetch(cur, wr, fr, pre);
#pragma unroll
    for (int h = 0; h < 2; ++h)
#pragma unroll
        for (int i = 0; i < 2; ++i) vn[h][i] = va[h][i];
    f32x4 acc[2][2][4][2];
#pragma unroll
    for (int a = 0; a < 2; ++a)
#pragma unroll
        for (int b = 0; b < 2; ++b)
#pragma unroll
            for (int m = 0; m < 4; ++m)
#pragma unroll
                for (int n = 0; n < 2; ++n) acc[a][b][m][n] = (f32x4){0.f, 0.f, 0.f, 0.f};
    bf16x8 At[4][2], B0[2][2], B1[2][2];
    const char* cA = cur.A; const char* cB = cur.B;
    PG8_STAGE(PG8_SB(0, 0), cB, voffB); PG8_STAGE(PG8_SB(0, 1), cB + hstep, voffB); PG8_STAGE(PG8_SA(0, 0), cA, va[0]); PG8_STAGE(PG8_SA(0, 1), cA, va[1]);
    if (wr == 1) PG8_BAR;
    PG8_WAIT_V(2); PG8_BAR;
    PG8_STAGE(PG8_SB(1, 0), cB + kstep, voffB); PG8_STAGE(PG8_SA(1, 0), cA + kstep, va[0]); PG8_STAGE(PG8_SB(1, 1), cB + hstep + kstep, voffB);
    PG8_WAIT_V(6); PG8_BAR;
    for (;;) {
        const bool has_next = S.next(ui + 1, nxt);
        if constexpr (GATHER) { if (has_next) {
#pragma unroll
            for (int h = 0; h < 2; ++h)
#pragma unroll
                for (int i = 0; i < 2; ++i) { const int r_ = h * HALF + RA[i]; vn[h][i] = (unsigned)nxt.list[r_ < nxt.nvalid ? r_ : nxt.nvalid - 1]; } } }
        const char* nA = has_next ? nxt.A : cA; const char* nB = has_next ? nxt.B : cB;
        for (int t = 0; t < nt; t += 2) {
            const bool last = (t == nt - 2);
            const char* a1 = cA + (size_t)(t + 1) * kstep;
            const char* a2 = last ? nA : cA + (size_t)(t + 2) * kstep; const char* b2 = last ? nB : cB + (size_t)(t + 2) * kstep;
            const char* a3 = a2 + kstep; const char* b3 = b2 + kstep;
            unsigned o2[2][2];
#pragma unroll
            for (int h = 0; h < 2; ++h)
#pragma unroll
                for (int i = 0; i < 2; ++i) { if constexpr (GATHER) o2[h][i] = (last && has_next) ? vn[h][i] * (unsigned)(lda * 2) + (unsigned)(CA[i] * 2) : va[h][i]; else o2[h][i] = va[h][i]; }
            PG8_LDB(B0, 0, 0); PG8_LDB(B1, 0, 1); PG8_SCHED; PG8_LDA(At, 0, 0); PG8_STAGE(PG8_SA(1, 1), a1, va[1]);
            PG8_WAIT_V(8); PG8_WAIT_L(0); PG8_BAR; PG8_MMA(0, 0, At, B0); PG8_MMA(0, 1, At, B1); PG8_BAR; PG8_SCHED;
            PG8_LDA(At, 0, 1); PG8_STAGE(PG8_SB(0, 0), b2, voffB); PG8_STAGE(PG8_SB(0, 1), b2 + hstep, voffB); PG8_STAGE(PG8_SA(0, 0), a2, o2[0]);
            PG8_WAIT_V(8); PG8_WAIT_L(0); PG8_BAR; PG8_MMA(1, 0, At, B0); PG8_MMA(1, 1, At, B1); PG8_BAR; PG8_SCHED;
            PG8_LDB(B0, 1, 0); PG8_LDB(B1, 1, 1); PG8_SCHED; PG8_LDA(At, 1, 0); PG8_STAGE(PG8_SA(0, 1), a2, o2[1]);
            PG8_WAIT_V(8); PG8_WAIT_L(0); PG8_BAR; PG8_MMA(0, 0, At, B0); PG8_MMA(0, 1, At, B1); PG8_BAR; PG8_SCHED;
            PG8_LDA(At, 1, 1); PG8_STAGE(PG8_SB(1, 0), b3, voffB); PG8_STAGE(PG8_SB(1, 1), b3 + hstep, voffB); PG8_STAGE(PG8_SA(1, 0), a3, o2[0]);
            PG8_WAIT_V(8); PG8_WAIT_L(0); PG8_BAR; PG8_MMA(1, 0, At, B0); PG8_MMA(1, 1, At, B1); PG8_BAR; PG8_SCHED;
        }
        if constexpr (ALIGN_EPI) { if (wr == 0) PG8_BAR; }
        E(acc, cur, wr, wc, fr, fq, pre);
        if (!has_next) break;
#pragma unroll
        for (int a = 0; a < 2; ++a)
#pragma unroll
            for (int b = 0; b < 2; ++b)
#pragma unroll
                for (int m = 0; m < 4; ++m)
#pragma unroll
                    for (int n = 0; n < 2; ++n) acc[a][b][m][n] = (f32x4){0.f, 0.f, 0.f, 0.f};
        cur = nxt; cA = nA; cB = nB; ++ui;
        E.prefetch(cur, wr, fr, pre);
#pragma unroll
        for (int h = 0; h < 2; ++h)
#pragma unroll
            for (int i = 0; i < 2; ++i) { if constexpr (GATHER) va[h][i] = vn[h][i] * (unsigned)(lda * 2) + (unsigned)(CA[i] * 2); else va[h][i] = vn[h][i]; }
        if constexpr (ALIGN_EPI) { if (wr == 1) PG8_BAR; }
    }
    PG8_WAIT_V(0);
    if constexpr (!ALIGN_EPI) { if (wr == 0) PG8_BAR; }
    PG8_BAR;
#undef PG8_SA
#undef PG8_SB
#undef PG8_STAGE
#undef PG8_SETOFF
#undef PG8_LDA
#undef PG8_LDB
#undef PG8_MMA
#undef PG8_WAIT_V
#undef PG8_WAIT_L
#undef PG8_BAR
#undef PG8_SCHED
}
}
namespace pg8 {
constexpr float LOG2E = 1.4426950408889634f;
__device__ __forceinline__ float fast_sigmoid(float v) { return __builtin_amdgcn_rcpf(1.f + __builtin_amdgcn_exp2f(-v * LOG2E)); }
__device__ __forceinline__ f32x4 sig4(f32x4 v) { return (f32x4){fast_sigmoid(v[0]), fast_sigmoid(v[1]), fast_sigmoid(v[2]), fast_sigmoid(v[3])}; }
__device__ __forceinline__ u32x4 pack8(f32x4 a, f32x4 b) { u32x4 w; w.x = cvt_pk_bf16(a[0], a[1]); w.y = cvt_pk_bf16(a[2], a[3]); w.z = cvt_pk_bf16(b[0], b[1]); w.w = cvt_pk_bf16(b[2], b[3]); return w; }

struct EpiQKV {
    static constexpr bool PERM = true;
    bf16_t* Q; size_t split_stride  ; const float* qkn  ; const float* cosT; const float* sinT; float c2, eps;
    __device__ __forceinline__ void prefetch(const Unit&, int, int, Pre&) const {}
    __device__ __forceinline__ void operator()(const f32x4 (&acc)[2][2][4][2], const Unit& u, int wr, int wc, int fr, int fq, const Pre& pre) const {
        const int which = u.c0 >> 10, colt = u.c0 & 1023;
        bf16_t* base = Q + (size_t)which * split_stride;
        const int ocol = colt + 64 * wc + 8 * fq;
        if (which == 2) {
#pragma unroll
            for (int ai = 0; ai < 2; ++ai)
#pragma unroll
                for (int m = 0; m < 4; ++m) { bf16_t* rowp = base + (size_t)(u.r0 + ai * HALF + wr * 64 + m * 16 + fr) * 1024 + ocol;
#pragma unroll
                    for (int bj = 0; bj < 2; ++bj) *(u32x4*)(rowp + 32 * bj) = pack8(acc[ai][bj][m][0], acc[ai][bj][m][1]); }
        } else {
            const float* gp = qkn + 64 * which; const float sc = which == 0 ? c2 : 1.f;
            f32x4 g[2][2];
#pragma unroll
            for (int bj = 0; bj < 2; ++bj)
#pragma unroll
                for (int n = 0; n < 2; ++n) g[bj][n] = *(const f32x4*)(gp + 32 * bj + 8 * fq + 4 * n);
#pragma unroll
            for (int ai = 0; ai < 2; ++ai)
#pragma unroll
                for (int m = 0; m < 4; ++m) {
                    const int row = u.r0 + ai * HALF + wr * 64 + m * 16 + fr, pos = row & 2047;
                    f32x4 c[2], s[2];
#pragma unroll
                    for (int n = 0; n < 2; ++n) { c[n] = *(const f32x4*)(cosT + pos * 32 + 8 * fq + 4 * n); s[n] = *(const f32x4*)(sinT + pos * 32 + 8 * fq + 4 * n); }
                    float ss = 0.f;
#pragma unroll
                    for (int bj = 0; bj < 2; ++bj)
#pragma unroll
                        for (int n = 0; n < 2; ++n) { const f32x4 v = acc[ai][bj][m][n]; ss += (v[0] * v[0] + v[1] * v[1]) + (v[2] * v[2] + v[3] * v[3]); }
                    ss += __shfl_xor(ss, 16); ss += __shfl_xor(ss, 32);
                    const float rstd = __builtin_amdgcn_rsqf(ss * (1.f / 64.f) + eps);
                    f32x4 o0[2], o1[2];
#pragma unroll
                    for (int n = 0; n < 2; ++n) { const f32x4 y0 = acc[ai][0][m][n] * rstd * g[0][n], y1 = acc[ai][1][m][n] * rstd * g[1][n];
                        o0[n] = (y0 * c[n] - y1 * s[n]) * sc; o1[n] = (y1 * c[n] + y0 * s[n]) * sc; }
                    bf16_t* rowp = base + (size_t)row * 1024 + ocol;
                    *(u32x4*)(rowp) = pack8(o0[0], o0[1]); *(u32x4*)(rowp + 32) = pack8(o1[0], o1[1]);
                }
        }
    }
};
__device__ __forceinline__ float row_rstd(const float* ssqp, int row, float eps) {
    const f32x4* p = (const f32x4*)(ssqp + (size_t)row * 16); const f32x4 a = p[0], b = p[1], c = p[2], d = p[3];
    const float s = (((a[0] + a[1]) + (a[2] + a[3])) + ((b[0] + b[1]) + (b[2] + b[3]))) + (((c[0] + c[1]) + (c[2] + c[3])) + ((d[0] + d[1]) + (d[2] + d[3])));
    return __builtin_amdgcn_rsqf(s * (1.f / 1024.f) + eps);
}
__device__ __forceinline__ f32x4 bf4(u32x2 w) { return (f32x4){bf_lo(w.x), bf_hi(w.x), bf_lo(w.y), bf_hi(w.y)}; }
template <bool BASE_BF16> struct EpiResNorm {
    static constexpr bool PERM = true;
    const void* base; bf16_t* hb; float* ssqp;
    __device__ __forceinline__ void prefetch(const Unit&, int, int, Pre&) const {}
    __device__ __forceinline__ void operator()(const f32x4 (&acc)[2][2][4][2], const Unit& u, int wr, int wc, int fr, int fq, const Pre& pre) const {
        const int col0 = u.c0 + wc * 32 + 8 * fq;
#pragma unroll
        for (int ai = 0; ai < 2; ++ai)
#pragma unroll
            for (int m = 0; m < 4; ++m) { const int row = u.r0 + ai * HALF + wr * 64 + m * 16 + fr; const size_t off = (size_t)row * 1024 + col0; float ss = 0.f;
#pragma unroll
                for (int bj = 0; bj < 2; ++bj) { const size_t o2 = off + bj * HALF;
                    f32x4 b0, b1;
                    if constexpr (BASE_BF16) { const u32x4 bw = *(const u32x4*)((const bf16_t*)base + o2); b0 = bf4((u32x2){bw.x, bw.y}); b1 = bf4((u32x2){bw.z, bw.w}); }
                    else { b0 = *(const f32x4*)((const float*)base + o2); b1 = *(const f32x4*)((const float*)base + o2 + 4); }
                    const u32x4 w = pack8(b0 + acc[ai][bj][m][0], b1 + acc[ai][bj][m][1]); *(u32x4*)(hb + o2) = w;
                    const f32x4 h0 = bf4((u32x2){w.x, w.y}), h1 = bf4((u32x2){w.z, w.w});
                    ss += ((h0[0] * h0[0] + h0[1] * h0[1]) + (h0[2] * h0[2] + h0[3] * h0[3])) + ((h1[0] * h1[0] + h1[1] * h1[1]) + (h1[2] * h1[2] + h1[3] * h1[3])); }
                ss += __shfl_xor(ss, 16); ss += __shfl_xor(ss, 32);
                if (fq == 0) ssqp[(size_t)row * 16 + (u.c0 >> 8) * 4 + wc] = ss; }
    }
};
template <int RS  > struct EpiSwiGLU {
    static constexpr bool PERM = true;
    bf16_t* O; int ldo; float eps; const float* ssqp; const int* lists_base;
    __device__ __forceinline__ void prefetch(const Unit& u, int wr, int fr, Pre& pre) const {
#pragma unroll
        for (int ai = 0; ai < 2; ++ai)
#pragma unroll
            for (int m = 0; m < 4; ++m) { const int rl = ai * HALF + wr * 64 + m * 16 + fr;
                if constexpr (RS == 1) pre.rs[ai][m] = row_rstd(ssqp, u.r0 + rl, eps); else pre.rs[ai][m] = ssqp[(u.list - lists_base) + (rl < u.nvalid ? rl : u.nvalid - 1)]; }
    }
    __device__ __forceinline__ void operator()(const f32x4 (&acc)[2][2][4][2], const Unit& u, int wr, int wc, int fr, int fq, const Pre& pre) const {
        const int col0 = (u.c0 >> 1) + wc * 32 + 8 * fq;
#pragma unroll
        for (int ai = 0; ai < 2; ++ai)
#pragma unroll
            for (int m = 0; m < 4; ++m) { const int rl = ai * HALF + wr * 64 + m * 16 + fr;
                const float rs = pre.rs[ai][m];
                f32x4 o[2];
#pragma unroll
                for (int n = 0; n < 2; ++n) { const f32x4 gt = acc[ai][0][m][n] * rs, up = acc[ai][1][m][n] * rs; o[n] = gt * sig4(gt) * up; }
                if (rl < u.nvalid) *(u32x4*)(O + (size_t)(u.r0 + rl) * ldo + col0) = pack8(o[0], o[1]); }
    }
};
struct EpiProj {
    static constexpr bool PERM = true;
    bf16_t* P0; long dP;
    __device__ __forceinline__ void prefetch(const Unit&, int, int, Pre&) const {}
    __device__ __forceinline__ void operator()(const f32x4 (&acc)[2][2][4][2], const Unit& u, int wr, int wc, int fr, int fq, const Pre& pre) const {
        bf16_t* base = P0 + u.ex * dP; const int col0 = u.c0 + wc * 32 + 8 * fq;
#pragma unroll
        for (int ai = 0; ai < 2; ++ai)
#pragma unroll
            for (int m = 0; m < 4; ++m) { bf16_t* rowp = base + (size_t)(u.r0 + ai * HALF + wr * 64 + m * 16 + fr) * 1024 + col0;
#pragma unroll
                for (int bj = 0; bj < 2; ++bj) *(u32x4*)(rowp + bj * HALF) = pack8(acc[ai][bj][m][0], acc[ai][bj][m][1]); }
    }
};
template <int RS, bool OUT_F32> struct EpiPle {
    static constexpr bool PERM = true;
    const bf16_t* Hin; const bf16_t* P; void* out; const float* ssq_in; float* ssq_out; float eps; int pad;
    __device__ __forceinline__ void prefetch(const Unit& u, int wr, int fr, Pre& pre) const {
#pragma unroll
        for (int ai = 0; ai < 2; ++ai)
#pragma unroll
            for (int m = 0; m < 4; ++m) { const int row = u.r0 + ai * HALF + wr * 64 + m * 16 + fr;
                if constexpr (RS == 1) pre.rs[ai][m] = row_rstd(ssq_in, row, eps); else pre.rs[ai][m] = ssq_in[row]; }
    }
    __device__ __forceinline__ void operator()(const f32x4 (&acc)[2][2][4][2], const Unit& u, int wr, int wc, int fr, int fq, const Pre& pre) const {
        const int col0 = u.c0 + wc * 32 + 8 * fq;
#pragma unroll
        for (int ai = 0; ai < 2; ++ai)
#pragma unroll
            for (int m = 0; m < 4; ++m) { const int row = u.r0 + ai * HALF + wr * 64 + m * 16 + fr; const size_t off = (size_t)row * 1024 + col0; float ss = 0.f;
                const float rs = pre.rs[ai][m];
#pragma unroll
                for (int bj = 0; bj < 2; ++bj) { const size_t o2 = off + bj * HALF;
                    const u32x4 hw = *(const u32x4*)(Hin + o2), pw = *(const u32x4*)(P + o2);
                    const f32x4 h0 = bf4((u32x2){hw.x, hw.y}) + sig4(acc[ai][bj][m][0] * rs) * bf4((u32x2){pw.x, pw.y});
                    const f32x4 h1 = bf4((u32x2){hw.z, hw.w}) + sig4(acc[ai][bj][m][1] * rs) * bf4((u32x2){pw.z, pw.w});
                    if constexpr (OUT_F32) { *(f32x4*)((float*)out + o2) = h0; *(f32x4*)((float*)out + o2 + 4) = h1; }
                    else { const u32x4 w = pack8(h0, h1); *(u32x4*)((bf16_t*)out + o2) = w; const f32x4 r0 = bf4((u32x2){w.x, w.y}), r1 = bf4((u32x2){w.z, w.w});
                        ss += ((r0[0] * r0[0] + r0[1] * r0[1]) + (r0[2] * r0[2] + r0[3] * r0[3])) + ((r1[0] * r1[0] + r1[1] * r1[1]) + (r1[2] * r1[2] + r1[3] * r1[3])); } }
                if constexpr (!OUT_F32) { ss += __shfl_xor(ss, 16); ss += __shfl_xor(ss, 32); if (fq == 0) ssq_out[(size_t)row * 16 + (u.c0 >> 8) * 4 + wc] = ss; } }
    }
};
struct EpiPool {
    static constexpr bool PERM = true;
    bf16_t* HB; const float* bias; const float* scale;
    __device__ __forceinline__ void prefetch(const Unit&, int, int, Pre&) const {}
    __device__ __forceinline__ void operator()(const f32x4 (&acc)[2][2][4][2], const Unit& u, int wr, int wc, int fr, int fq, const Pre& pre) const {
        const int col0 = u.c0 + wc * 32 + 8 * fq;
#pragma unroll
        for (int bj = 0; bj < 2; ++bj) { const f32x4 bv0 = *(const f32x4*)(bias + col0 + bj * HALF), bv1 = *(const f32x4*)(bias + col0 + bj * HALF + 4), sv0 = *(const f32x4*)(scale + col0 + bj * HALF), sv1 = *(const f32x4*)(scale + col0 + bj * HALF + 4);
#pragma unroll
            for (int ai = 0; ai < 2; ++ai)
#pragma unroll
                for (int m = 0; m < 4; ++m) { const size_t o2 = (size_t)(u.r0 + ai * HALF + wr * 64 + m * 16 + fr) * 1024 + col0 + bj * HALF;
                    const u32x4 hw = *(const u32x4*)(HB + o2);
                    *(u32x4*)(HB + o2) = pack8(bf4((u32x2){hw.x, hw.y}) + (acc[ai][bj][m][0] + bv0) * sv0, bf4((u32x2){hw.z, hw.w}) + (acc[ai][bj][m][1] + bv1) * sv1); } }
    }
};
struct EpiMoeDown {
    static constexpr bool PERM = true;
    bf16_t* Ys;
    __device__ __forceinline__ void prefetch(const Unit& u, int wr, int fr, Pre& pre) const { const float* gw = (const float*)u.list;
#pragma unroll
        for (int ai = 0; ai < 2; ++ai)
#pragma unroll
            for (int m = 0; m < 4; ++m) { const int rl = ai * HALF + wr * 64 + m * 16 + fr; pre.rs[ai][m] = gw[rl < u.nvalid ? rl : u.nvalid - 1]; }
    }
    __device__ __forceinline__ void operator()(const f32x4 (&acc)[2][2][4][2], const Unit& u, int wr, int wc, int fr, int fq, const Pre& pre) const {
        const int col0 = u.c0 + wc * 32 + 8 * fq;
#pragma unroll
        for (int ai = 0; ai < 2; ++ai)
#pragma unroll
            for (int m = 0; m < 4; ++m) { const int rl = ai * HALF + wr * 64 + m * 16 + fr;
                if (rl < u.nvalid) { const float g = pre.rs[ai][m]; bf16_t* rowp = Ys + (size_t)(u.r0 + rl) * 1024 + col0;
#pragma unroll
                    for (int bj = 0; bj < 2; ++bj) *(u32x4*)(rowp + bj * HALF) = pack8(acc[ai][bj][m][0] * g, acc[ai][bj][m][1] * g); } }
    }
};
struct EpiPart {
    static constexpr bool PERM = false;
    float* PART;
    __device__ __forceinline__ void prefetch(const Unit&, int, int, Pre&) const {}
    __device__ __forceinline__ void operator()(const f32x4 (&acc)[2][2][4][2], const Unit& u, int wr, int wc, int fr, int fq, const Pre& pre) const {
        float* base = PART + (size_t)u.ex * 65536 + wc * 32 + 4 * fq;
#pragma unroll
        for (int ai = 0; ai < 2; ++ai)
#pragma unroll
            for (int m = 0; m < 4; ++m) { float* rowp = base + (size_t)(ai * HALF + wr * 64 + m * 16 + fr) * 256;
#pragma unroll
                for (int bj = 0; bj < 2; ++bj)
#pragma unroll
                    for (int n = 0; n < 2; ++n) *(f32x4*)(rowp + bj * HALF + n * 16) = acc[ai][bj][m][n]; }
    }
};
}
#include <hip/hip_bf16.h>
#include <cmath>
namespace attn_body {
using bf16=__hip_bfloat16;
using bf16x8=__attribute__((ext_vector_type(8)))short;
using s16x4=__attribute__((ext_vector_type(4)))short;
using f32x16=__attribute__((ext_vector_type(16)))float;
using u32x4=__attribute__((ext_vector_type(4)))unsigned;
constexpr int BATCH=8,SEQ=2048,D=64,DM=1024;
constexpr int NW=8,QBLK=32,QB=QBLK*NW,KVBLK=64,NQB=SEQ/QB;
constexpr int ATTN_PITCH=DM, ATTN_UNIT_ROWS=QB;
__device__ __forceinline__ int crow(int r,int hi){return (r&3)+8*(r>>2)+4*hi;}
#define SBAR() __builtin_amdgcn_sched_barrier(0)
__device__ __forceinline__ void cmask(f32x16&p0,f32x16&p1,int jb,int qrel,int hi){
  const float NEG=-INFINITY; int kb=64*jb+4*hi;
  #pragma unroll
  for(int r=0;r<16;++r){int kv=kb+(r&3)+8*(r>>2); if(kv>qrel)p0[r]=NEG; if(kv+32>qrel)p1[r]=NEG;}
}

constexpr int NSLOT=3, SLOTB=8192;
constexpr int LDS_K=0, LDS_V=NSLOT*SLOTB, LDS_WS=2*NSLOT*SLOTB, LDS_OST=LDS_WS+NW*64*4, LDS_BYTES=LDS_OST+NW*4096;
constexpr float C2=0.125f*1.4426950408889634f;
__device__ __forceinline__ void glds16(const void*gsrc,unsigned lds_dst){unsigned keep;
  asm volatile("s_mov_b32 %0, m0\n\ts_mov_b32 m0, %2\n\ts_nop 0\n\tglobal_load_lds_dwordx4 %1, off\n\ts_mov_b32 m0, %0":"=&s"(keep):"v"(gsrc),"s"(lds_dst):"memory");}
__device__ __forceinline__ float max3f(float a,float b,float c){float r;asm("v_max3_f32 %0, %1, %2, %3":"=v"(r):"v"(a),"v"(b),"v"(c));return r;}
__device__ __forceinline__ float max2f(float a,float b){float r;asm("v_max_f32_e32 %0, %1, %2":"=v"(r):"v"(a),"v"(b));return r;}
__device__ __forceinline__ float fadd_s(float a,float b){float r;asm("v_add_f32_e32 %0, %1, %2":"=v"(r):"v"(a),"v"(b));return r;}
__device__ __forceinline__ float fsub_s(float a,float b){float r;asm("v_sub_f32_e32 %0, %1, %2":"=v"(r):"v"(a),"v"(b));return r;}
typedef float f32x2_t __attribute__((ext_vector_type(2))); typedef __bf16 bf16x2_t __attribute__((ext_vector_type(2)));
__device__ __forceinline__ unsigned cvtpk_s(float lo,float hi){f32x2_t v={lo,hi};bf16x2_t b=__builtin_convertvector(v,bf16x2_t);return __builtin_bit_cast(unsigned,b);}
#define WAIT_BAR(N) asm volatile("s_waitcnt vmcnt(" #N ") lgkmcnt(0)\n\ts_barrier":::"memory")

__device__ __forceinline__ void qkt(f32x16&p0,f32x16&p1,const char*Kslot,const bf16x8*qr,const f32x16&negm,int r32,int hi){
  const char*kb=Kslot+hi*1024+r32*16;
  #pragma unroll
  for(int d0=0;d0<4;++d0){
    const bf16x8 b0=*reinterpret_cast<const bf16x8*>(kb+d0*2048);
    const bf16x8 b1=*reinterpret_cast<const bf16x8*>(kb+d0*2048+512);
    if(d0==0){p0=__builtin_amdgcn_mfma_f32_32x32x16_bf16(b0,qr[0],negm,0,0,0);p1=__builtin_amdgcn_mfma_f32_32x32x16_bf16(b1,qr[0],negm,0,0,0);}
    else{p0=__builtin_amdgcn_mfma_f32_32x32x16_bf16(b0,qr[d0],p0,0,0,0);p1=__builtin_amdgcn_mfma_f32_32x32x16_bf16(b1,qr[d0],p1,0,0,0);}}
}
typedef __attribute__((address_space(3))) const char* lds_cptr;
typedef short v4i16_t __attribute__((ext_vector_type(4)));
__device__ __forceinline__ void kload8(bf16x8*kf,lds_cptr kp){
  kf[0]=*(const __attribute__((address_space(3))) bf16x8*)(kp);      kf[1]=*(const __attribute__((address_space(3))) bf16x8*)(kp+512);
  kf[2]=*(const __attribute__((address_space(3))) bf16x8*)(kp+2048); kf[3]=*(const __attribute__((address_space(3))) bf16x8*)(kp+2560);
  kf[4]=*(const __attribute__((address_space(3))) bf16x8*)(kp+4096); kf[5]=*(const __attribute__((address_space(3))) bf16x8*)(kp+4608);
  kf[6]=*(const __attribute__((address_space(3))) bf16x8*)(kp+6144); kf[7]=*(const __attribute__((address_space(3))) bf16x8*)(kp+6656);
}
__device__ __forceinline__ void kload2(bf16x8*kf,lds_cptr kp,int j){ kf[2*j]=*(const __attribute__((address_space(3))) bf16x8*)(kp+j*2048); kf[2*j+1]=*(const __attribute__((address_space(3))) bf16x8*)(kp+j*2048+512); }
__device__ __forceinline__ s16x4 vtr(lds_cptr p){ return __builtin_bit_cast(s16x4,__builtin_amdgcn_ds_read_tr16_b64_v4i16((__attribute__((address_space(3))) v4i16_t*)p)); }
__device__ __forceinline__ float rowmax(const f32x16&p0,const f32x16&p1){
  float a=max3f(p0[0],p0[1],p1[0]),b=max3f(p0[2],p0[3],p1[1]);a=max3f(a,p1[2],p1[3]);
  #pragma unroll
  for(int r=4;r<16;r+=4){a=max3f(a,p0[r],p0[r+1]);b=max3f(b,p0[r+2],p0[r+3]);a=max3f(a,p1[r],p1[r+1]);b=max3f(b,p1[r+2],p1[r+3]);}
  const float m=max2f(a,b);
  auto rr=__builtin_amdgcn_permlane32_swap(__float_as_uint(m),__float_as_uint(m),false,false);
  return max2f(__uint_as_float(rr[0]),__uint_as_float(rr[1]));
}
__device__ __forceinline__ void pv(f32x16*o,int vb,bf16x8 pa0,bf16x8 pa1,bf16x8 pa2,bf16x8 pa3){
  #pragma unroll
  for(int d0=0;d0<2;++d0){s16x4 lo[4],hi[4];
    #pragma unroll
    for(int ks=0;ks<4;++ks){
      asm volatile("ds_read_b64_tr_b16 %0,%1 offset:%c2":"=&v"(lo[ks]):"v"(vb),"i"(d0*4096+ks*1024):"memory");
      asm volatile("ds_read_b64_tr_b16 %0,%1 offset:%c2":"=&v"(hi[ks]):"v"(vb),"i"(d0*4096+ks*1024+512):"memory");}
    asm volatile("s_waitcnt lgkmcnt(0)":::"memory");SBAR();
    #define PK(k) (bf16x8){lo[k][0],lo[k][1],lo[k][2],lo[k][3],hi[k][0],hi[k][1],hi[k][2],hi[k][3]}
    o[d0]=__builtin_amdgcn_mfma_f32_32x32x16_bf16(pa0,PK(0),o[d0],0,0,0);
    o[d0]=__builtin_amdgcn_mfma_f32_32x32x16_bf16(pa1,PK(1),o[d0],0,0,0);
    o[d0]=__builtin_amdgcn_mfma_f32_32x32x16_bf16(pa2,PK(2),o[d0],0,0,0);
    o[d0]=__builtin_amdgcn_mfma_f32_32x32x16_bf16(pa3,PK(3),o[d0],0,0,0);
    #undef PK
  }
}

#ifndef ATTN_STORE16
#define ATTN_STORE16(p,v) (*(u32x4*)(p)=(v))
#endif
template<int THRL> __device__ __forceinline__ void attn_unit(int b,int qb,const bf16*Q,const bf16*__restrict__ K,const bf16*__restrict__ V,bf16*O,char*shm){
  int tid_=threadIdx.x; asm volatile("":"+v"(tid_));
  const int tid=tid_,lane=tid&63,r32=lane&31,hi=lane>>5; const int wid=__builtin_amdgcn_readfirstlane(tid>>6);
  const long rowbase=(long)b*SEQ; const int q0=qb*QB;
  const bf16*Qw=Q+(rowbase+q0+wid*QBLK)*DM;
  const bf16*Kh=K+rowbase*DM,*Vh=V+rowbase*DM;
  const unsigned lds0=(unsigned)(uintptr_t)shm;
  float*wsf=(float*)(shm+LDS_WS)+wid*64;
  const bf16*ksrc=Kh+(long)lane*DM+wid*8;
  const bf16*vsrc=Vh+(long)(16*(wid&3)+(lane>>2))*DM+(wid>>2)*32+(lane&3)*8;
  const unsigned kdst=lds0+LDS_K+wid*1024, vdst=lds0+LDS_V+wid*1024;
  #define DMA_K(t,slot) glds16(ksrc+(long)(t)*KVBLK*DM,(unsigned)__builtin_amdgcn_readfirstlane(kdst+(slot)))
  #define DMA_V(t,slot) glds16(vsrc+(long)(t)*KVBLK*DM,(unsigned)__builtin_amdgcn_readfirstlane(vdst+(slot)))
  const int vb0=(int)(lds0+LDS_V)+((lane>>4)&1)*32+(lane&3)*8+(4*hi+((lane&15)>>2))*64;
  const char*Kbase=shm+LDS_K; bf16x8 kf[8];
  const lds_cptr shm3=(lds_cptr)shm; const lds_cptr kp0=shm3+LDS_K+hi*1024+r32*16; const lds_cptr vp0=shm3+LDS_V+((lane>>4)&1)*32+(lane&3)*8+(4*hi+((lane&15)>>2))*64;
  const int NT=(q0+QB)/KVBLK;
  DMA_K(0,0);DMA_V(0,0);DMA_K(1,SLOTB);
  bf16x8 qr[4];
  #pragma unroll
  for(int d0=0;d0<4;++d0)qr[d0]=*reinterpret_cast<const bf16x8*>(&Qw[(long)r32*DM+d0*16+hi*8]);
  float zz_=0.f; asm volatile("":"+v"(zz_)); const f32x16 zv_={zz_,zz_,zz_,zz_,zz_,zz_,zz_,zz_,zz_,zz_,zz_,zz_,zz_,zz_,zz_,zz_};
  float mhat=zz_,l_reg=zz_;f32x16 o[2];o[0]=zv_;o[1]=zv_;f32x16 negm=zv_;asm volatile("":"+v"(negm));
  const int qrel=wid*QBLK+r32;
  #define CMASK(P0,P1,t) do{int jb_=(t)-(NT-4); if(jb_>=0)cmask(P0,P1,jb_,qrel,hi);}while(0)
  bool resc=false;
  #define START(P0,P1) do{ const float rm=rowmax(P0,P1); resc=false; \
    { const float dl=rm; mhat=fadd_s(mhat,dl); \
      _Pragma("unroll") for(int r=0;r<16;++r){P0[r]=fsub_s(P0[r],dl);P1[r]=fsub_s(P1[r],dl);} \
      _Pragma("unroll") for(int r=0;r<16;++r)negm[r]=-mhat; asm volatile("":"+v"(negm)); } \
    _Pragma("unroll") for(int r=0;r<16;++r)P0[r]=__builtin_amdgcn_exp2f(P0[r]); }while(0)
  #define RESC() do{ if(resc){ asm volatile("s_waitcnt lgkmcnt(0)":::"memory"); \
      _Pragma("unroll") for(int d_=0;d_<2;++d_) _Pragma("unroll") for(int r=0;r<16;++r)o[d_][r]*=wsf[crow(r,hi)]; } }while(0)
  f32x16 pA0,pA1,pB0,pB1;
  int sl_prev=0,sl_cur=0,sl_next=SLOTB;
  #define ROT() do{sl_prev=sl_cur;sl_cur=sl_next;sl_next=(sl_next==(NSLOT-1)*SLOTB)?0:sl_next+SLOTB;}while(0)
  DMA_K(2,2*SLOTB);
  WAIT_BAR(3);
  qkt(pA0,pA1,Kbase,qr,negm,r32,hi);asm volatile("s_nop 15\n\ts_nop 7":"+v"(pA0),"+v"(pA1));CMASK(pA0,pA1,0);
  START(pA0,pA1);
  _Pragma("unroll") for(int r=0;r<16;++r)pA1[r]=__builtin_amdgcn_exp2f(pA1[r]);
  WAIT_BAR(0);
  DMA_K(3,0);DMA_V(1,SLOTB);
  ROT();
  kload8(kf,kp0+sl_cur);
  WAIT_BAR(2);
  s16x4 vlo[8],vhi[8]; u32x4 pw0,pw1,pw2,pw3;
  #define PKW(P,B) cvtpk_s(P[B],P[B+1])
  #define PAF(k) __builtin_bit_cast(bf16x8,pw##k)
  #define VFR(i) (bf16x8){vlo[i][0],vlo[i][1],vlo[i][2],vlo[i][3],vhi[i][0],vhi[i][1],vhi[i][2],vhi[i][3]}
  #define PIN(x) asm volatile("":"+v"(x))
  #define MX3(a,b,c) __builtin_fmaxf(__builtin_fmaxf((a),(b)),(c))
  #define GAPA(MF,A0,A1,A2,A3,W0,W1,PW) do{ MF; sacc+=A0; sacc+=A1; sacc+=A2; sacc+=A3; PIN(sacc); W0; W1; PIN(PW); SBAR(); }while(0)
  #define EX(v) __builtin_amdgcn_exp2f(v)
  #define GAPB(MF,X,B) do{ MF; X[B]=EX(X[B]); X[B+1]=EX(X[B+1]); X[B+2]=EX(X[B+2]); X[B+3]=EX(X[B+3]); PIN(X); SBAR(); }while(0)
  #define VRD(i) do{ vlo[i]=vtr(vp_+(((i)>>2)*4096+((i)&3)*1024)); vhi[i]=vtr(vp_+(((i)>>2)*4096+((i)&3)*1024+512)); }while(0)
  #define KRD(G,j) do{ if(G){ kload2(kf,kp0+sl_next,j); SBAR(); } }while(0)
  #define STEP(C0,C1,P0,P1,t,GK,GV,GL) do{ SBAR(); \
    const lds_cptr vp_=vp0+sl_prev; \
    VRD(0); SBAR(); float sacc=(P0[0]+P0[1]); \
    GAPA(C0=__builtin_amdgcn_mfma_f32_32x32x16_bf16(kf[0],qr[0],negm,0,0,0), P0[2],P0[3],P0[4],P0[5],     pw0[0]=PKW(P0,0), pw0[1]=PKW(P0,2), pw0); \
    VRD(4); SBAR(); GAPA(C1=__builtin_amdgcn_mfma_f32_32x32x16_bf16(kf[1],qr[0],negm,0,0,0), P0[6],P0[7],P0[8],P0[9],     pw0[2]=PKW(P0,4), pw0[3]=PKW(P0,6), pw0); \
    VRD(1); SBAR(); GAPA(C0=__builtin_amdgcn_mfma_f32_32x32x16_bf16(kf[2],qr[1],C0,0,0,0),   P0[10],P0[11],P0[12],P0[13], pw1[0]=PKW(P0,8), pw1[1]=PKW(P0,10), pw1); \
    VRD(5); SBAR(); GAPA(C1=__builtin_amdgcn_mfma_f32_32x32x16_bf16(kf[3],qr[1],C1,0,0,0),   P0[14],P0[15],P1[0],P1[1],   pw1[2]=PKW(P0,12),pw1[3]=PKW(P0,14), pw1); \
    VRD(2); SBAR(); GAPA(C0=__builtin_amdgcn_mfma_f32_32x32x16_bf16(kf[4],qr[2],C0,0,0,0),   P1[2],P1[3],P1[4],P1[5],     pw2[0]=PKW(P1,0), pw2[1]=PKW(P1,2), pw2); \
    VRD(6); SBAR(); GAPA(C1=__builtin_amdgcn_mfma_f32_32x32x16_bf16(kf[5],qr[2],C1,0,0,0),   P1[6],P1[7],P1[8],P1[9],     pw2[2]=PKW(P1,4), pw2[3]=PKW(P1,6), pw2); \
    VRD(3); SBAR(); GAPA(C0=__builtin_amdgcn_mfma_f32_32x32x16_bf16(kf[6],qr[3],C0,0,0,0),   P1[10],P1[11],P1[12],P1[13], pw3[0]=PKW(P1,8), pw3[1]=PKW(P1,10), pw3); \
    VRD(7); SBAR(); GAPA(C1=__builtin_amdgcn_mfma_f32_32x32x16_bf16(kf[7],qr[3],C1,0,0,0),   P1[14],P1[15],0.f,0.f,       pw3[2]=PKW(P1,12),pw3[3]=PKW(P1,14), pw3); \
    l_reg+=sacc; \
    if(GK){DMA_K((t)+3,sl_cur);} if(GV){DMA_V((t)+1,sl_next);} \
    CMASK(C0,C1,t); \
    { float a=MX3(C0[0],C0[1],C1[0]),b=MX3(C0[2],C0[3],C1[1]); a=MX3(a,C1[2],C1[3]); \
      _Pragma("unroll") for(int r=4;r<16;r+=4){a=MX3(a,C0[r],C0[r+1]);b=MX3(b,C0[r+2],C0[r+3]);a=MX3(a,C1[r],C1[r+1]);b=MX3(b,C1[r+2],C1[r+3]);} \
      float rm=__builtin_fmaxf(a,b); { auto rr=__builtin_amdgcn_permlane32_swap(__float_as_uint(rm),__float_as_uint(rm),false,false); rm=__builtin_fmaxf(__uint_as_float(rr[0]),__uint_as_float(rr[1])); } \
      resc=false; \
      if(__builtin_expect(__any(rm>(float)THRL),0)){ const float dl=__builtin_fmaxf(rm,0.f); mhat+=dl; \
        _Pragma("unroll") for(int r=0;r<16;++r){C0[r]-=dl;C1[r]-=dl;} \
        _Pragma("unroll") for(int r=0;r<16;++r)negm[r]=-mhat; asm volatile("":"+v"(negm)); \
        const float f=__builtin_amdgcn_exp2f(-dl); l_reg*=f; if(hi==0)wsf[r32]=f; resc=true; } } \
    SBAR(); \
    GAPB(o[0]=__builtin_amdgcn_mfma_f32_32x32x16_bf16(PAF(0),VFR(0),o[0],0,0,0), C0,0); \
    GAPB(o[1]=__builtin_amdgcn_mfma_f32_32x32x16_bf16(PAF(0),VFR(4),o[1],0,0,0), C0,4); \
    KRD(GL,0); GAPB(o[0]=__builtin_amdgcn_mfma_f32_32x32x16_bf16(PAF(1),VFR(1),o[0],0,0,0), C0,8); \
    KRD(GL,1); GAPB(o[1]=__builtin_amdgcn_mfma_f32_32x32x16_bf16(PAF(1),VFR(5),o[1],0,0,0), C0,12); \
    KRD(GL,2); GAPB(o[0]=__builtin_amdgcn_mfma_f32_32x32x16_bf16(PAF(2),VFR(2),o[0],0,0,0), C1,0); \
    KRD(GL,3); GAPB(o[1]=__builtin_amdgcn_mfma_f32_32x32x16_bf16(PAF(2),VFR(6),o[1],0,0,0), C1,4); \
    GAPB(o[0]=__builtin_amdgcn_mfma_f32_32x32x16_bf16(PAF(3),VFR(3),o[0],0,0,0), C1,8); \
    GAPB(o[1]=__builtin_amdgcn_mfma_f32_32x32x16_bf16(PAF(3),VFR(7),o[1],0,0,0), C1,12); \
    }while(0)
  int t=1;
  #undef CMASK
  #define CMASK(P0,P1,t) do{}while(0)
  for(;t+5<NT;t+=2){
    STEP(pB0,pB1,pA0,pA1,t,true,true,true);     WAIT_BAR(2); RESC(); ROT();
    STEP(pA0,pA1,pB0,pB1,t+1,true,true,true);   WAIT_BAR(2); RESC(); ROT();
  }
  #undef CMASK
  #define CMASK(P0,P1,t) do{int jb_=(t)-(NT-4); if(jb_>=0)cmask(P0,P1,jb_,qrel,hi);}while(0)
  #define ENDW(tt) do{ if((tt)+3<NT){WAIT_BAR(2);} else if((tt)+2<NT){WAIT_BAR(1);} else {WAIT_BAR(0);} }while(0)
  for(;t+1<NT;t+=2){
    STEP(pB0,pB1,pA0,pA1,t,(t+3<NT),(t+1<NT),(t+1<NT));       ENDW(t);   RESC(); ROT();
    STEP(pA0,pA1,pB0,pB1,t+1,(t+4<NT),(t+2<NT),(t+2<NT));     ENDW(t+1); RESC(); ROT();
  }
  STEP(pB0,pB1,pA0,pA1,NT-1,false,false,false); RESC();
  { float sacc=pB0[0]+pB0[1]; _Pragma("unroll") for(int r=2;r<16;++r)sacc+=pB0[r]; _Pragma("unroll") for(int r=0;r<16;++r)sacc+=pB1[r]; l_reg+=sacc;
    pw0=(u32x4){PKW(pB0,0),PKW(pB0,2),PKW(pB0,4),PKW(pB0,6)};pw1=(u32x4){PKW(pB0,8),PKW(pB0,10),PKW(pB0,12),PKW(pB0,14)};pw2=(u32x4){PKW(pB1,0),PKW(pB1,2),PKW(pB1,4),PKW(pB1,6)};pw3=(u32x4){PKW(pB1,8),PKW(pB1,10),PKW(pB1,12),PKW(pB1,14)};
    SBAR(); pv(o,vb0+sl_cur,PAF(0),PAF(1),PAF(2),PAF(3)); }
  #undef PKW
  #undef PAF
  #undef VFR
  #undef PIN
  #undef MX3
  #undef GAPA
  #undef GAPB
  #undef EX
  #undef VRD
  #undef KRD
  #undef STEP
  #undef ENDW
  {auto rr=__builtin_amdgcn_permlane32_swap(__float_as_uint(l_reg),__float_as_uint(l_reg),false,false);l_reg=__uint_as_float(rr[0])+__uint_as_float(rr[1]);}
  if(hi==0)wsf[32+r32]=l_reg;asm volatile("s_waitcnt lgkmcnt(0)":::"memory");
  float rli[16];
  #pragma unroll
  for(int r=0;r<16;++r)rli[r]=__builtin_amdgcn_rcpf(wsf[32+crow(r,hi)]);
  bf16*Ow=O+(rowbase+q0+wid*QBLK)*DM;
  { bf16*stg=(bf16*)(shm+LDS_OST)+wid*2048;
    #pragma unroll
    for(int r=0;r<16;++r){const int orow=crow(r,hi);
      #pragma unroll
      for(int d0=0;d0<2;++d0)stg[orow*64+d0*32+r32]=__float2bfloat16(o[d0][r]*rli[r]);}
    asm volatile("s_waitcnt lgkmcnt(0)":::"memory");
    #pragma unroll
    for(int i=0;i<4;++i){const int row=i*8+(lane>>3),ch=lane&7; const u32x4 v=*(const u32x4*)(stg+row*64+ch*8); ATTN_STORE16(Ow+(long)row*DM+ch*8,v);} }
  asm volatile("s_waitcnt lgkmcnt(0)\n\ts_barrier":::"memory");
  #undef DMA_K
  #undef DMA_V
  #undef CMASK
  #undef START
  #undef RESC
  #undef ROT
}
__device__ __forceinline__ void pv4(f32x16*o,int vb,bf16x8 pa0,bf16x8 pa1,bf16x8 pa2,bf16x8 pa3){
  #pragma unroll
  for(int d0=0;d0<4;++d0){s16x4 lo[4],hi[4];
    #pragma unroll
    for(int ks=0;ks<4;++ks){
      asm volatile("ds_read_b64_tr_b16 %0,%1 offset:%c2":"=&v"(lo[ks]):"v"(vb),"i"(d0*4096+ks*1024):"memory");
      asm volatile("ds_read_b64_tr_b16 %0,%1 offset:%c2":"=&v"(hi[ks]):"v"(vb),"i"(d0*4096+ks*1024+512):"memory");}
    asm volatile("s_waitcnt lgkmcnt(0)":::"memory");SBAR();
    #define PK(k) (bf16x8){lo[k][0],lo[k][1],lo[k][2],lo[k][3],hi[k][0],hi[k][1],hi[k][2],hi[k][3]}
    o[d0]=__builtin_amdgcn_mfma_f32_32x32x16_bf16(pa0,PK(0),o[d0],0,0,0);
    o[d0]=__builtin_amdgcn_mfma_f32_32x32x16_bf16(pa1,PK(1),o[d0],0,0,0);
    o[d0]=__builtin_amdgcn_mfma_f32_32x32x16_bf16(pa2,PK(2),o[d0],0,0,0);
    o[d0]=__builtin_amdgcn_mfma_f32_32x32x16_bf16(pa3,PK(3),o[d0],0,0,0);
    #undef PK
  }
}

template<int THRL,bool FUSE> __device__ __forceinline__ void attn_unit128(int b,int qb,const bf16*Q,const bf16*__restrict__ K,const bf16*__restrict__ V,bf16*O,char*shm,bf16*ON=nullptr,const float*subg=nullptr,float lam=0.f,float oscale=1.f,float eps=0.f){
  int tid_=threadIdx.x; asm volatile("":"+v"(tid_));
  const int tid=tid_,lane=tid&63,r32=lane&31,hi=lane>>5; const int wid=__builtin_amdgcn_readfirstlane(tid>>6);
  const long rowbase=(long)b*SEQ; const int q0=qb*QB;
  const bf16*Qw=Q+(rowbase+q0+wid*QBLK)*DM;
  const bf16*Kh=K+rowbase*DM,*Vh=V+rowbase*DM;
  const unsigned lds0=(unsigned)(uintptr_t)shm;
  constexpr int LDS_V2=NSLOT*SLOTB, VSLOT=2*SLOTB, LDS_WS2=LDS_V2+NSLOT*VSLOT, LDS_OST2=LDS_WS2+NW*64*4;
  float*wsf=(float*)(shm+LDS_WS2)+wid*64;
  const bf16*ksrc=Kh+(long)lane*DM+wid*8;
  const bf16*vsrc=Vh+(long)(16*(wid&3)+(lane>>2))*DM+(wid>>2)*32+(lane&3)*8;
  const unsigned kdst=lds0+LDS_K+wid*1024, vdst=lds0+LDS_V2+wid*1024;
  #define DMA_K(t,slot) glds16(ksrc+(long)(t)*KVBLK*DM,(unsigned)__builtin_amdgcn_readfirstlane(kdst+(slot)))
  #define DMA_V(t,slot) do{ glds16(vsrc+(long)(t)*KVBLK*DM,(unsigned)__builtin_amdgcn_readfirstlane(vdst+2*(slot))); glds16(vsrc+(long)(t)*KVBLK*DM+64,(unsigned)__builtin_amdgcn_readfirstlane(vdst+2*(slot)+8192)); }while(0)
  const int vb0=(int)(lds0+LDS_V2)+((lane>>4)&1)*32+(lane&3)*8+(4*hi+((lane&15)>>2))*64;
  const char*Kbase=shm+LDS_K; bf16x8 kf[8];
  const lds_cptr shm3=(lds_cptr)shm; const lds_cptr kp0=shm3+LDS_K+hi*1024+r32*16; const lds_cptr vp0=shm3+LDS_V2+((lane>>4)&1)*32+(lane&3)*8+(4*hi+((lane&15)>>2))*64;
  const int NT=(q0+QB)/KVBLK;
  DMA_K(0,0);DMA_V(0,0);DMA_K(1,SLOTB);
  bf16x8 qr[4];
  #pragma unroll
  for(int d0=0;d0<4;++d0)qr[d0]=*reinterpret_cast<const bf16x8*>(&Qw[(long)r32*DM+d0*16+hi*8]);
  float zz_=0.f; asm volatile("":"+v"(zz_)); const f32x16 zv_={zz_,zz_,zz_,zz_,zz_,zz_,zz_,zz_,zz_,zz_,zz_,zz_,zz_,zz_,zz_,zz_};
  float mhat=zz_,l_reg=zz_;f32x16 o[4];o[0]=zv_;o[1]=zv_;o[2]=zv_;o[3]=zv_;f32x16 negm=zv_;asm volatile("":"+v"(negm));
  const int qrel=wid*QBLK+r32;
  #define CMASK(P0,P1,t) do{int jb_=(t)-(NT-4); if(jb_>=0)cmask(P0,P1,jb_,qrel,hi);}while(0)
  bool resc=false;
  #define START(P0,P1) do{ const float rm=rowmax(P0,P1); resc=false; \
    { const float dl=rm; mhat=fadd_s(mhat,dl); \
      _Pragma("unroll") for(int r=0;r<16;++r){P0[r]=fsub_s(P0[r],dl);P1[r]=fsub_s(P1[r],dl);} \
      _Pragma("unroll") for(int r=0;r<16;++r)negm[r]=-mhat; asm volatile("":"+v"(negm)); } \
    _Pragma("unroll") for(int r=0;r<16;++r)P0[r]=__builtin_amdgcn_exp2f(P0[r]); }while(0)
  #define RESC() do{ if(resc){ asm volatile("s_waitcnt lgkmcnt(0)":::"memory"); \
      _Pragma("unroll") for(int d_=0;d_<4;++d_) _Pragma("unroll") for(int r=0;r<16;++r)o[d_][r]*=wsf[crow(r,hi)]; } }while(0)
  f32x16 pA0,pA1,pB0,pB1;
  int sl_prev=0,sl_cur=0,sl_next=SLOTB;
  #define ROT() do{sl_prev=sl_cur;sl_cur=sl_next;sl_next=(sl_next==(NSLOT-1)*SLOTB)?0:sl_next+SLOTB;}while(0)
  DMA_K(2,2*SLOTB);
  WAIT_BAR(4);
  qkt(pA0,pA1,Kbase,qr,negm,r32,hi);asm volatile("s_nop 15\n\ts_nop 7":"+v"(pA0),"+v"(pA1));CMASK(pA0,pA1,0);
  START(pA0,pA1);
  _Pragma("unroll") for(int r=0;r<16;++r)pA1[r]=__builtin_amdgcn_exp2f(pA1[r]);
  WAIT_BAR(0);
  DMA_K(3,0);DMA_V(1,SLOTB);
  ROT();
  kload8(kf,kp0+sl_cur);
  WAIT_BAR(3);
  s16x4 vlo[8],vhi[8]; u32x4 pw0,pw1,pw2,pw3;
  #define PKW(P,B) cvtpk_s(P[B],P[B+1])
  #define PAF(k) __builtin_bit_cast(bf16x8,pw##k)
  #define VFR(s) (bf16x8){vlo[s][0],vlo[s][1],vlo[s][2],vlo[s][3],vhi[s][0],vhi[s][1],vhi[s][2],vhi[s][3]}
  #define PIN(x) asm volatile("":"+v"(x))
  #define MX3(a,b,c) __builtin_fmaxf(__builtin_fmaxf((a),(b)),(c))
  #define GAPA(MF,A0,A1,A2,A3,W0,W1,PW) do{ MF; sacc+=A0; sacc+=A1; sacc+=A2; sacc+=A3; PIN(sacc); W0; W1; PIN(PW); SBAR(); }while(0)
  #define EX(v) __builtin_amdgcn_exp2f(v)
  #define GAPB(MF,X,B) do{ MF; X[B]=EX(X[B]); X[B+1]=EX(X[B+1]); PIN(X); SBAR(); }while(0)
  #define VRD(s,f) do{ vlo[s]=vtr(vp_+(((f)>>2)*4096+((f)&3)*1024)); vhi[s]=vtr(vp_+(((f)>>2)*4096+((f)&3)*1024+512)); }while(0)
  #define KRD(G,j) do{ if(G){ kload2(kf,kp0+sl_next,j); SBAR(); } }while(0)
  #define STEP(C0,C1,P0,P1,t,GK,GV,GL) do{ SBAR(); \
    const lds_cptr vp_=vp0+2*sl_prev; \
    VRD(0,0); SBAR(); float sacc=(P0[0]+P0[1]); \
    GAPA(C0=__builtin_amdgcn_mfma_f32_32x32x16_bf16(kf[0],qr[0],negm,0,0,0), P0[2],P0[3],P0[4],P0[5],     pw0[0]=PKW(P0,0), pw0[1]=PKW(P0,2), pw0); \
    VRD(1,4); SBAR(); GAPA(C1=__builtin_amdgcn_mfma_f32_32x32x16_bf16(kf[1],qr[0],negm,0,0,0), P0[6],P0[7],P0[8],P0[9],     pw0[2]=PKW(P0,4), pw0[3]=PKW(P0,6), pw0); \
    VRD(2,8); SBAR(); GAPA(C0=__builtin_amdgcn_mfma_f32_32x32x16_bf16(kf[2],qr[1],C0,0,0,0),   P0[10],P0[11],P0[12],P0[13], pw1[0]=PKW(P0,8), pw1[1]=PKW(P0,10), pw1); \
    VRD(3,12); SBAR(); GAPA(C1=__builtin_amdgcn_mfma_f32_32x32x16_bf16(kf[3],qr[1],C1,0,0,0),   P0[14],P0[15],P1[0],P1[1],   pw1[2]=PKW(P0,12),pw1[3]=PKW(P0,14), pw1); \
    VRD(4,1); SBAR(); GAPA(C0=__builtin_amdgcn_mfma_f32_32x32x16_bf16(kf[4],qr[2],C0,0,0,0),   P1[2],P1[3],P1[4],P1[5],     pw2[0]=PKW(P1,0), pw2[1]=PKW(P1,2), pw2); \
    VRD(5,5); SBAR(); GAPA(C1=__builtin_amdgcn_mfma_f32_32x32x16_bf16(kf[5],qr[2],C1,0,0,0),   P1[6],P1[7],P1[8],P1[9],     pw2[2]=PKW(P1,4), pw2[3]=PKW(P1,6), pw2); \
    VRD(6,9); SBAR(); GAPA(C0=__builtin_amdgcn_mfma_f32_32x32x16_bf16(kf[6],qr[3],C0,0,0,0),   P1[10],P1[11],P1[12],P1[13], pw3[0]=PKW(P1,8), pw3[1]=PKW(P1,10), pw3); \
    VRD(7,13); SBAR(); GAPA(C1=__builtin_amdgcn_mfma_f32_32x32x16_bf16(kf[7],qr[3],C1,0,0,0),   P1[14],P1[15],0.f,0.f,       pw3[2]=PKW(P1,12),pw3[3]=PKW(P1,14), pw3); \
    l_reg+=sacc; \
    if(GK){DMA_K((t)+3,sl_cur);} if(GV){DMA_V((t)+1,sl_next);} \
    CMASK(C0,C1,t); \
    { float a=MX3(C0[0],C0[1],C1[0]),b=MX3(C0[2],C0[3],C1[1]); a=MX3(a,C1[2],C1[3]); \
      _Pragma("unroll") for(int r=4;r<16;r+=4){a=MX3(a,C0[r],C0[r+1]);b=MX3(b,C0[r+2],C0[r+3]);a=MX3(a,C1[r],C1[r+1]);b=MX3(b,C1[r+2],C1[r+3]);} \
      float rm=__builtin_fmaxf(a,b); { auto rr=__builtin_amdgcn_permlane32_swap(__float_as_uint(rm),__float_as_uint(rm),false,false); rm=__builtin_fmaxf(__uint_as_float(rr[0]),__uint_as_float(rr[1])); } \
      resc=false; \
      if(__builtin_expect(__any(rm>(float)THRL),0)){ const float dl=__builtin_fmaxf(rm,0.f); mhat+=dl; \
        _Pragma("unroll") for(int r=0;r<16;++r){C0[r]-=dl;C1[r]-=dl;} \
        _Pragma("unroll") for(int r=0;r<16;++r)negm[r]=-mhat; asm volatile("":"+v"(negm)); \
        const float f=__builtin_amdgcn_exp2f(-dl); l_reg*=f; if(hi==0)wsf[r32]=f; resc=true; } } \
    SBAR(); \
    GAPB(o[0]=__builtin_amdgcn_mfma_f32_32x32x16_bf16(PAF(0),VFR(0),o[0],0,0,0), C0,0); VRD(0,2); SBAR(); \
    GAPB(o[1]=__builtin_amdgcn_mfma_f32_32x32x16_bf16(PAF(0),VFR(1),o[1],0,0,0), C0,2); VRD(1,6); SBAR(); \
    GAPB(o[2]=__builtin_amdgcn_mfma_f32_32x32x16_bf16(PAF(0),VFR(2),o[2],0,0,0), C0,4); VRD(2,10); SBAR(); \
    GAPB(o[3]=__builtin_amdgcn_mfma_f32_32x32x16_bf16(PAF(0),VFR(3),o[3],0,0,0), C0,6); VRD(3,14); SBAR(); \
    GAPB(o[0]=__builtin_amdgcn_mfma_f32_32x32x16_bf16(PAF(1),VFR(4),o[0],0,0,0), C0,8); VRD(4,3); SBAR(); \
    GAPB(o[1]=__builtin_amdgcn_mfma_f32_32x32x16_bf16(PAF(1),VFR(5),o[1],0,0,0), C0,10); VRD(5,7); SBAR(); \
    GAPB(o[2]=__builtin_amdgcn_mfma_f32_32x32x16_bf16(PAF(1),VFR(6),o[2],0,0,0), C0,12); VRD(6,11); SBAR(); \
    GAPB(o[3]=__builtin_amdgcn_mfma_f32_32x32x16_bf16(PAF(1),VFR(7),o[3],0,0,0), C0,14); VRD(7,15); SBAR(); \
    KRD(GL,0); GAPB(o[0]=__builtin_amdgcn_mfma_f32_32x32x16_bf16(PAF(2),VFR(0),o[0],0,0,0), C1,0); \
    KRD(GL,1); GAPB(o[1]=__builtin_amdgcn_mfma_f32_32x32x16_bf16(PAF(2),VFR(1),o[1],0,0,0), C1,2); \
    KRD(GL,2); GAPB(o[2]=__builtin_amdgcn_mfma_f32_32x32x16_bf16(PAF(2),VFR(2),o[2],0,0,0), C1,4); \
    KRD(GL,3); GAPB(o[3]=__builtin_amdgcn_mfma_f32_32x32x16_bf16(PAF(2),VFR(3),o[3],0,0,0), C1,6); \
    GAPB(o[0]=__builtin_amdgcn_mfma_f32_32x32x16_bf16(PAF(3),VFR(4),o[0],0,0,0), C1,8); \
    GAPB(o[1]=__builtin_amdgcn_mfma_f32_32x32x16_bf16(PAF(3),VFR(5),o[1],0,0,0), C1,10); \
    GAPB(o[2]=__builtin_amdgcn_mfma_f32_32x32x16_bf16(PAF(3),VFR(6),o[2],0,0,0), C1,12); \
    GAPB(o[3]=__builtin_amdgcn_mfma_f32_32x32x16_bf16(PAF(3),VFR(7),o[3],0,0,0), C1,14); \
    }while(0)
  int t=1;
  #undef CMASK
  #define CMASK(P0,P1,t) do{}while(0)
  for(;t+5<NT;t+=2){
    STEP(pB0,pB1,pA0,pA1,t,true,true,true);     WAIT_BAR(3); RESC(); ROT();
    STEP(pA0,pA1,pB0,pB1,t+1,true,true,true);   WAIT_BAR(3); RESC(); ROT();
  }
  #undef CMASK
  #define CMASK(P0,P1,t) do{int jb_=(t)-(NT-4); if(jb_>=0)cmask(P0,P1,jb_,qrel,hi);}while(0)
  #define ENDW(tt) do{ if((tt)+3<NT){WAIT_BAR(3);} else if((tt)+2<NT){WAIT_BAR(2);} else {WAIT_BAR(0);} }while(0)
  for(;t+1<NT;t+=2){
    STEP(pB0,pB1,pA0,pA1,t,(t+3<NT),(t+1<NT),(t+1<NT));       ENDW(t);   RESC(); ROT();
    STEP(pA0,pA1,pB0,pB1,t+1,(t+4<NT),(t+2<NT),(t+2<NT));     ENDW(t+1); RESC(); ROT();
  }
  STEP(pB0,pB1,pA0,pA1,NT-1,false,false,false); RESC();
  { float sacc=pB0[0]+pB0[1]; _Pragma("unroll") for(int r=2;r<16;++r)sacc+=pB0[r]; _Pragma("unroll") for(int r=0;r<16;++r)sacc+=pB1[r]; l_reg+=sacc;
    pw0=(u32x4){PKW(pB0,0),PKW(pB0,2),PKW(pB0,4),PKW(pB0,6)};pw1=(u32x4){PKW(pB0,8),PKW(pB0,10),PKW(pB0,12),PKW(pB0,14)};pw2=(u32x4){PKW(pB1,0),PKW(pB1,2),PKW(pB1,4),PKW(pB1,6)};pw3=(u32x4){PKW(pB1,8),PKW(pB1,10),PKW(pB1,12),PKW(pB1,14)};
    SBAR(); pv4(o,vb0+2*sl_cur,PAF(0),PAF(1),PAF(2),PAF(3)); }
  #undef PKW
  #undef PAF
  #undef VFR
  #undef PIN
  #undef MX3
  #undef GAPA
  #undef GAPB
  #undef EX
  #undef VRD
  #undef KRD
  #undef STEP
  #undef ENDW
  {auto rr=__builtin_amdgcn_permlane32_swap(__float_as_uint(l_reg),__float_as_uint(l_reg),false,false);l_reg=__uint_as_float(rr[0])+__uint_as_float(rr[1]);}
  if(hi==0)wsf[32+r32]=l_reg;asm volatile("s_waitcnt lgkmcnt(0)":::"memory");
  float rli[16];
  #pragma unroll
  for(int r=0;r<16;++r)rli[r]=__builtin_amdgcn_rcpf(wsf[32+crow(r,hi)]);
  bf16*Ow=O+(rowbase+q0+wid*QBLK)*DM;
  { bf16*stg=(bf16*)(shm+LDS_OST2)+wid*2048;
    float dv[2][4][8]; float ssq[4]={0.f,0.f,0.f,0.f};
    #pragma unroll
    for(int hf=0;hf<2;++hf){
      #pragma unroll
      for(int r=0;r<16;++r){const int orow=crow(r,hi);
        #pragma unroll
        for(int d0=0;d0<2;++d0)stg[orow*64+d0*32+r32]=__float2bfloat16(o[2*hf+d0][r]*rli[r]);}
      asm volatile("s_waitcnt lgkmcnt(0)":::"memory");
      #pragma unroll
      for(int i=0;i<4;++i){const int row=i*8+(lane>>3),ch=lane&7; const u32x4 v=*(const u32x4*)(stg+row*64+ch*8);
        if constexpr(!FUSE){ ATTN_STORE16(Ow+(long)row*DM+hf*64+ch*8,v); }
        else{ const u32x4 v0=*(const u32x4*)(Ow+(long)row*DM+hf*64+ch*8);
          #pragma unroll
          for(int e=0;e<4;++e){ const float a0=__uint_as_float(v0[e]<<16),a1=__uint_as_float(v0[e]&0xffff0000u),b0=__uint_as_float(v[e]<<16),b1=__uint_as_float(v[e]&0xffff0000u);
            const float d0_=a0-lam*b0,d1_=a1-lam*b1; dv[hf][i][2*e]=d0_; dv[hf][i][2*e+1]=d1_; ssq[i]+=d0_*d0_+d1_*d1_; } } }
      asm volatile("s_waitcnt lgkmcnt(0)":::"memory"); }
    if constexpr(FUSE){
      bf16*Nw=ON+(rowbase+q0+wid*QBLK)*DM;
      #pragma unroll
      for(int i=0;i<4;++i){ float s_=ssq[i]; s_+=__shfl_xor(s_,1); s_+=__shfl_xor(s_,2); s_+=__shfl_xor(s_,4); ssq[i]=__builtin_amdgcn_rsqf(s_*(1.f/128.f)+eps)*oscale; }
      #pragma unroll
      for(int hf=0;hf<2;++hf){ const int ch=lane&7; float g_[8];
        #pragma unroll
        for(int e=0;e<8;++e)g_[e]=subg[hf*64+ch*8+e];
        #pragma unroll
        for(int i=0;i<4;++i){const int row=i*8+(lane>>3); u32x4 w;
          #pragma unroll
          for(int e=0;e<4;++e)w[e]=cvtpk_s(dv[hf][i][2*e]*ssq[i]*g_[2*e],dv[hf][i][2*e+1]*ssq[i]*g_[2*e+1]);
          *(u32x4*)(Nw+(long)row*DM+hf*64+ch*8)=w; } } } }
  asm volatile("s_waitcnt lgkmcnt(0)\n\ts_barrier":::"memory");
  #undef DMA_K
  #undef DMA_V
  #undef CMASK
  #undef START
  #undef RESC
  #undef ROT
}
constexpr int ATTN_LDS_BYTES=LDS_BYTES, ATTN128_LDS_BYTES=NSLOT*SLOTB+NSLOT*2*SLOTB+NW*64*4+NW*4096;
#undef SBAR
#undef WAIT_BAR
}
#define GAS __attribute__((address_space(1)))
#define LAS __attribute__((address_space(3)))
typedef unsigned short bf16;
typedef unsigned v4u __attribute__((ext_vector_type(4)));
typedef float f32x4 __attribute__((ext_vector_type(4)));
typedef short bf16x8 __attribute__((ext_vector_type(8)));
typedef GAS unsigned gu32;
typedef GAS unsigned long long gu64;
#define RLX_AGENT __ATOMIC_RELAXED, __HIP_MEMORY_SCOPE_AGENT
#define LDS_WAIT() asm volatile("s_waitcnt lgkmcnt(0)" ::: "memory")
#define VM_WAIT() asm volatile("s_waitcnt vmcnt(0)" ::: "memory")
__device__ __forceinline__ unsigned long long rt() { return __builtin_amdgcn_s_memrealtime(); }
__device__ __forceinline__ unsigned f2bf(float f) { unsigned u = __builtin_bit_cast(unsigned, f); return (u + 0x7fffu + ((u >> 16) & 1u)) >> 16; }
__device__ __forceinline__ unsigned pk2(float lo, float hi) { return f2bf(lo) | (f2bf(hi) << 16); }

#define XB_TMO      128
#define XB_XCNT(j)  (256  + 64 * (j))
#define XB_XSUB(j)  (1280 + 64 * (j))
#define XB_XGEN(j)  (2304 + 64 * (j))
#define XB_TOP      3328
#define XB_TOPGEN   3392
#define XCD_BAR_WORDS 3456
#define XB_SPIN_CAP (1u << 18)

__device__ __forceinline__ unsigned xb_ld(unsigned* p)              { return __hip_atomic_load(p, __ATOMIC_RELAXED, __HIP_MEMORY_SCOPE_AGENT); }
__device__ __forceinline__ unsigned xb_add(unsigned* p, unsigned v) { return __hip_atomic_fetch_add(p, v, __ATOMIC_RELAXED, __HIP_MEMORY_SCOPE_AGENT); }
__device__ __forceinline__ unsigned xb_xcc_id() { return (unsigned)__builtin_amdgcn_s_getreg((3 << 11) | 20) & 0xFu; }
#define XB_SPIN(cond, bar) do { unsigned _sp = 0; while (cond) { __builtin_amdgcn_s_sleep(1); \
    if ((++_sp & 255u) == 0u) { if (xb_ld(&(bar)[XB_TMO])) break; if (_sp > XB_SPIN_CAP) { atomicAdd(&(bar)[XB_TMO], 1u); break; } } } } while (0)

struct XcdBarrier {
    unsigned* bar; unsigned x;
    volatile LAS unsigned* st;
};

__device__ __forceinline__ XcdBarrier xcd_barrier_post(unsigned* bar, volatile LAS unsigned* st) {
    XcdBarrier b; b.bar = bar; b.x = xb_xcc_id(); b.st = st;
    if (threadIdx.x == 0) (void)xb_add(&bar[XB_XCNT(b.x)], 1u);
    return b;
}
__device__ __forceinline__ void xcd_barrier_complete(unsigned* bar, unsigned x, unsigned& nloc, unsigned& nx) {
    const unsigned G = gridDim.x * gridDim.y * gridDim.z;
    unsigned sum, cnt, mine, sp = 0u;
    for (;;) {
        sum = 0u; cnt = 0u; mine = 0u;
#pragma unroll
        for (unsigned j = 0; j < 16; ++j) { const unsigned c = xb_ld(&bar[XB_XCNT(j)]); sum += c; cnt += (c > 0u) ? 1u : 0u; mine = (j == x) ? c : mine; }
        if (sum == G) break;
        __builtin_amdgcn_s_sleep(1);
        if ((++sp & 255u) == 0u) { if (xb_ld(&bar[XB_TMO])) break; if (sp > XB_SPIN_CAP) { atomicAdd(&bar[XB_TMO], 1u); break; } }
    }
    nloc = mine > 0u ? mine : 1u; nx = cnt > 0u ? cnt : 1u;
}

__device__ __forceinline__ void xcd_barrier(const XcdBarrier& b) {
    asm volatile("s_waitcnt vmcnt(0)" ::: "memory");
    __syncthreads();
    if (threadIdx.x == 0) {
        unsigned* bar = b.bar;
        __builtin_amdgcn_s_waitcnt(0);
        unsigned nloc = b.st[0], nx = b.st[1];
        if (nloc == 0u) { xcd_barrier_complete(bar, b.x, nloc, nx); b.st[0] = nloc; b.st[1] = nx; }
        const unsigned old = xb_add(&bar[XB_XSUB(b.x)], 1u);
        const unsigned gen = old / nloc;
        if (old + 1u == (gen + 1u) * nloc) {
            __builtin_amdgcn_fence(__ATOMIC_RELEASE, "agent");
            asm volatile("s_waitcnt vmcnt(0)" ::: "memory");
            const unsigned og = xb_add(&bar[XB_TOP], 1u);
            const unsigned tg = og / nx;
            if (og + 1u == (tg + 1u) * nx) xb_add(&bar[XB_TOPGEN], 1u);
            else XB_SPIN(xb_ld(&bar[XB_TOPGEN]) == tg, bar);
            __builtin_amdgcn_fence(__ATOMIC_ACQUIRE, "agent");
            xb_add(&bar[XB_XGEN(b.x)], 1u);
            asm volatile("s_waitcnt vmcnt(0)" ::: "memory");
        } else {
            XB_SPIN(xb_ld(&bar[XB_XGEN(b.x)]) == gen, bar);
            __builtin_amdgcn_fence(__ATOMIC_ACQUIRE, "agent");
            asm volatile("s_waitcnt vmcnt(0)" ::: "memory");
        }
    }
    __syncthreads();
}
constexpr int NWAVES = 8;
constexpr int D = 1024, NB = 8, S = 2048, M = NB * S, PLE = 256, QKVW = 3072, DFF = 2816, NE = 8, DFE = 3584;
constexpr float EPS = 1e-6f, LAM_INIT0 = 0.2f;
constexpr int N_PHASES = 17;
#ifndef WGM_P1
#define WGM_P1 2
#endif
#ifndef WGM_P5
#define WGM_P5 2
#endif
#ifndef WGM_P11
#define WGM_P11 2
#endif
#ifndef WGM_1U
#define WGM_1U 8
#endif
#ifndef MK_N_LAUNCHES
#define MK_N_LAUNCHES 1
#endif
#ifndef MEGA_END
#define MEGA_END N_PHASES
#endif

constexpr size_t MiB = 1u << 20;
constexpr size_t WS_CTL = 0, CTL_ZERO_BYTES = 1 * MiB;
constexpr size_t WS_COS = 1 * MiB, WS_SIN = WS_COS + 256 * 1024, WS_TOKSLOT = WS_COS + 512 * 1024, WS_QKN = WS_TOKSLOT + 256 * 1024, WS_RSTL = 7 * MiB + 512 * 1024  , WS_RSTD1 = WS_QKN + 64 * 1024, WS_RSTD2 = WS_RSTD1 + 64 * 1024;
constexpr size_t WS_LISTS = 2 * MiB, WS_GWL = WS_LISTS + 512 * 1024;
constexpr size_t WS_WPOOL = 4 * MiB, WS_WPG1 = 5 * MiB, WS_WPP1 = 7 * MiB;
constexpr size_t WS_WGU = 8 * MiB, WS_WD = 120 * MiB;
constexpr size_t WS_YS = 8 * MiB;
constexpr size_t WS_XN = 176 * MiB, WS_PROJ1 = 208 * MiB, WS_BIG = 240 * MiB;
constexpr size_t WS_WQKV = 240 * MiB, WS_WO = 246 * MiB, WS_WGU0 = 248 * MiB, WS_WD0 = 259 * MiB, WS_WPG0 = 265 * MiB, WS_WPP0 = 267 * MiB;
constexpr size_t WS_Q = 268 * MiB, WS_K = 300 * MiB, WS_V = 332 * MiB, WS_O = 364 * MiB;
constexpr size_t WS_HFF = 268 * MiB, WS_PROJ0 = 364 * MiB, WS_PB = 428 * MiB;
constexpr size_t WS_HM = 240 * MiB;
constexpr size_t WS_XNB = 396 * MiB;
constexpr size_t WS_SSQA = 3 * MiB, WS_SSQB = 460 * MiB, WS_SSQC = 461 * MiB;
constexpr size_t WS_END = 466 * MiB;
static_assert(WS_WD0 + (size_t)D * DFF * 2 <= WS_WPG0 && WS_WGU0 + (size_t)2 * DFF * D * 2 <= WS_WD0 && WS_HFF + (size_t)M * DFF * 2 <= WS_PROJ0 && WS_HM + (size_t)(2 * M + 256) * DFE * 2 <= WS_END, "d_ws map");
constexpr int CW_TMO = 0, CW_CODE = 1, CW_BAR = 4096, CW_MOECNT = 65536, CW_STEAL = 98304;

constexpr int RING_OFF = 0, RING_BYTES = 131072, LDSCTL_OFF = RING_BYTES, MISC_OFF = LDSCTL_OFF + 320, LDS_BYTES = 147456;

struct Frame { LAS unsigned char* lds; volatile LAS unsigned* MISC; gu32* ctl; int tid, lane, wave, vcu, G; };

__device__ __forceinline__ float wave_sum(float v) {
#pragma unroll
    for (int o = 1; o < 64; o <<= 1) v += __shfl_xor(v, o);
    return v;
}
__device__ __forceinline__ unsigned cvtpk(float lo, float hi) { unsigned r; asm volatile("v_cvt_pk_bf16_f32 %0, %1, %2" : "=v"(r) : "v"(lo), "v"(hi)); return r; }
__device__ __forceinline__ float bflo(unsigned w) { return __uint_as_float(w << 16); }
__device__ __forceinline__ float bfhi(unsigned w) { return __uint_as_float(w & 0xffff0000u); }

__device__ __forceinline__ int map_row(int map, int n) {
    if (map == 1) return (n & ~255) + ((n >> 5) & 1) * 128 + ((n >> 6) & 3) * 32 + (n & 31);
    if (map == 2) return ((n >> 7) << 8) + (n & 127);
    if (map == 3) return ((n >> 7) << 8) + 128 + (n & 127);
    return n;
}
typedef float f32x2g __attribute__((ext_vector_type(2)));
__device__ __forceinline__ void tr_load(f32x4 (&v)[16], f32x2g (&g)[8], const float* W, int N, int k0, int n0, int lane, const float* gk) {
    const int ksub = lane >> 4, n4 = (lane & 15) * 4;
#pragma unroll
    for (int it = 0; it < 8; ++it)
#pragma unroll
        for (int h = 0; h < 2; ++h) v[2 * it + h] = __builtin_nontemporal_load((const GAS f32x4*)(W + (size_t)(k0 + it * 8 + 2 * ksub + h) * N + n0 + n4));
    const float* gp = gk ? gk : W;
#pragma unroll
    for (int it = 0; it < 8; ++it) g[it] = *(const GAS f32x2g*)(gp + k0 + it * 8 + 2 * ksub);
}
__device__ __forceinline__ void tr_store(const f32x4 (&v)[16], bf16* dst, int ldd, int map, int k0, int n0, LAS unsigned* tile, int lane, const f32x2g (&graw)[8], float sel) {
    const int ksub = lane >> 4, q = lane & 15;
    f32x2g g[8];
#pragma unroll
    for (int it = 0; it < 8; ++it) g[it] = graw[it] * sel + (1.f - sel);
#pragma unroll
    for (int it = 0; it < 8; ++it)
#pragma unroll
        for (int j = 0; j < 4; ++j) tile[(4 * q + j) * 32 + ((4 * it + ksub) ^ ((q & 7) * 4))] = cvtpk(v[2 * it][j] * g[it].x, v[2 * it + 1][j] * g[it].y);
    LDS_WAIT(); asm volatile("" ::: "memory");
    const int c = lane & 7;
#pragma unroll
    for (int j2 = 0; j2 < 8; ++j2) { const int n = (lane >> 3) + 8 * j2, fz = ((n >> 2) & 7) * 4; const v4u w = *(const LAS v4u*)(tile + n * 32 + ((4 * c) ^ fz));
        *(GAS v4u*)(dst + (size_t)map_row(map, n0 + n) * ldd + k0 + 8 * c) = w; }
    LDS_WAIT(); asm volatile("" ::: "memory");
}
struct TItem { const float* W; bf16* dst; const float* g; int K, N, map, kb, nb; };
enum { A_X = 0, A_P, A_NORM_MIX, A_NORM_FFN, A_NORM_PLE, A_WQKV, A_WO, A_QNORM, A_KNORM, A_LQ1, A_LK1, A_LQ2, A_LK2, A_SUBLN, A_POOLW, A_POOLB, A_POOLS, A_FFNG, A_FFNU, A_FFND, A_ROUTER, A_MOEG, A_MOEU, A_MOED, A_PLEP, A_PLEG };
__device__ __forceinline__ const float* arg_ptr(int i) {
    const __attribute__((address_space(4))) char* kp = (const __attribute__((address_space(4))) char*)__builtin_amdgcn_kernarg_segment_ptr();
    unsigned off = (unsigned)i * 8u; asm volatile("" : "+s"(off));
    return *(const float* const __attribute__((address_space(4)))*)(kp + off);
}
constexpr int TI_QKV = 768, TI_O = 256, TI_FF = 704, TI_PG = 256, TI_PP = 64, TI_POOL = 64, TI_MOE = 7168;
constexpr int TI_TOTAL = TI_QKV + TI_O + 3 * TI_FF + 2 * TI_PG + 2 * TI_PP + TI_POOL + 3 * TI_MOE;
__device__ __forceinline__ void decode_item(unsigned char* ws, int r, TItem& t) {
    int ai = 0, gi = -1, gofs = 0; size_t wofs = 0;
    do {
#define TJOB(cnt, Ai, Wofs, Kp, Np, dstp, mapp, Gi, Gofs) if (r < (cnt)) { ai = (Ai); wofs = (Wofs); gi = (Gi); gofs = (Gofs); t.K = (Kp); t.N = (Np); t.dst = (bf16*)(dstp); t.map = (mapp); t.kb = r / ((Np) / 64); t.nb = r % ((Np) / 64); break; } r -= (cnt);
        if (r < TI_MOE) { const int e = r / 896; r -= e * 896; ai = A_MOEG; gi = A_NORM_FFN; gofs = D; wofs = (size_t)e * D * DFE; t.K = D; t.N = DFE; t.dst = (bf16*)(ws + WS_WGU) + (size_t)e * 2 * DFE * D; t.map = 2; t.kb = r / 56; t.nb = r % 56; break; } r -= TI_MOE;
        if (r < TI_MOE) { const int e = r / 896; r -= e * 896; ai = A_MOEU; gi = A_NORM_FFN; gofs = D; wofs = (size_t)e * D * DFE; t.K = D; t.N = DFE; t.dst = (bf16*)(ws + WS_WGU) + (size_t)e * 2 * DFE * D; t.map = 3; t.kb = r / 56; t.nb = r % 56; break; } r -= TI_MOE;
        if (r < TI_MOE) { const int e = r / 896; r -= e * 896; ai = A_MOED; wofs = (size_t)e * DFE * D; t.K = DFE; t.N = D; t.dst = (bf16*)(ws + WS_WD) + (size_t)e * D * DFE; t.map = 0; t.kb = r / 16; t.nb = r % 16; break; } r -= TI_MOE;
        TJOB(TI_QKV, A_WQKV, 0, D, QKVW, ws + WS_WQKV, 1, -1, 0)
        TJOB(TI_O, A_WO, 0, D, D, ws + WS_WO, 0, -1, 0)
        TJOB(TI_FF, A_FFNG, 0, D, DFF, ws + WS_WGU0, 2, A_NORM_FFN, 0)
        TJOB(TI_FF, A_FFNU, 0, D, DFF, ws + WS_WGU0, 3, A_NORM_FFN, 0)
        TJOB(TI_FF, A_FFND, 0, DFF, D, ws + WS_WD0, 0, -1, 0)
        TJOB(TI_PG, A_PLEG, 0, D, D, ws + WS_WPG0, 0, A_NORM_PLE, 0)
        TJOB(TI_PG, A_PLEG, (size_t)D * D, D, D, ws + WS_WPG1, 0, A_NORM_PLE, D)
        TJOB(TI_PP, A_PLEP, 0, PLE, D, ws + WS_WPP0, 0, -1, 0)
        TJOB(TI_PP, A_PLEP, (size_t)PLE * D, PLE, D, ws + WS_WPP1, 0, -1, 0)
        { const int g = r / 16; r -= g * 16; ai = A_POOLW; gi = A_NORM_MIX; gofs = D + g * 256; wofs = (size_t)g * 256 * 256; t.K = 256; t.N = 256; t.dst = (bf16*)(ws + WS_WPOOL) + (size_t)g * 256 * 256; t.map = 0; t.kb = r / 4; t.nb = r % 4; }
#undef TJOB
    } while (0);
    t.W = arg_ptr(ai) + wofs; t.g = nullptr; if (gi >= 0) t.g = arg_ptr(gi) + gofs;
}
__device__ __forceinline__ void rms_row_to_bf16(const float* xrow, const float* gain, bf16* orow, int lane) {
    const GAS f32x4* xr = (const GAS f32x4*)xrow + lane;
    f32x4 v[4]; float s = 0.f;
#pragma unroll
    for (int j = 0; j < 4; ++j) { v[j] = xr[64 * j]; s += (v[j].x * v[j].x + v[j].y * v[j].y) + (v[j].z * v[j].z + v[j].w * v[j].w); }
    const float rstd = __builtin_amdgcn_rsqf(wave_sum(s) * (1.f / D) + EPS);
    GAS unsigned long long* o8 = (GAS unsigned long long*)orow + lane;
#pragma unroll
    for (int j = 0; j < 4; ++j) { const f32x4 g = ((const GAS f32x4*)gain)[lane + 64 * j];
        o8[64 * j] = (unsigned long long)cvtpk(v[j].x * rstd * g.x, v[j].y * rstd * g.y) | ((unsigned long long)cvtpk(v[j].z * rstd * g.z, v[j].w * rstd * g.w) << 32); }
}
__device__ __forceinline__ void p_norm(Frame& F, const float* H, const float* gain, bf16* XN) {
    const int gw = F.vcu * NWAVES + F.wave, NGW = F.G * NWAVES, lane = F.lane;
    for (int m0 = gw * 4; m0 < M; m0 += NGW * 4) {
        f32x4 v[4][4];
#pragma unroll
        for (int r = 0; r < 4; ++r) { const GAS f32x4* xr = (const GAS f32x4*)(H + (size_t)(m0 + r) * D) + lane;
#pragma unroll
            for (int j = 0; j < 4; ++j) v[r][j] = xr[64 * j]; }
#pragma unroll
        for (int r = 0; r < 4; ++r) { float s = 0.f;
#pragma unroll
            for (int j = 0; j < 4; ++j) s += (v[r][j].x * v[r][j].x + v[r][j].y * v[r][j].y) + (v[r][j].z * v[r][j].z + v[r][j].w * v[r][j].w);
            const float rstd = __builtin_amdgcn_rsqf(wave_sum(s) * (1.f / D) + EPS);
            GAS unsigned long long* o8 = (GAS unsigned long long*)(XN + (size_t)(m0 + r) * D) + lane;
#pragma unroll
            for (int j = 0; j < 4; ++j) { const f32x4 g = ((const GAS f32x4*)gain)[lane + 64 * j];
                o8[64 * j] = (unsigned long long)cvtpk(v[r][j].x * rstd * g.x, v[r][j].y * rstd * g.y) | ((unsigned long long)cvtpk(v[r][j].z * rstd * g.z, v[r][j].w * rstd * g.w) << 32); } }
    }
}
__device__ __forceinline__ void conv_range(unsigned char* ws, LAS unsigned* tile, int lane_in, int it0, int step, int nmax, int it_end) {
    int lane = lane_in; asm volatile("" : "+v"(lane));
    for (int it = it0, n = 0; it < it_end && n < nmax; it += 2 * step, n += 2) {
        const bool hasb = (it + step < it_end) && (n + 1 < nmax); const int itb = hasb ? it + step : it;
        TItem ta, tb; f32x4 va[16], vb[16]; f32x2g ga[8], gb[8];
        decode_item(ws, it, ta); tr_load(va, ga, ta.W, ta.N, ta.kb * 64, ta.nb * 64, lane, ta.g);
        decode_item(ws, itb, tb); tr_load(vb, gb, tb.W, tb.N, tb.kb * 64, tb.nb * 64, lane, tb.g);
        tr_store(va, ta.dst, ta.K, ta.map, ta.kb * 64, ta.nb * 64, tile, lane, ga, ta.g ? 1.f : 0.f);
        tr_store(vb, tb.dst, tb.K, tb.map, tb.kb * 64, tb.nb * 64, tile, lane, gb, tb.g ? 1.f : 0.f);
    }
}
__device__ __forceinline__ void p0_prologue(Frame& F, unsigned char* ws) {
    const int gw = F.vcu * NWAVES + F.wave, NGW = F.G * NWAVES, gt = gw * 64 + F.lane, NGT = NGW * 64;
    for (int idx = gt; idx < S * 32; idx += NGT) {
        const int pos = idx >> 5, i = idx & 31;
        const float inv = 1.0f / __builtin_amdgcn_exp2f((float)i * (13.287712379549449f / 32.f));
        const float ang = (float)pos * inv; const double a = (double)ang * 0.15915494309189535; const float f = (float)(a - __builtin_rint(a));
        ((float*)(ws + WS_COS))[idx] = __builtin_amdgcn_cosf(f); ((float*)(ws + WS_SIN))[idx] = __builtin_amdgcn_sinf(f);
    }
    if (gt < 128) ((float*)(ws + WS_QKN))[gt] = gt < 64 ? arg_ptr(A_QNORM)[gt] : arg_ptr(A_KNORM)[gt - 64];
    { const float* pp = arg_ptr(A_P);
#pragma unroll 4
    for (int i = gt; i < 2 * M * PLE / 8; i += NGT) { const f32x4 a = ((const GAS f32x4*)pp)[2 * i], b = ((const GAS f32x4*)pp)[2 * i + 1];
        v4u w; w.x = cvtpk(a.x, a.y); w.y = cvtpk(a.z, a.w); w.z = cvtpk(b.x, b.y); w.w = cvtpk(b.z, b.w); ((GAS v4u*)(ws + WS_PB))[i] = w; } }
    p_norm(F, arg_ptr(A_X), arg_ptr(A_NORM_MIX), (bf16*)(ws + WS_XN));
    conv_range(ws, (LAS unsigned*)(F.lds + RING_OFF + F.wave * 8192), F.lane, 3 * TI_MOE + gw, NGW, 1 << 30, TI_TOTAL);
}
__device__ __forceinline__ void p_subln(Frame& F, const bf16* O, bf16* XN) {
    const int gw = F.vcu * NWAVES + F.wave, NGW = F.G * NWAVES, lane = F.lane;
    const float lam = __expf(wave_sum(arg_ptr(A_LQ1)[lane] * arg_ptr(A_LK1)[lane])) - __expf(wave_sum(arg_ptr(A_LQ2)[lane] * arg_ptr(A_LK2)[lane])) + LAM_INIT0;
    const float* subln_g = arg_ptr(A_SUBLN);
    float sg[16];
#pragma unroll
    for (int i = 0; i < 4; ++i) { const f32x4 g = *(const GAS f32x4*)(subln_g + (lane & 7) * 16 + 4 * i); sg[4 * i] = g.x; sg[4 * i + 1] = g.y; sg[4 * i + 2] = g.z; sg[4 * i + 3] = g.w; }
    for (int m = gw; m < M; m += NGW) {
        const GAS v4u* o0 = (const GAS v4u*)(O + (size_t)m * D) + 2 * lane; const GAS v4u* o1 = (const GAS v4u*)(O + (size_t)M * D + (size_t)m * D) + 2 * lane;
        const v4u a0 = o0[0], a1 = o0[1], b0 = o1[0], b1 = o1[1];
        const unsigned aw[8] = {a0.x, a0.y, a0.z, a0.w, a1.x, a1.y, a1.z, a1.w}, bw[8] = {b0.x, b0.y, b0.z, b0.w, b1.x, b1.y, b1.z, b1.w};
        float v[16]; float ss = 0.f;
#pragma unroll
        for (int i = 0; i < 8; ++i) { v[2 * i] = bflo(aw[i]) - lam * bflo(bw[i]); v[2 * i + 1] = bfhi(aw[i]) - lam * bfhi(bw[i]); ss += v[2 * i] * v[2 * i] + v[2 * i + 1] * v[2 * i + 1]; }
        ss += __shfl_xor(ss, 1); ss += __shfl_xor(ss, 2); ss += __shfl_xor(ss, 4);
        const float r = __builtin_amdgcn_rsqf(ss * (1.f / 128.f) + EPS) * (1.f - LAM_INIT0);
        v4u w0, w1;
        w0.x = cvtpk(v[0] * r * sg[0], v[1] * r * sg[1]); w0.y = cvtpk(v[2] * r * sg[2], v[3] * r * sg[3]); w0.z = cvtpk(v[4] * r * sg[4], v[5] * r * sg[5]); w0.w = cvtpk(v[6] * r * sg[6], v[7] * r * sg[7]);
        w1.x = cvtpk(v[8] * r * sg[8], v[9] * r * sg[9]); w1.y = cvtpk(v[10] * r * sg[10], v[11] * r * sg[11]); w1.z = cvtpk(v[12] * r * sg[12], v[13] * r * sg[13]); w1.w = cvtpk(v[14] * r * sg[14], v[15] * r * sg[15]);
        GAS v4u* o = (GAS v4u*)(XN + (size_t)m * D) + 2 * lane; o[0] = w0; o[1] = w1;
    }
}
__device__ __forceinline__ void p_pool(Frame& F, const bf16* H, bf16* XN, const float* ssqp) {
    LAS float* rs = (LAS float*)(F.lds + RING_OFF);
    for (int blk = F.vcu; blk < M / 64; blk += F.G) {
        const int r0 = blk * 64, t0 = r0 & (S - 1);
        if (F.tid < 80) { const int row = r0 - 16 + F.tid; float r = 0.f; if (F.tid >= 16 || t0 != 0) r = pg8::row_rstd(ssqp, row, EPS); rs[F.tid] = r; }
        __syncthreads();
        typedef float f32x2v __attribute__((ext_vector_type(2)));
        const int col = 2 * F.tid, g = col >> 8, w = 2 << g;
        const bf16* Hc = H + (size_t)r0 * D + col;
#define LD2(p) ({ const unsigned w_ = *(const GAS unsigned*)(p); (f32x2v){bflo(w_), bfhi(w_)}; })
        float s0 = 0.f, s1 = 0.f;
        if (t0 != 0) for (int k = 1; k <= w; ++k) { const f32x2v hv = LD2(Hc - (long)k * D); const float r = rs[16 - k]; s0 += hv.x * r; s1 += hv.y * r; }
        for (int rb = 0; rb < 64; rb += 8) {
            f32x2v nv[8], ov[8];
#pragma unroll
            for (int j = 0; j < 8; ++j) nv[j] = LD2(Hc + (long)(rb + j) * D);
#pragma unroll
            for (int j = 0; j < 8; ++j) { ov[j] = (f32x2v){0.f, 0.f}; if (t0 + rb + j >= w) ov[j] = LD2(Hc + (long)(rb + j - w) * D); }
#pragma unroll
            for (int j = 0; j < 8; ++j) { const int rl = rb + j, t = t0 + rl; const float rn = rs[16 + rl]; const float a0 = nv[j].x * rn, a1 = nv[j].y * rn;
                s0 += a0; s1 += a1;
                if (t >= w) { const float ro = rs[16 + rl - w]; s0 -= ov[j].x * ro; s1 -= ov[j].y * ro; }
                const int cnt = (t + 1 < w) ? t + 1 : w; const float ic = 1.f / (float)cnt;
                *(GAS unsigned*)(XN + (size_t)(r0 + rl) * D + col) = cvtpk(s0 * ic - a0, s1 * ic - a1); }
        }
#undef LD2
        __syncthreads();
    }
}
__device__ __forceinline__ void p_router(Frame& F, const bf16* H, const float* gain, const float* Wr, float* rstl, int* lists, float* gwl, int* tokslot, gu32* cntw) {
    LAS float* rec = (LAS float*)(F.lds + RING_OFF);
    const int lane = F.lane;
    float wr[4][4][8];
#pragma unroll
    for (int j = 0; j < 4; ++j)
#pragma unroll
        for (int i = 0; i < 4; ++i) { const int k = 4 * lane + 256 * j + i; const f32x4 a = *(const GAS f32x4*)(Wr + k * 8), b = *(const GAS f32x4*)(Wr + k * 8 + 4);
            wr[j][i][0] = a.x; wr[j][i][1] = a.y; wr[j][i][2] = a.z; wr[j][i][3] = a.w; wr[j][i][4] = b.x; wr[j][i][5] = b.y; wr[j][i][6] = b.z; wr[j][i][7] = b.w; }
    f32x4 gn[4];
#pragma unroll
    for (int j = 0; j < 4; ++j) gn[j] = ((const GAS f32x4*)gain)[lane + 64 * j];
    for (int blk = F.vcu; blk < M / 64; blk += F.G) {
        unsigned long long raw[8][4];
#pragma unroll
        for (int rr = 0; rr < 8; ++rr) { const GAS unsigned long long* xr = (const GAS unsigned long long*)(H + (size_t)(blk * 64 + F.wave * 8 + rr) * D) + lane;
#pragma unroll
            for (int j = 0; j < 4; ++j) raw[rr][j] = xr[64 * j]; }
#pragma unroll
        for (int rr = 0; rr < 8; ++rr) {
            const int rl = F.wave * 8 + rr;
            f32x4 v[4]; float s = 0.f;
#pragma unroll
            for (int j = 0; j < 4; ++j) { const unsigned long long a = raw[rr][j]; v[j] = (f32x4){bflo((unsigned)a), bfhi((unsigned)a), bflo((unsigned)(a >> 32)), bfhi((unsigned)(a >> 32))}; s += (v[j].x * v[j].x + v[j].y * v[j].y) + (v[j].z * v[j].z + v[j].w * v[j].w); }
            const float rstd = __builtin_amdgcn_rsqf(wave_sum(s) * (1.f / D) + EPS);
            float lg[8];
#pragma unroll
            for (int e = 0; e < 8; ++e) lg[e] = 0.f;
#pragma unroll
            for (int j = 0; j < 4; ++j) { const float xu[4] = {v[j].x * rstd, v[j].y * rstd, v[j].z * rstd, v[j].w * rstd};
                const float xv[4] = {xu[0] * gn[j].x, xu[1] * gn[j].y, xu[2] * gn[j].z, xu[3] * gn[j].w};
#pragma unroll
                for (int i = 0; i < 4; ++i)
#pragma unroll
                    for (int e = 0; e < 8; ++e) lg[e] = __builtin_fmaf(xv[i], wr[j][i][e], lg[e]); }
#pragma unroll
            for (int e = 0; e < 8; ++e) lg[e] = wave_sum(lg[e]);
            int i0 = 0; float v0 = lg[0];
#pragma unroll
            for (int e = 1; e < 8; ++e) if (lg[e] > v0) { v0 = lg[e]; i0 = e; }
            int i1 = 0; float v1 = -INFINITY;
#pragma unroll
            for (int e = 0; e < 8; ++e) if (e != i0 && lg[e] > v1) { v1 = lg[e]; i1 = e; }
            const float g1 = 1.f / (1.f + __expf(v0 - v1)), g0 = 1.f - g1;
            if (lane == 0) { rec[rl * 8 + 0] = __int_as_float(i0); rec[rl * 8 + 1] = __int_as_float(i1); rec[rl * 8 + 2] = g0; rec[rl * 8 + 3] = g1; rec[rl * 8 + 4] = rstd; }
        }
        __syncthreads();
        {
            const int ex = F.wave, rl = lane; const int a = __float_as_int(rec[rl * 8]), b = __float_as_int(rec[rl * 8 + 1]);
            const bool sel = (a == ex) || (b == ex); const unsigned long long bal = __ballot(sel);
            const int n = __popcll(bal), pre = __popcll(bal & ((1ull << lane) - 1ull));
            int base = 0; if (lane == 0) base = (int)__hip_atomic_fetch_add(cntw + 64 * ex, (unsigned)n, RLX_AGENT);
            base = __builtin_amdgcn_readfirstlane(base);
            if (sel) { const int k = (a == ex) ? 0 : 1, tok = blk * 64 + rl, pos = base + pre;
                lists[ex * M + pos] = tok; gwl[ex * M + pos] = rec[rl * 8 + 2 + k]; rstl[ex * M + pos] = rec[rl * 8 + 4]; tokslot[tok * 2 + k] = (ex << 16) | pos; }
        }
        __syncthreads();
    }
}
__device__ __forceinline__ void p_combine(Frame& F, bf16* HB, const bf16* Ys, const int* tokslot, float* rstd_out) {
    const int gw = F.vcu * NWAVES + F.wave, NGW = F.G * NWAVES, lane = F.lane;
    int off[8]; { int a = 0;
#pragma unroll
        for (int e = 0; e < 8; ++e) { off[e] = a; a += (int)__hip_atomic_load(F.ctl + CW_MOECNT + 64 * e, RLX_AGENT); } }
    constexpr int RPW = 8;
    for (int m0 = gw * RPW; m0 < M; m0 += NGW * RPW) {
        const int ts = (lane < 2 * RPW) ? tokslot[2 * m0 + lane] : 0;
#pragma unroll
        for (int g = 0; g < RPW; g += 4) {
            unsigned long long ya[4][4], yb[4][4], hh[4][4];
#pragma unroll
            for (int r = 0; r < 4; ++r) {
                const int ts0 = __builtin_amdgcn_readlane(ts, 2 * (g + r)), ts1 = __builtin_amdgcn_readlane(ts, 2 * (g + r) + 1);
                int s0 = ts0 & 0xffff, s1 = ts1 & 0xffff;
#pragma unroll
                for (int e = 0; e < 8; ++e) { if ((ts0 >> 16) == e) s0 += off[e]; if ((ts1 >> 16) == e) s1 += off[e]; }
                const GAS unsigned long long* hr = (const GAS unsigned long long*)(HB + (size_t)(m0 + g + r) * D) + lane;
                const GAS unsigned long long* y0 = (const GAS unsigned long long*)(Ys + (size_t)s0 * D) + lane; const GAS unsigned long long* y1 = (const GAS unsigned long long*)(Ys + (size_t)s1 * D) + lane;
#pragma unroll
                for (int j = 0; j < 4; ++j) { ya[r][j] = y0[64 * j]; yb[r][j] = y1[64 * j]; hh[r][j] = hr[64 * j]; }
            }
#pragma unroll
            for (int r = 0; r < 4; ++r) {
                GAS unsigned long long* hw = (GAS unsigned long long*)(HB + (size_t)(m0 + g + r) * D) + lane; float s = 0.f;
#pragma unroll
                for (int j = 0; j < 4; ++j) { const unsigned al = (unsigned)ya[r][j], ah = (unsigned)(ya[r][j] >> 32), bl = (unsigned)yb[r][j], bh = (unsigned)(yb[r][j] >> 32), hl = (unsigned)hh[r][j], hu = (unsigned)(hh[r][j] >> 32);
                    const unsigned w0 = cvtpk(bflo(hl) + (bflo(al) + bflo(bl)), bfhi(hl) + (bfhi(al) + bfhi(bl))), w1 = cvtpk(bflo(hu) + (bflo(ah) + bflo(bh)), bfhi(hu) + (bfhi(ah) + bfhi(bh)));
                    hw[64 * j] = (unsigned long long)w0 | ((unsigned long long)w1 << 32);
                    s += (bflo(w0) * bflo(w0) + bfhi(w0) * bfhi(w0)) + (bflo(w1) * bflo(w1) + bfhi(w1) * bfhi(w1)); }
                const float rstd = __builtin_amdgcn_rsqf(wave_sum(s) * (1.f / D) + EPS);
                if (lane == 0) rstd_out[m0 + g + r] = rstd;
            }
        }
    }
}

struct Args { const float* in[26]; float* out; unsigned char* ws; int ph_lo, ph_hi, li, pad; };
__global__ void __launch_bounds__(NWAVES * 64, 2) mega_fwd(Args args) {
    extern __shared__ __attribute__((aligned(16))) unsigned char lds[];
    Frame F;
    F.lds = (LAS unsigned char*)lds;
    F.MISC = (volatile LAS unsigned*)(F.lds + MISC_OFF);
    F.tid = threadIdx.x; F.lane = F.tid & 63; F.wave = __builtin_amdgcn_readfirstlane(F.tid >> 6);
    F.G = gridDim.x; { const int bx = blockIdx.x; F.vcu = (F.G % 8 == 0) ? (bx % 8) * (F.G / 8) + bx / 8 : bx; }
    unsigned char* ws = args.ws;
    F.ctl = (gu32*)(ws + WS_CTL);
    float* const Hout = args.out;
    for (int u = F.tid; u < (LDS_BYTES - LDSCTL_OFF) / 4; u += NWAVES * 64) ((LAS unsigned*)(F.lds + LDSCTL_OFF))[u] = 0u;
    __syncthreads();
    XcdBarrier bar; bar.bar = (unsigned*)(F.ctl + CW_BAR) + args.li * XCD_BAR_WORDS; bar.x = 0; bar.st = nullptr;
    const int lo = args.ph_lo, hi = args.ph_hi;
    if (hi - lo > 1) bar = xcd_barrier_post((unsigned*)(F.ctl + CW_BAR) + args.li * XCD_BAR_WORDS, F.MISC + 8);
#ifndef PHASE_MASK
#define PHASE_MASK 0x1ffff
#endif
#define IN(k) (((PHASE_MASK >> (k)) & 1) && lo <= (k) && (k) < hi)
#define SEAM(k) do { if (IN(k) && IN((k) + 1)) xcd_barrier(bar); } while (0)
#ifndef REP_MASK
#define REP_MASK 0
#endif
#define REPS(k) (((REP_MASK >> (k)) & 1) ? 2 : 1)
#define REPEAT(k) _Pragma("unroll 1") for (int rep_ = 0; rep_ < REPS(k); (++rep_ < REPS(k)) ? xcd_barrier(bar) : (void)0)
    bf16* XN = (bf16*)(ws + WS_XN);
    const int bx = (int)blockIdx.x;
    const long TS1024 = 256L * 1024 * 2;

    float* SSQA = (float*)(ws + WS_SSQA); float* SSQB = (float*)(ws + WS_SSQB); float* SSQC = (float*)(ws + WS_SSQC);
    if (IN(0)) REPEAT(0) { p0_prologue(F, ws); } SEAM(0);
    if (IN(1)) REPEAT(1) {
        pg8::DenseSched Sd{(const char*)XN, (const char*)(ws + WS_WQKV), 64, 12, F.G, bx, TS1024, 0, TS1024, WGM_P1};
        pg8::EpiQKV E{(bf16*)(ws + WS_Q), (size_t)(WS_K - WS_Q) / 2, (const float*)(ws + WS_QKN), (const float*)(ws + WS_COS), (const float*)(ws + WS_SIN), attn_body::C2, EPS};
        pg8::gemm_phase<pg8::EpiQKV, pg8::DenseSched, false, true>(F.lds + RING_OFF, D, D, D, Sd, E);
    } SEAM(1);
    if (IN(2)) REPEAT(2) {
        static_assert(attn_body::ATTN128_LDS_BYTES <= RING_BYTES, "attention LDS");
        const float lam = __expf(wave_sum(arg_ptr(A_LQ1)[F.lane] * arg_ptr(A_LK1)[F.lane])) - __expf(wave_sum(arg_ptr(A_LQ2)[F.lane] * arg_ptr(A_LK2)[F.lane])) + LAM_INIT0;
        const float* subg = arg_ptr(A_SUBLN);
        const int hgrp = (F.vcu * 3) / F.G; const int hkpos = (hgrp == 0) ? -1 : (hgrp == 1) ? 0 : 2; bool conv_done = false;
        for (int hc = F.vcu; hc < NB * 8 * 4; hc += F.G) {
            const int bh = hc >> 2, s_ = hc & 3, b = bh >> 3, h = bh & 7;
            const attn_body::bf16* Vp = (const attn_body::bf16*)(ws + WS_V) + h * 128; attn_body::bf16* Op = (attn_body::bf16*)(ws + WS_O) + h * 128;
            _Pragma("unroll 1") for (int qi = -1; qi < 4; ++qi) {
                if (qi >= 0) { int qb = (qi & 2) ? s_ : 7 - s_; asm volatile("" : "+s"(qb)); const int c = qi & 1;
                    const attn_body::bf16* Qp = (const attn_body::bf16*)(ws + WS_Q) + (h * 2 + c) * 64; const attn_body::bf16* Kp = (const attn_body::bf16*)(ws + WS_K) + (h * 2 + c) * 64;
                    if (c == 0) attn_body::attn_unit128<8, false>(b, qb, Qp, Kp, Vp, Op, (char*)lds + RING_OFF);
                    else attn_body::attn_unit128<8, true>(b, qb, Qp, Kp, Vp, Op, (char*)lds + RING_OFF, (attn_body::bf16*)XN + h * 128, subg, lam, 1.f - LAM_INIT0, EPS); }
                if (qi == hkpos && !conv_done) {
                    conv_range(ws, (LAS unsigned*)(F.lds + RING_OFF + F.wave * 8192), F.lane, F.vcu * NWAVES + F.wave, F.G * NWAVES, 1 << 30, 2 * TI_MOE); conv_done = true;
                    asm volatile("s_waitcnt lgkmcnt(0)" ::: "memory"); __builtin_amdgcn_s_barrier(); asm volatile("" ::: "memory"); }
            }
        }
    } SEAM(2);
    bf16* HB0 = (bf16*)Hout;
    bf16* HB1 = XN;
    bf16* PL = (bf16*)(ws + WS_Q);
    if (IN(4)) REPEAT(4) {
        pg8::DenseSched Sd{(const char*)XN, (const char*)(ws + WS_WO), 64, 4, F.G, bx, TS1024, 0, TS1024, WGM_1U};
        pg8::EpiResNorm<false> E{arg_ptr(A_X), HB0, SSQA};
        pg8::gemm_phase<pg8::EpiResNorm<false>, pg8::DenseSched, false, true>(F.lds + RING_OFF, D, D, D, Sd, E);
    } SEAM(4);
    if (IN(5)) REPEAT(5) {
        { pg8::DenseSched Sd{(const char*)HB0, (const char*)(ws + WS_WGU0), 64, 22, F.G, bx, TS1024, 0, TS1024, WGM_P5};
          pg8::EpiSwiGLU<1> E{(bf16*)(ws + WS_HFF), DFF, EPS, SSQA, nullptr};
          pg8::gemm_phase<pg8::EpiSwiGLU<1>, pg8::DenseSched, false, true>(F.lds + RING_OFF, D, D, D, Sd, E); }
        { const bool split = (F.G == 256);
          pg8::ProjSched Sp{(const char*)(ws + WS_PB), (const char*)(ws + WS_WPP0), (long)M * PLE * 2, (long)WS_WPP1 - (long)WS_WPP0, split ? 128 : F.G, split ? bx - 128 : bx};
          pg8::EpiProj E{(bf16*)(ws + WS_PROJ0), ((long)WS_PROJ1 - (long)WS_PROJ0) / 2};
          pg8::gemm_phase<pg8::EpiProj, pg8::ProjSched, false, true>(F.lds + RING_OFF, PLE, PLE, PLE, Sp, E); }
    } SEAM(5);
    if (IN(6)) {
        pg8::DenseSched Sd{(const char*)(ws + WS_HFF), (const char*)(ws + WS_WD0), 64, 4, F.G, bx, 256L * DFF * 2, 0, 256L * DFF * 2, WGM_1U};
        pg8::EpiResNorm<true> E{HB0, HB0, SSQB};
        pg8::gemm_phase<pg8::EpiResNorm<true>, pg8::DenseSched, false, true>(F.lds + RING_OFF, DFF, DFF, DFF, Sd, E);
    } SEAM(6);
    if (IN(7)) {
        pg8::DenseSched Sd{(const char*)HB0, (const char*)(ws + WS_WPG0), 64, 4, F.G, bx, TS1024, 0, TS1024, WGM_1U};
        pg8::EpiPle<1, false> E{HB0, (const bf16*)(ws + WS_PROJ0), HB1, SSQB, SSQC, EPS, 0};
        pg8::gemm_phase<pg8::EpiPle<1, false>, pg8::DenseSched, false, true>(F.lds + RING_OFF, D, D, D, Sd, E);
    } SEAM(7);
    if (IN(8)) REPEAT(8) { p_pool(F, HB1, PL, SSQC); } SEAM(8);
    if (IN(9)) {
        pg8::DenseSched Sd{(const char*)PL, (const char*)(ws + WS_WPOOL), 64, 4, F.G, bx, TS1024, 256L * 2, 256L * 256 * 2, WGM_1U};
        pg8::EpiPool E{HB1, arg_ptr(A_POOLB), arg_ptr(A_POOLS)};
        pg8::gemm_phase<pg8::EpiPool, pg8::DenseSched, false, true>(F.lds + RING_OFF, 256, D, 256, Sd, E);
    } SEAM(9);
    if (IN(10)) REPEAT(10) { const bool dmy = rep_ + 1 < REPS(10); unsigned char* wd = dmy ? ws + 300 * MiB : ws;
        p_router(F, HB1, arg_ptr(A_NORM_FFN) + D, arg_ptr(A_ROUTER), (float*)(wd + WS_RSTL), (int*)(wd + WS_LISTS), (float*)(wd + WS_GWL), (int*)(wd + WS_TOKSLOT), F.ctl + CW_MOECNT + (dmy ? 1024 : 0)); } SEAM(10);
    if (IN(11)) REPEAT(11) {
        pg8::MoeSched Sm; Sm.A = (const char*)HB1; Sm.B = (const char*)(ws + WS_WGU); Sm.lists = (const int*)(ws + WS_LISTS);
#pragma unroll
        for (int e = 0; e < 8; ++e) Sm.cnt[e] = __builtin_amdgcn_readfirstlane((int)__hip_atomic_load(F.ctl + CW_MOECNT + 64 * e, RLX_AGENT));
        Sm.nN = 28; Sm.G = F.G; Sm.c = bx; Sm.b_e = 2L * DFE * D * 2; Sm.b_pn = TS1024; Sm.a_row = 0; Sm.list_stride = M; Sm.gather = true; Sm.WGM = WGM_P11; Sm.lim = Sm.total();
        pg8::EpiSwiGLU<2> E{(bf16*)(ws + WS_HM), DFE, EPS, (const float*)(ws + WS_RSTL), (const int*)(ws + WS_LISTS)};
        pg8::gemm_phase<pg8::EpiSwiGLU<2>, pg8::MoeSched, true, true>(F.lds + RING_OFF, D, D, D, Sm, E);
        if (rep_ == 0) {
            volatile LAS int* bw = (volatile LAS int*)(F.lds + MISC_OFF + 96);
            for (;;) {
                if (F.tid == 0) bw[0] = (int)__hip_atomic_fetch_add(F.ctl + CW_STEAL, 1u, RLX_AGENT);
                __syncthreads();
                const int batch = __builtin_amdgcn_readfirstlane(bw[0]);
                __syncthreads();
                if (batch * 16 >= TI_MOE) break;
                conv_range(ws, (LAS unsigned*)(F.lds + RING_OFF + F.wave * 8192), F.lane, 2 * TI_MOE + batch * 16 + F.wave * 2, 1, 2, 3 * TI_MOE);
            }
        }
    } SEAM(11);
    pg8::MoeSched Sdn; Sdn.A = (const char*)(ws + WS_HM); Sdn.B = (const char*)(ws + WS_WD); Sdn.lists = (const int*)(ws + WS_GWL);
    Sdn.nN = 4; Sdn.G = F.G; Sdn.c = bx; Sdn.b_e = (long)D * DFE * 2; Sdn.b_pn = 256L * DFE * 2; Sdn.a_row = (long)DFE * 2; Sdn.list_stride = M; Sdn.gather = false; Sdn.WGM = 8; Sdn.lim = 0;
    int dn_R = 0, dn_P = 1;
    if (IN(12) || IN(13) || IN(14)) {
#pragma unroll
        for (int e = 0; e < 8; ++e) Sdn.cnt[e] = __builtin_amdgcn_readfirstlane((int)__hip_atomic_load(F.ctl + CW_MOECNT + 64 * e, RLX_AGENT));
        const int tot = Sdn.total(), whole = (tot / F.G) * F.G;
        dn_R = tot - whole; Sdn.lim = whole;
        dn_P = (dn_R * 14 <= 192 && dn_R * 14 <= F.G) ? 14 : (dn_R * 7 <= 192 && dn_R * 7 <= F.G) ? 7 : (dn_R * 4 <= 192 && dn_R * 4 <= F.G) ? 4 : (dn_R * 2 <= 192 && dn_R * 2 <= F.G) ? 2 : 1;
        if (dn_R * dn_P > 192 || dn_R * dn_P > F.G) { Sdn.lim = tot; dn_R = 0; }
    }
    float* PART = (float*)(ws + 72 * MiB);
    if (IN(12)) REPEAT(12) {
        pg8::EpiMoeDown E{(bf16*)(ws + WS_YS)};
        pg8::gemm_phase<pg8::EpiMoeDown, pg8::MoeSched, false, true>(F.lds + RING_OFF, DFE, DFE, DFE, Sdn, E);
    }
    if (IN(13) && dn_R > 0) {
        pg8::PieceSched Sp{Sdn, Sdn.lim, dn_R, dn_P, (long)(DFE / dn_P) * 2};
        pg8::EpiPart E{PART};
        pg8::gemm_phase<pg8::EpiPart, pg8::PieceSched, false, true>(F.lds + RING_OFF, DFE / dn_P, DFE, DFE, Sp, E);
    }
    if (IN(13) && IN(14) && dn_R > 0) xcd_barrier(bar);
    if (IN(14) && dn_R > 0) {
        for (int w = F.vcu; w < dn_R * 16; w += F.G) {
            const int j = w >> 4, rl = (w & 15) * 16 + (F.tid >> 5), cl = (F.tid & 31) * 8;
            pg8::Unit u; Sdn.decode(Sdn.lim + j, u);
            if (rl < u.nvalid) {
                const float* pp = PART + (size_t)(j * dn_P) * 65536 + (size_t)rl * 256 + cl;
                f32x4 a = (f32x4){0.f, 0.f, 0.f, 0.f}, b = a;
                for (int p = 0; p < dn_P; ++p) { a += *(const GAS f32x4*)(pp + (size_t)p * 65536); b += *(const GAS f32x4*)(pp + (size_t)p * 65536 + 4); }
                const float gwt = ((const float*)u.list)[rl];
                v4u o; o.x = cvtpk(a.x * gwt, a.y * gwt); o.y = cvtpk(a.z * gwt, a.w * gwt); o.z = cvtpk(b.x * gwt, b.y * gwt); o.w = cvtpk(b.z * gwt, b.w * gwt);
                *(GAS v4u*)((bf16*)(ws + WS_YS) + (size_t)(u.r0 + rl) * D + u.c0 + cl) = o;
            }
        }
    }
    if ((IN(12) || IN(13) || IN(14)) && IN(15)) xcd_barrier(bar);
    if (IN(15)) { p_combine(F, HB1, (const bf16*)(ws + WS_YS), (const int*)(ws + WS_TOKSLOT), (float*)(ws + WS_RSTD2)); } SEAM(15);
    if (IN(16)) {
        pg8::DenseSched Sd{(const char*)HB1, (const char*)(ws + WS_WPG1), 64, 4, F.G, bx, TS1024, 0, TS1024, WGM_1U};
        pg8::EpiPle<2, true> E{HB1, (const bf16*)(ws + WS_PROJ1), Hout, (const float*)(ws + WS_RSTD2), nullptr, EPS, 0};
        pg8::gemm_phase<pg8::EpiPle<2, true>, pg8::DenseSched, false, true>(F.lds + RING_OFF, D, D, D, Sd, E);
    }
#undef IN
#undef SEAM
}
extern "C" void kernel_launch(void* const* d_in, const int* in_sizes, int n_in, void* d_out, int out_size, void* d_ws, size_t ws_size, hipStream_t stream) {
    static int grid = 0;
    if (grid == 0) {
        if (n_in != 26 || in_sizes[0] != M * D || out_size != M * D || ws_size < WS_END) { fprintf(stderr, "kernel_launch: unexpected shapes / workspace (%zu)\n", ws_size); grid = -1; return; }
        int dev = 0, cus = 0, per_cu = 0;
        if (hipGetDevice(&dev) != hipSuccess || hipDeviceGetAttribute(&cus, hipDeviceAttributeMultiprocessorCount, dev) != hipSuccess) { grid = -1; return; }
        if (hipFuncSetAttribute((const void*)mega_fwd, hipFuncAttributeMaxDynamicSharedMemorySize, LDS_BYTES) != hipSuccess) { fprintf(stderr, "kernel_launch: hipFuncSetAttribute failed\n"); grid = -1; return; }
        if (hipOccupancyMaxActiveBlocksPerMultiprocessor(&per_cu, (const void*)mega_fwd, NWAVES * 64, LDS_BYTES) != hipSuccess || per_cu < 1) { fprintf(stderr, "kernel_launch: occupancy query says %d\n", per_cu); }
        (void)hipGetLastError();
        grid = cus;
    }
    if (grid < 0) return;
    if (hipMemsetAsync((char*)d_ws + WS_CTL, 0, CTL_ZERO_BYTES, stream) != hipSuccess) return;
    Args a{};
    for (int i = 0; i < 26; ++i) a.in[i] = (const float*)d_in[i];
    a.out = (float*)d_out; a.ws = (unsigned char*)d_ws;
#if MK_N_LAUNCHES == 1
    a.ph_lo = 0; a.ph_hi = MEGA_END; a.li = 0; a.pad = 0;
    hipLaunchKernelGGL(mega_fwd, dim3(grid), dim3(NWAVES * 64), LDS_BYTES, stream, a);
#else
    for (int ph = 0; ph < MEGA_END; ++ph) { a.ph_lo = ph; a.ph_hi = ph + 1; a.li = 0; a.pad = 0; hipLaunchKernelGGL(mega_fwd, dim3(grid), dim3(NWAVES * 64), LDS_BYTES, stream, a); }
#endif
#if MEGA_END < 17
    nv::naive_suffix(MEGA_END <= 5 ? 0 : MEGA_END <= 7 ? 1 : MEGA_END <= 8 ? 2 : MEGA_END <= 10 ? 3 : 4, d_in, (float*)d_out, (char*)d_ws, stream);
#endif
}
```

```cpp
#define MEGA_END 17
#define MK_N_LAUNCHES 1
#include <hip/hip_runtime.h>
#include <cstdio>
#include <cstdint>
namespace pg8 {
#define PG8_LAS __attribute__((address_space(3)))
typedef unsigned short bf16_t;
typedef short bf16x8 __attribute__((ext_vector_type(8)));
typedef float f32x4 __attribute__((ext_vector_type(4)));
typedef float f32x2 __attribute__((ext_vector_type(2)));
typedef unsigned u32x4 __attribute__((ext_vector_type(4)));
typedef unsigned u32x2 __attribute__((ext_vector_type(2)));
constexpr int BM = 256, BK = 64, HALF = 128, HTB = HALF * BK * 2  , STAGE_BYTES = 8 * HTB, NXCD = 8;

__host__ __device__ __forceinline__ int lds_byte(int r, int c) { const int st = (r >> 4) * 2 + (c >> 5), rr = r & 15, cc = c & 31, ob = rr * 64 + cc * 2; return st * 1024 + (ob ^ (((ob >> 9) & 1) << 5)); }
__host__ __device__ __forceinline__ void stage_rc(int b, int& R, int& C) { const int st = b / 1024, sb = b % 1024, swz = sb ^ (((sb >> 9) & 1) << 5); R = (st >> 1) * 16 + swz / 64; C = (st & 1) * 32 + (swz % 64) / 2; }
__host__ __device__ __forceinline__ int perm32(int rho) { const int n = rho >> 4, i = rho & 15; return 8 * (i >> 2) + 4 * n + (i & 3); }

struct Unit { const char* A; const char* B; const int* list; int r0, c0, nvalid, ex; };
struct Pre { float rs[2][4]; };

__device__ __forceinline__ unsigned cvt_pk_bf16(float lo, float hi) { unsigned r; asm volatile("v_cvt_pk_bf16_f32 %0, %1, %2" : "=v"(r) : "v"(lo), "v"(hi)); return r; }
__device__ __forceinline__ float bf_lo(unsigned w) { return __uint_as_float(w << 16); }
__device__ __forceinline__ float bf_hi(unsigned w) { return __uint_as_float(w & 0xffff0000u); }

__device__ __forceinline__ void tile_of(int L, int nM, int nN, int& pm, int& pn, int WGM = 8) {
    const int nwg = nM * nN; int wgid = L; { const int q = nwg / NXCD, r = nwg % NXCD, xcd = wgid % NXCD, off = wgid / NXCD; wgid = (xcd < r ? xcd * (q + 1) : r * (q + 1) + (xcd - r) * q) + off; }
    const int nig = WGM * nN, gid = wgid / nig, fm = gid * WGM, gsz = (nM - fm) < WGM ? (nM - fm) : WGM;
    pm = fm + ((wgid % nig) % gsz); pn = (wgid % nig) / gsz;
}
struct DenseSched {
    const char* A; const char* B; int nM, nN, G, c; long a_pm, a_pn, b_pn; int wgm;
    __device__ __forceinline__ bool next(int i, Unit& u) const {
        if (c < 0) return false; const long L = (long)i * G + c; if (L >= (long)nM * nN) return false;
        int pm, pn; tile_of((int)L, nM, nN, pm, pn, wgm);
        u.A = A + pm * a_pm + pn * a_pn; u.B = B + pn * b_pn; u.list = nullptr; u.r0 = pm * BM; u.c0 = pn * BM; u.nvalid = BM; u.ex = 0; return true;
    }
};
struct ProjSched {
    const char* A0; const char* B0; long dA, dB; int G, c;
    __device__ __forceinline__ bool next(int i, Unit& u) const {
        if (c < 0) return false; const long L = (long)i * G + c; if (L >= 64 * 8) return false;
        int pm, pn; tile_of((int)L, 64, 8, pm, pn, 8); const int layer = pn >> 2, pc = pn & 3;
        u.A = A0 + layer * dA + (long)pm * (256 * 256 * 2); u.B = B0 + layer * dB + (long)pc * (256 * 256 * 2); u.list = nullptr; u.r0 = pm * BM; u.c0 = pc * BM; u.nvalid = BM; u.ex = layer; return true;
    }
};
struct MoeSched {
    const char* A; const char* B; const int* lists; int cnt[8]; int nN, G, c; long b_e, b_pn, a_row; int list_stride; bool gather; int lim; int WGM;
    __device__ __forceinline__ int total() const { int tot = 0;
#pragma unroll
        for (int e = 0; e < 8; ++e) tot += ((cnt[e] + 255) >> 8) * nN;
        return tot; }
    __device__ __forceinline__ void decode(int L, Unit& u) const {
        const int tot = total();
        int w = L; { const int q = tot / NXCD, r = tot % NXCD, xcd = w % NXCD, off = w / NXCD; w = (xcd < r ? xcd * (q + 1) : r * (q + 1) + (xcd - r) * q) + off; }
        int ex = 0, off_rows = 0, tiles = 0, ce = 0; bool found = false;
#pragma unroll
        for (int e = 0; e < 8; ++e) { const int t = (cnt[e] + 255) >> 8, ue = t * nN; if (!found) { if (w < ue) { found = true; ex = e; tiles = t; ce = cnt[e]; } else { w -= ue; off_rows += cnt[e]; } } }
        const int nig = WGM * nN, gid = w / nig, fm = gid * WGM, gsz = (tiles - fm) < WGM ? (tiles - fm) : WGM;
        const int pm = fm + ((w % nig) % gsz), pn = (w % nig) / gsz;
        u.r0 = off_rows + pm * BM; u.c0 = pn * BM; u.nvalid = (ce - pm * BM) < BM ? (ce - pm * BM) : BM; u.ex = ex;
        u.B = B + ex * b_e + pn * b_pn;
        u.list = lists + (long)ex * list_stride + pm * BM;
        u.A = gather ? A : A + (long)u.r0 * a_row;
    }
    __device__ __forceinline__ bool next(int i, Unit& u) const {
        const long L0 = (long)i * G + c; if (L0 >= lim) return false;
        decode((int)L0, u); return true;
    }
};
struct PieceSched {
    MoeSched S; int L0, R, P; long kbytes;
    __device__ __forceinline__ bool next(int i, Unit& u) const {
        if (i != 0 || S.c >= R * P) return false;
        const int q = S.c, j = q / P, p = q - j * P;
        S.decode(L0 + j, u); u.A += p * kbytes; u.B += p * kbytes; u.ex = q; return true;
    }
};

template <class Epi, class Sched, bool GATHER, bool ALIGN_EPI>
__device__ __forceinline__ void gemm_phase(PG8_LAS unsigned char* lds, const int K, const int lda, const int ldb, const Sched& S, const Epi& E) {
    int tid_ = threadIdx.x; asm volatile("" : "+v"(tid_));
    const int tid = tid_, wid = __builtin_amdgcn_readfirstlane(tid >> 6), lane = tid & 63, wr = wid >> 2, wc = wid & 3, fr = lane & 15, fq = lane >> 4;
    int Kr_ = K; asm volatile("" : "+s"(Kr_));
    const int nt = Kr_ / BK;
    int RA[2], CA[2]; unsigned voffB[2];
#pragma unroll
    for (int i = 0; i < 2; ++i) { int R, C; stage_rc(tid * 16 + i * 8192, R, C); RA[i] = R; CA[i] = C; const int Rb = Epi::PERM ? ((R & ~31) + perm32(R & 31)) : R; voffB[i] = (unsigned)(Rb * ldb + C) * 2u; }
    const size_t kstep = (size_t)(BK * 2);
    const size_t hstep = (size_t)HALF * ldb * 2;
    const unsigned ldsw = (unsigned)wid * 1024u;
    const int aoff = lds_byte(wr * 64 + fr, fq * 8), boff = lds_byte(wc * 32 + fr, fq * 8);
#define PG8_SA(b, h) (((b) * 2 + (h)) * HTB)
#define PG8_SB(b, h) ((4 + (b) * 2 + (h)) * HTB)
#define PG8_STAGE(bufoff, gbase, voff) do { _Pragma("unroll") for (int _i = 0; _i < 2; ++_i) \
        __builtin_amdgcn_global_load_lds((const unsigned*)((const char*)(gbase) + (voff)[_i]), (PG8_LAS unsigned*)(lds + (bufoff) + ldsw + _i * 8192), 16, 0, 0); } while (0)
#define PG8_SETOFF(v, u) do { _Pragma("unroll") for (int _h = 0; _h < 2; ++_h) _Pragma("unroll") for (int _i = 0; _i < 2; ++_i) { const int _r = _h * HALF + RA[_i]; \
        if constexpr (GATHER) { const int _rr = _r < (u).nvalid ? _r : (u).nvalid - 1; v[_h][_i] = (unsigned)(u).list[_rr] * (unsigned)(lda * 2) + (unsigned)(CA[_i] * 2); } \
        else { v[_h][_i] = (unsigned)(_r * lda + CA[_i]) * 2u; } } } while (0)
#define PG8_LDA(dst, b, h) do { _Pragma("unroll") for (int m = 0; m < 4; ++m) _Pragma("unroll") for (int k = 0; k < 2; ++k) dst[m][k] = *(const PG8_LAS bf16x8*)(lds + PG8_SA(b, h) + aoff + m * 2048 + k * 1024); } while (0)
#define PG8_LDB(dst, b, h) do { _Pragma("unroll") for (int n = 0; n < 2; ++n) _Pragma("unroll") for (int k = 0; k < 2; ++k) dst[n][k] = *(const PG8_LAS bf16x8*)(lds + PG8_SB(b, h) + boff + n * 2048 + k * 1024); } while (0)
#define PG8_MMA(ai, bj, At, Bt) do { __builtin_amdgcn_s_setprio(1); _Pragma("unroll") for (int m = 0; m < 4; ++m) _Pragma("unroll") for (int n = 0; n < 2; ++n) _Pragma("unroll") for (int k = 0; k < 2; ++k) \
        acc[ai][bj][m][n] = __builtin_amdgcn_mfma_f32_16x16x32_bf16(Bt[n][k], At[m][k], acc[ai][bj][m][n], 0, 0, 0); __builtin_amdgcn_s_setprio(0); } while (0)
#define PG8_WAIT_V(n) asm volatile("s_waitcnt vmcnt(" #n ")" ::: "memory")
#define PG8_WAIT_L(n) asm volatile("s_waitcnt lgkmcnt(" #n ")" ::: "memory")
#define PG8_BAR __builtin_amdgcn_s_barrier()
#define PG8_SCHED __builtin_amdgcn_sched_barrier(0)
    Unit cur, nxt; int ui = 0;
    if (!S.next(0, cur)) return;
    unsigned va[2][2], vn[2][2];
    PG8_SETOFF(va, cur);
    Pre pre; E.prefetch(cur, wr, fr, pre);
#pragma unroll
    for (int h = 0; h < 2; ++h)
#pragma unroll
        for (int i = 0; i < 2; ++i) vn[h][i] = va[h][i];
    f32x4 acc[2][2][4][2];
#pragma unroll
    for (int a = 0; a < 2; ++a)
#pragma unroll
        for (int b = 0; b < 2; ++b)
#pragma unroll
            for (int m = 0; m < 4; ++m)
#pragma unroll
                for (int n = 0; n < 2; ++n) acc[a][b][m][n] = (f32x4){0.f, 0.f, 0.f, 0.f};
    bf16x8 At[4][2], B0[2][2], B1[2][2];
    const char* cA = cur.A; const char* cB = cur.B;
    PG8_STAGE(PG8_SB(0, 0), cB, voffB); PG8_STAGE(PG8_SB(0, 1), cB + hstep, voffB); PG8_STAGE(PG8_SA(0, 0), cA, va[0]); PG8_STAGE(PG8_SA(0, 1), cA, va[1]);
    if (wr == 1) PG8_BAR;
    PG8_WAIT_V(2); PG8_BAR;
    PG8_STAGE(PG8_SB(1, 0), cB + kstep, voffB); PG8_STAGE(PG8_SA(1, 0), cA + kstep, va[0]); PG8_STAGE(PG8_SB(1, 1), cB + hstep + kstep, voffB);
    PG8_WAIT_V(6); PG8_BAR;
    for (;;) {
        const bool has_next = S.next(ui + 1, nxt);
        if constexpr (GATHER) { if (has_next) {
#pragma unroll
            for (int h = 0; h < 2; ++h)
#pragma unroll
                for (int i = 0; i < 2; ++i) { const int r_ = h * HALF + RA[i]; vn[h][i] = (unsigned)nxt.list[r_ < nxt.nvalid ? r_ : nxt.nvalid - 1]; } } }
        const char* nA = has_next ? nxt.A : cA; const char* nB = has_next ? nxt.B : cB;
        for (int t = 0; t < nt; t += 2) {
            const bool last = (t == nt - 2);
            const char* a1 = cA + (size_t)(t + 1) * kstep;
            const char* a2 = last ? nA : cA + (size_t)(t + 2) * kstep; const char* b2 = last ? nB : cB + (size_t)(t + 2) * kstep;
            const char* a3 = a2 + kstep; const char* b3 = b2 + kstep;
            unsigned o2[2][2];
#pragma unroll
            for (int h = 0; h < 2; ++h)
#pragma unroll
                for (int i = 0; i < 2; ++i) { if constexpr (GATHER) o2[h][i] = (last && has_next) ? vn[h][i] * (unsigned)(lda * 2) + (unsigned)(CA[i] * 2) : va[h][i]; else o2[h][i] = va[h][i]; }
            PG8_LDB(B0, 0, 0); PG8_LDB(B1, 0, 1); PG8_SCHED; PG8_LDA(At, 0, 0); PG8_STAGE(PG8_SA(1, 1), a1, va[1]);
            PG8_WAIT_V(8); PG8_WAIT_L(0); PG8_BAR; PG8_MMA(0, 0, At, B0); PG8_MMA(0, 1, At, B1); PG8_BAR; PG8_SCHED;
            PG8_LDA(At, 0, 1); PG8_STAGE(PG8_SB(0, 0), b2, voffB); PG8_STAGE(PG8_SB(0, 1), b2 + hstep, voffB); PG8_STAGE(PG8_SA(0, 0), a2, o2[0]);
            PG8_WAIT_V(8); PG8_WAIT_L(0); PG8_BAR; PG8_MMA(1, 0, At, B0); PG8_MMA(1, 1, At, B1); PG8_BAR; PG8_SCHED;
            PG8_LDB(B0, 1, 0); PG8_LDB(B1, 1, 1); PG8_SCHED; PG8_LDA(At, 1, 0); PG8_STAGE(PG8_SA(0, 1), a2, o2[1]);
            PG8_WAIT_V(8); PG8_WAIT_L(0); PG8_BAR; PG8_MMA(0, 0, At, B0); PG8_MMA(0, 1, At, B1); PG8_BAR; PG8_SCHED;
            PG8_LDA(At, 1, 1); PG8_STAGE(PG8_SB(1, 0), b3, voffB); PG8_STAGE(PG8_SB(1, 1), b3 + hstep, voffB); PG8_STAGE(PG8_SA(1, 0), a3, o2[0]);
            PG8_WAIT_V(8); PG8_WAIT_L(0); PG8_BAR; PG8_MMA(1, 0, At, B0); PG8_MMA(1, 1, At, B1); PG8_BAR; PG8_SCHED;
        }
        if constexpr (ALIGN_EPI) { if (wr == 0) PG8_BAR; }
        E(acc, cur, wr, wc, fr, fq, pre);
        if (!has_next) break;
#pragma unroll
        for (int a = 0; a < 2; ++a)
#pragma unroll
            for (int b = 0; b < 2; ++b)
#pragma unroll
                for (int m = 0; m < 4; ++m)
#pragma unroll
                    for (int n = 0; n < 2; ++n) acc[a][b][m][n] = (f32x4){0.f, 0.f, 0.f, 0.f};
        cur = nxt; cA = nA; cB = nB; ++ui;
        E.prefetch(cur, wr, fr, pre);
#pragma unroll
        for (int h = 0; h < 2; ++h)
#pragma unroll
            for (int i = 0; i < 2; ++i) { if constexpr (GATHER) va[h][i] = vn[h][i] * (unsigned)(lda * 2) + (unsigned)(CA[i] * 2); else va[h][i] = vn[h][i]; }
        if constexpr (ALIGN_EPI) { if (wr == 1) PG8_BAR; }
    }
    PG8_WAIT_V(0);
    if constexpr (!ALIGN_EPI) { if (wr == 0) PG8_BAR; }
    PG8_BAR;
#undef PG8_SA
#undef PG8_SB
#undef PG8_STAGE
#undef PG8_SETOFF
#undef PG8_LDA
#undef PG8_LDB
#undef PG8_MMA
#undef PG8_WAIT_V
#undef PG8_WAIT_L
#undef PG8_BAR
#undef PG8_SCHED
}
}
namespace pg8 {
constexpr float LOG2E = 1.4426950408889634f;
__device__ __forceinline__ float fast_sigmoid(float v) { return __builtin_amdgcn_rcpf(1.f + __builtin_amdgcn_exp2f(-v * LOG2E)); }
__device__ __forceinline__ f32x4 sig4(f32x4 v) { return (f32x4){fast_sigmoid(v[0]), fast_sigmoid(v[1]), fast_sigmoid(v[2]), fast_sigmoid(v[3])}; }
__device__ __forceinline__ u32x4 pack8(f32x4 a, f32x4 b) { u32x4 w; w.x = cvt_pk_bf16(a[0], a[1]); w.y = cvt_pk_bf16(a[2], a[3]); w.z = cvt_pk_bf16(b[0], b[1]); w.w = cvt_pk_bf16(b[2], b[3]); return w; }

struct EpiQKV {
    static constexpr bool PERM = true;
    bf16_t* Q; size_t split_stride  ; const float* qkn  ; const float* cosT; const float* sinT; float c2, eps;
    __device__ __forceinline__ void prefetch(const Unit&, int, int, Pre&) const {}
    __device__ __forceinline__ void operator()(const f32x4 (&acc)[2][2][4][2], const Unit& u, int wr, int wc, int fr, int fq, const Pre& pre) const {
        const int which = u.c0 >> 10, colt = u.c0 & 1023;
        bf16_t* base = Q + (size_t)which * split_stride;
        const int ocol = colt + 64 * wc + 8 * fq;
        if (which == 2) {
#pragma unroll
            for (int ai = 0; ai < 2; ++ai)
#pragma unroll
                for (int m = 0; m < 4; ++m) { bf16_t* rowp = base + (size_t)(u.r0 + ai * HALF + wr * 64 + m * 16 + fr) * 1024 + ocol;
#pragma unroll
                    for (int bj = 0; bj < 2; ++bj) *(u32x4*)(rowp + 32 * bj) = pack8(acc[ai][bj][m][0], acc[ai][bj][m][1]); }
        } else {
            const float* gp = qkn + 64 * which; const float sc = which == 0 ? c2 : 1.f;
            f32x4 g[2][2];
#pragma unroll
            for (int bj = 0; bj < 2; ++bj)
#pragma unroll
                for (int n = 0; n < 2; ++n) g[bj][n] = *(const f32x4*)(gp + 32 * bj + 8 * fq + 4 * n);
#pragma unroll
            for (int ai = 0; ai < 2; ++ai)
#pragma unroll
                for (int m = 0; m < 4; ++m) {
                    const int row = u.r0 + ai * HALF + wr * 64 + m * 16 + fr, pos = row & 2047;
                    f32x4 c[2], s[2];
#pragma unroll
                    for (int n = 0; n < 2; ++n) { c[n] = *(const f32x4*)(cosT + pos * 32 + 8 * fq + 4 * n); s[n] = *(const f32x4*)(sinT + pos * 32 + 8 * fq + 4 * n); }
                    float ss = 0.f;
#pragma unroll
                    for (int bj = 0; bj < 2; ++bj)
#pragma unroll
                        for (int n = 0; n < 2; ++n) { const f32x4 v = acc[ai][bj][m][n]; ss += (v[0] * v[0] + v[1] * v[1]) + (v[2] * v[2] + v[3] * v[3]); }
                    ss += __shfl_xor(ss, 16); ss += __shfl_xor(ss, 32);
                    const float rstd = __builtin_amdgcn_rsqf(ss * (1.f / 64.f) + eps);
                    f32x4 o0[2], o1[2];
#pragma unroll
                    for (int n = 0; n < 2; ++n) { const f32x4 y0 = acc[ai][0][m][n] * rstd * g[0][n], y1 = acc[ai][1][m][n] * rstd * g[1][n];
                        o0[n] = (y0 * c[n] - y1 * s[n]) * sc; o1[n] = (y1 * c[n] + y0 * s[n]) * sc; }
                    bf16_t* rowp = base + (size_t)row * 1024 + ocol;
                    *(u32x4*)(rowp) = pack8(o0[0], o0[1]); *(u32x4*)(rowp + 32) = pack8(o1[0], o1[1]);
                }
        }
    }
};
__device__ __forceinline__ float row_rstd(const float* ssqp, int row, float eps) {
    const f32x4* p = (const f32x4*)(ssqp + (size_t)row * 16); const f32x4 a = p[0], b = p[1], c = p[2], d = p[3];
    const float s = (((a[0] + a[1]) + (a[2] + a[3])) + ((b[0] + b[1]) + (b[2] + b[3]))) + (((c[0] + c[1]) + (c[2] + c[3])) + ((d[0] + d[1]) + (d[2] + d[3])));
    return __builtin_amdgcn_rsqf(s * (1.f / 1024.f) + eps);
}
__device__ __forceinline__ f32x4 bf4(u32x2 w) { return (f32x4){bf_lo(w.x), bf_hi(w.x), bf_lo(w.y), bf_hi(w.y)}; }
template <bool BASE_BF16> struct EpiResNorm {
    static constexpr bool PERM = true;
    const void* base; bf16_t* hb; float* ssqp;
    __device__ __forceinline__ void prefetch(const Unit&, int, int, Pre&) const {}
    __device__ __forceinline__ void operator()(const f32x4 (&acc)[2][2][4][2], const Unit& u, int wr, int wc, int fr, int fq, const Pre& pre) const {
        const int col0 = u.c0 + wc * 32 + 8 * fq;
#pragma unroll
        for (int ai = 0; ai < 2; ++ai)
#pragma unroll
            for (int m = 0; m < 4; ++m) { const int row = u.r0 + ai * HALF + wr * 64 + m * 16 + fr; const size_t off = (size_t)row * 1024 + col0; float ss = 0.f;
#pragma unroll
                for (int bj = 0; bj < 2; ++bj) { const size_t o2 = off + bj * HALF;
                    f32x4 b0, b1;
                    if constexpr (BASE_BF16) { const u32x4 bw = *(const u32x4*)((const bf16_t*)base + o2); b0 = bf4((u32x2){bw.x, bw.y}); b1 = bf4((u32x2){bw.z, bw.w}); }
                    else { b0 = *(const f32x4*)((const float*)base + o2); b1 = *(const f32x4*)((const float*)base + o2 + 4); }
                    const u32x4 w = pack8(b0 + acc[ai][bj][m][0], b1 + acc[ai][bj][m][1]); *(u32x4*)(hb + o2) = w;
                    const f32x4 h0 = bf4((u32x2){w.x, w.y}), h1 = bf4((u32x2){w.z, w.w});
                    ss += ((h0[0] * h0[0] + h0[1] * h0[1]) + (h0[2] * h0[2] + h0[3] * h0[3])) + ((h1[0] * h1[0] + h1[1] * h1[1]) + (h1[2] * h1[2] + h1[3] * h1[3])); }
                ss += __shfl_xor(ss, 16); ss += __shfl_xor(ss, 32);
                if (fq == 0) ssqp[(size_t)row * 16 + (u.c0 >> 8) * 4 + wc] = ss; }
    }
};
template <int RS  > struct EpiSwiGLU {
    static constexpr bool PERM = true;
    bf16_t* O; int ldo; float eps; const float* ssqp; const int* lists_base;
    __device__ __forceinline__ void prefetch(const Unit& u, int wr, int fr, Pre& pre) const {
#pragma unroll
        for (int ai = 0; ai < 2; ++ai)
#pragma unroll
            for (int m = 0; m < 4; ++m) { const int rl = ai * HALF + wr * 64 + m * 16 + fr;
                if constexpr (RS == 1) pre.rs[ai][m] = row_rstd(ssqp, u.r0 + rl, eps); else pre.rs[ai][m] = ssqp[(u.list - lists_base) + (rl < u.nvalid ? rl : u.nvalid - 1)]; }
    }
    __device__ __forceinline__ void operator()(const f32x4 (&acc)[2][2][4][2], const Unit& u, int wr, int wc, int fr, int fq, const Pre& pre) const {
        const int col0 = (u.c0 >> 1) + wc * 32 + 8 * fq;
#pragma unroll
        for (int ai = 0; ai < 2; ++ai)
#pragma unroll
            for (int m = 0; m < 4; ++m) { const int rl = ai * HALF + wr * 64 + m * 16 + fr;
                const float rs = pre.rs[ai][m];
                f32x4 o[2];
#pragma unroll
                for (int n = 0; n < 2; ++n) { const f32x4 gt = acc[ai][0][m][n] * rs, up = acc[ai][1][m][n] * rs; o[n] = gt * sig4(gt) * up; }
                if (rl < u.nvalid) *(u32x4*)(O + (size_t)(u.r0 + rl) * ldo + col0) = pack8(o[0], o[1]); }
    }
};
struct EpiProj {
    static constexpr bool PERM = true;
    bf16_t* P0; long dP;
    __device__ __forceinline__ void prefetch(const Unit&, int, int, Pre&) const {}
    __device__ __forceinline__ void operator()(const f32x4 (&acc)[2][2][4][2], const Unit& u, int wr, int wc, int fr, int fq, const Pre& pre) const {
        bf16_t* base = P0 + u.ex * dP; const int col0 = u.c0 + wc * 32 + 8 * fq;
#pragma unroll
        for (int ai = 0; ai < 2; ++ai)
#pragma unroll
            for (int m = 0; m < 4; ++m) { bf16_t* rowp = base + (size_t)(u.r0 + ai * HALF + wr * 64 + m * 16 + fr) * 1024 + col0;
#pragma unroll
                for (int bj = 0; bj < 2; ++bj) *(u32x4*)(rowp + bj * HALF) = pack8(acc[ai][bj][m][0], acc[ai][bj][m][1]); }
    }
};
template <int RS, bool OUT_F32> struct EpiPle {
    static constexpr bool PERM = true;
    const bf16_t* Hin; const bf16_t* P; void* out; const float* ssq_in; float* ssq_out; float eps; int pad;
    __device__ __forceinline__ void prefetch(const Unit& u, int wr, int fr, Pre& pre) const {
#pragma unroll
        for (int ai = 0; ai < 2; ++ai)
#pragma unroll
            for (int m = 0; m < 4; ++m) { const int row = u.r0 + ai * HALF + wr * 64 + m * 16 + fr;
                if constexpr (RS == 1) pre.rs[ai][m] = row_rstd(ssq_in, row, eps); else pre.rs[ai][m] = ssq_in[row]; }
    }
    __device__ __forceinline__ void operator()(const f32x4 (&acc)[2][2][4][2], const Unit& u, int wr, int wc, int fr, int fq, const Pre& pre) const {
        const int col0 = u.c0 + wc * 32 + 8 * fq;
#pragma unroll
        for (int ai = 0; ai < 2; ++ai)
#pragma unroll
            for (int m = 0; m < 4; ++m) { const int row = u.r0 + ai * HALF + wr * 64 + m * 16 + fr; const size_t off = (size_t)row * 1024 + col0; float ss = 0.f;
                const float rs = pre.rs[ai][m];
#pragma unroll
                for (int bj = 0; bj < 2; ++bj) { const size_t o2 = off + bj * HALF;
                    const u32x4 hw = *(const u32x4*)(Hin + o2), pw = *(const u32x4*)(P + o2);
                    const f32x4 h0 = bf4((u32x2){hw.x, hw.y}) + sig4(acc[ai][bj][m][0] * rs) * bf4((u32x2){pw.x, pw.y});
                    const f32x4 h1 = bf4((u32x2){hw.z, hw.w}) + sig4(acc[ai][bj][m][1] * rs) * bf4((u32x2){pw.z, pw.w});
                    if constexpr (OUT_F32) { *(f32x4*)((float*)out + o2) = h0; *(f32x4*)((float*)out + o2 + 4) = h1; }
                    else { const u32x4 w = pack8(h0, h1); *(u32x4*)((bf16_t*)out + o2) = w; const f32x4 r0 = bf4((u32x2){w.x, w.y}), r1 = bf4((u32x2){w.z, w.w});
                        ss += ((r0[0] * r0[0] + r0[1] * r0[1]) + (r0[2] * r0[2] + r0[3] * r0[3])) + ((r1[0] * r1[0] + r1[1] * r1[1]) + (r1[2] * r1[2] + r1[3] * r1[3])); } }
                if constexpr (!OUT_F32) { ss += __shfl_xor(ss, 16); ss += __shfl_xor(ss, 32); if (fq == 0) ssq_out[(size_t)row * 16 + (u.c0 >> 8) * 4 + wc] = ss; } }
    }
};
struct EpiPool {
    static constexpr bool PERM = true;
    bf16_t* HB; const float* bias; const float* scale;
    __device__ __forceinline__ void prefetch(const Unit&, int, int, Pre&) const {}
    __device__ __forceinline__ void operator()(const f32x4 (&acc)[2][2][4][2], const Unit& u, int wr, int wc, int fr, int fq, const Pre& pre) const {
        const int col0 = u.c0 + wc * 32 + 8 * fq;
#pragma unroll
        for (int bj = 0; bj < 2; ++bj) { const f32x4 bv0 = *(const f32x4*)(bias + col0 + bj * HALF), bv1 = *(const f32x4*)(bias + col0 + bj * HALF + 4), sv0 = *(const f32x4*)(scale + col0 + bj * HALF), sv1 = *(const f32x4*)(scale + col0 + bj * HALF + 4);
#pragma unroll
            for (int ai = 0; ai < 2; ++ai)
#pragma unroll
                for (int m = 0; m < 4; ++m) { const size_t o2 = (size_t)(u.r0 + ai * HALF + wr * 64 + m * 16 + fr) * 1024 + col0 + bj * HALF;
                    const u32x4 hw = *(const u32x4*)(HB + o2);
                    *(u32x4*)(HB + o2) = pack8(bf4((u32x2){hw.x, hw.y}) + (acc[ai][bj][m][0] + bv0) * sv0, bf4((u32x2){hw.z, hw.w}) + (acc[ai][bj][m][1] + bv1) * sv1); } }
    }
};
struct EpiMoeDown {
    static constexpr bool PERM = true;
    bf16_t* Ys;
    __device__ __forceinline__ void prefetch(const Unit& u, int wr, int fr, Pre& pre) const { const float* gw = (const float*)u.list;
#pragma unroll
        for (int ai = 0; ai < 2; ++ai)
#pragma unroll
            for (int m = 0; m < 4; ++m) { const int rl = ai * HALF + wr * 64 + m * 16 + fr; pre.rs[ai][m] = gw[rl < u.nvalid ? rl : u.nvalid - 1]; }
    }
    __device__ __forceinline__ void operator()(const f32x4 (&acc)[2][2][4][2], const Unit& u, int wr, int wc, int fr, int fq, const Pre& pre) const {
        const int col0 = u.c0 + wc * 32 + 8 * fq;
#pragma unroll
        for (int ai = 0; ai < 2; ++ai)
#pragma unroll
            for (int m = 0; m < 4; ++m) { const int rl = ai * HALF + wr * 64 + m * 16 + fr;
                if (rl < u.nvalid) { const float g = pre.rs[ai][m]; bf16_t* rowp = Ys + (size_t)(u.r0 + rl) * 1024 + col0;
#pragma unroll
                    for (int bj = 0; bj < 2; ++bj) *(u32x4*)(rowp + bj * HALF) = pack8(acc[ai][bj][m][0] * g, acc[ai][bj][m][1] * g); } }
    }
};
struct EpiPart {
    static constexpr bool PERM = false;
    float* PART;
    __device__ __forceinline__ void prefetch(const Unit&, int, int, Pre&) const {}
    __device__ __forceinline__ void operator()(const f32x4 (&acc)[2][2][4][2], const Unit& u, int wr, int wc, int fr, int fq, const Pre& pre) const {
        float* base = PART + (size_t)u.ex * 65536 + wc * 32 + 4 * fq;
#pragma unroll
        for (int ai = 0; ai < 2; ++ai)
#pragma unroll
            for (int m = 0; m < 4; ++m) { float* rowp = base + (size_t)(ai * HALF + wr * 64 + m * 16 + fr) * 256;
#pragma unroll
                for (int bj = 0; bj < 2; ++bj)
#pragma unroll
                    for (int n = 0; n < 2; ++n) *(f32x4*)(rowp + bj * HALF + n * 16) = acc[ai][bj][m][n]; }
    }
};
}
#include <hip/hip_bf16.h>
#include <cmath>
namespace attn_body {
using bf16=__hip_bfloat16;
using bf16x8=__attribute__((ext_vector_type(8)))short;
using s16x4=__attribute__((ext_vector_type(4)))short;
using f32x16=__attribute__((ext_vector_type(16)))float;
using u32x4=__attribute__((ext_vector_type(4)))unsigned;
constexpr int BATCH=8,SEQ=2048,D=64,DM=1024;
constexpr int NW=8,QBLK=32,QB=QBLK*NW,KVBLK=64,NQB=SEQ/QB;
constexpr int ATTN_PITCH=DM, ATTN_UNIT_ROWS=QB;
__device__ __forceinline__ int crow(int r,int hi){return (r&3)+8*(r>>2)+4*hi;}
#define SBAR() __builtin_amdgcn_sched_barrier(0)
__device__ __forceinline__ void cmask(f32x16&p0,f32x16&p1,int jb,int qrel,int hi){
  const float NEG=-INFINITY; int kb=64*jb+4*hi;
  #pragma unroll
  for(int r=0;r<16;++r){int kv=kb+(r&3)+8*(r>>2); if(kv>qrel)p0[r]=NEG; if(kv+32>qrel)p1[r]=NEG;}
}

constexpr int NSLOT=3, SLOTB=8192;
constexpr int LDS_K=0, LDS_V=NSLOT*SLOTB, LDS_WS=2*NSLOT*SLOTB, LDS_OST=LDS_WS+NW*64*4, LDS_BYTES=LDS_OST+NW*4096;
constexpr float C2=0.125f*1.4426950408889634f;
__device__ __forceinline__ void glds16(const void*gsrc,unsigned lds_dst){unsigned keep;
  asm volatile("s_mov_b32 %0, m0\n\ts_mov_b32 m0, %2\n\ts_nop 0\n\tglobal_load_lds_dwordx4 %1, off\n\ts_mov_b32 m0, %0":"=&s"(keep):"v"(gsrc),"s"(lds_dst):"memory");}
__device__ __forceinline__ float max3f(float a,float b,float c){float r;asm("v_max3_f32 %0, %1, %2, %3":"=v"(r):"v"(a),"v"(b),"v"(c));return r;}
__device__ __forceinline__ float max2f(float a,float b){float r;asm("v_max_f32_e32 %0, %1, %2":"=v"(r):"v"(a),"v"(b));return r;}
__device__ __forceinline__ float fadd_s(float a,float b){float r;asm("v_add_f32_e32 %0, %1, %2":"=v"(r):"v"(a),"v"(b));return r;}
__device__ __forceinline__ float fsub_s(float a,float b){float r;asm("v_sub_f32_e32 %0, %1, %2":"=v"(r):"v"(a),"v"(b));return r;}
typedef float f32x2_t __attribute__((ext_vector_type(2))); typedef __bf16 bf16x2_t __attribute__((ext_vector_type(2)));
__device__ __forceinline__ unsigned cvtpk_s(float lo,float hi){f32x2_t v={lo,hi};bf16x2_t b=__builtin_convertvector(v,bf16x2_t);return __builtin_bit_cast(unsigned,b);}
#define WAIT_BAR(N) asm volatile("s_waitcnt vmcnt(" #N ") lgkmcnt(0)\n\ts_barrier":::"memory")

__device__ __forceinline__ void qkt(f32x16&p0,f32x16&p1,const char*Kslot,const bf16x8*qr,const f32x16&negm,int r32,int hi){
  const char*kb=Kslot+hi*1024+r32*16;
  #pragma unroll
  for(int d0=0;d0<4;++d0){
    const bf16x8 b0=*reinterpret_cast<const bf16x8*>(kb+d0*2048);
    const bf16x8 b1=*reinterpret_cast<const bf16x8*>(kb+d0*2048+512);
    if(d0==0){p0=__builtin_amdgcn_mfma_f32_32x32x16_bf16(b0,qr[0],negm,0,0,0);p1=__builtin_amdgcn_mfma_f32_32x32x16_bf16(b1,qr[0],negm,0,0,0);}
    else{p0=__builtin_amdgcn_mfma_f32_32x32x16_bf16(b0,qr[d0],p0,0,0,0);p1=__builtin_amdgcn_mfma_f32_32x32x16_bf16(b1,qr[d0],p1,0,0,0);}}
}
typedef __attribute__((address_space(3))) const char* lds_cptr;
typedef short v4i16_t __attribute__((ext_vector_type(4)));
__device__ __forceinline__ void kload8(bf16x8*kf,lds_cptr kp){
  kf[0]=*(const __attribute__((address_space(3))) bf16x8*)(kp);      kf[1]=*(const __attribute__((address_space(3))) bf16x8*)(kp+512);
  kf[2]=*(const __attribute__((address_space(3))) bf16x8*)(kp+2048); kf[3]=*(const __attribute__((address_space(3))) bf16x8*)(kp+2560);
  kf[4]=*(const __attribute__((address_space(3))) bf16x8*)(kp+4096); kf[5]=*(const __attribute__((address_space(3))) bf16x8*)(kp+4608);
  kf[6]=*(const __attribute__((address_space(3))) bf16x8*)(kp+6144); kf[7]=*(const __attribute__((address_space(3))) bf16x8*)(kp+6656);
}
__device__ __forceinline__ void kload2(bf16x8*kf,lds_cptr kp,int j){ kf[2*j]=*(const __attribute__((address_space(3))) bf16x8*)(kp+j*2048); kf[2*j+1]=*(const __attribute__((address_space(3))) bf16x8*)(kp+j*2048+512); }
__device__ __forceinline__ s16x4 vtr(lds_cptr p){ return __builtin_bit_cast(s16x4,__builtin_amdgcn_ds_read_tr16_b64_v4i16((__attribute__((address_space(3))) v4i16_t*)p)); }
__device__ __forceinline__ float rowmax(const f32x16&p0,const f32x16&p1){
  float a=max3f(p0[0],p0[1],p1[0]),b=max3f(p0[2],p0[3],p1[1]);a=max3f(a,p1[2],p1[3]);
  #pragma unroll
  for(int r=4;r<16;r+=4){a=max3f(a,p0[r],p0[r+1]);b=max3f(b,p0[r+2],p0[r+3]);a=max3f(a,p1[r],p1[r+1]);b=max3f(b,p1[r+2],p1[r+3]);}
  const float m=max2f(a,b);
  auto rr=__builtin_amdgcn_permlane32_swap(__float_as_uint(m),__float_as_uint(m),false,false);
  return max2f(__uint_as_float(rr[0]),__uint_as_float(rr[1]));
}
__device__ __forceinline__ void pv(f32x16*o,int vb,bf16x8 pa0,bf16x8 pa1,bf16x8 pa2,bf16x8 pa3){
  #pragma unroll
  for(int d0=0;d0<2;++d0){s16x4 lo[4],hi[4];
    #pragma unroll
    for(int ks=0;ks<4;++ks){
      asm volatile("ds_read_b64_tr_b16 %0,%1 offset:%c2":"=&v"(lo[ks]):"v"(vb),"i"(d0*4096+ks*1024):"memory");
      asm volatile("ds_read_b64_tr_b16 %0,%1 offset:%c2":"=&v"(hi[ks]):"v"(vb),"i"(d0*4096+ks*1024+512):"memory");}
    asm volatile("s_waitcnt lgkmcnt(0)":::"memory");SBAR();
    #define PK(k) (bf16x8){lo[k][0],lo[k][1],lo[k][2],lo[k][3],hi[k][0],hi[k][1],hi[k][2],hi[k][3]}
    o[d0]=__builtin_amdgcn_mfma_f32_32x32x16_bf16(pa0,PK(0),o[d0],0,0,0);
    o[d0]=__builtin_amdgcn_mfma_f32_32x32x16_bf16(pa1,PK(1),o[d0],0,0,0);
    o[d0]=__builtin_amdgcn_mfma_f32_32x32x16_bf16(pa2,PK(2),o[d0],0,0,0);
    o[d0]=__builtin_amdgcn_mfma_f32_32x32x16_bf16(pa3,PK(3),o[d0],0,0,0);
    #undef PK
  }
}

#ifndef ATTN_STORE16
#define ATTN_STORE16(p,v) (*(u32x4*)(p)=(v))
#endif
template<int THRL> __device__ __forceinline__ void attn_unit(int b,int qb,const bf16*Q,const bf16*__restrict__ K,const bf16*__restrict__ V,bf16*O,char*shm){
  int tid_=threadIdx.x; asm volatile("":"+v"(tid_));
  const int tid=tid_,lane=tid&63,r32=lane&31,hi=lane>>5; const int wid=__builtin_amdgcn_readfirstlane(tid>>6);
  const long rowbase=(long)b*SEQ; const int q0=qb*QB;
  const bf16*Qw=Q+(rowbase+q0+wid*QBLK)*DM;
  const bf16*Kh=K+rowbase*DM,*Vh=V+rowbase*DM;
  const unsigned lds0=(unsigned)(uintptr_t)shm;
  float*wsf=(float*)(shm+LDS_WS)+wid*64;
  const bf16*ksrc=Kh+(long)lane*DM+wid*8;
  const bf16*vsrc=Vh+(long)(16*(wid&3)+(lane>>2))*DM+(wid>>2)*32+(lane&3)*8;
  const unsigned kdst=lds0+LDS_K+wid*1024, vdst=lds0+LDS_V+wid*1024;
  #define DMA_K(t,slot) glds16(ksrc+(long)(t)*KVBLK*DM,(unsigned)__builtin_amdgcn_readfirstlane(kdst+(slot)))
  #define DMA_V(t,slot) glds16(vsrc+(long)(t)*KVBLK*DM,(unsigned)__builtin_amdgcn_readfirstlane(vdst+(slot)))
  const int vb0=(int)(lds0+LDS_V)+((lane>>4)&1)*32+(lane&3)*8+(4*hi+((lane&15)>>2))*64;
  const char*Kbase=shm+LDS_K; bf16x8 kf[8];
  const lds_cptr shm3=(lds_cptr)shm; const lds_cptr kp0=shm3+LDS_K+hi*1024+r32*16; const lds_cptr vp0=shm3+LDS_V+((lane>>4)&1)*32+(lane&3)*8+(4*hi+((lane&15)>>2))*64;
  const int NT=(q0+QB)/KVBLK;
  DMA_K(0,0);DMA_V(0,0);DMA_K(1,SLOTB);
  bf16x8 qr[4];
  #pragma unroll
  for(int d0=0;d0<4;++d0)qr[d0]=*reinterpret_cast<const bf16x8*>(&Qw[(long)r32*DM+d0*16+hi*8]);
  float zz_=0.f; asm volatile("":"+v"(zz_)); const f32x16 zv_={zz_,zz_,zz_,zz_,zz_,zz_,zz_,zz_,zz_,zz_,zz_,zz_,zz_,zz_,zz_,zz_};
  float mhat=zz_,l_reg=zz_;f32x16 o[2];o[0]=zv_;o[1]=zv_;f32x16 negm=zv_;asm volatile("":"+v"(negm));
  const int qrel=wid*QBLK+r32;
  #define CMASK(P0,P1,t) do{int jb_=(t)-(NT-4); if(jb_>=0)cmask(P0,P1,jb_,qrel,hi);}while(0)
  bool resc=false;
  #define START(P0,P1) do{ const float rm=rowmax(P0,P1); resc=false; \
    { const float dl=rm; mhat=fadd_s(mhat,dl); \
      _Pragma("unroll") for(int r=0;r<16;++r){P0[r]=fsub_s(P0[r],dl);P1[r]=fsub_s(P1[r],dl);} \
      _Pragma("unroll") for(int r=0;r<16;++r)negm[r]=-mhat; asm volatile("":"+v"(negm)); } \
    _Pragma("unroll") for(int r=0;r<16;++r)P0[r]=__builtin_amdgcn_exp2f(P0[r]); }while(0)
  #define RESC() do{ if(resc){ asm volatile("s_waitcnt lgkmcnt(0)":::"memory"); \
      _Pragma("unroll") for(int d_=0;d_<2;++d_) _Pragma("unroll") for(int r=0;r<16;++r)o[d_][r]*=wsf[crow(r,hi)]; } }while(0)
  f32x16 pA0,pA1,pB0,pB1;
  int sl_prev=0,sl_cur=0,sl_next=SLOTB;
  #define ROT() do{sl_prev=sl_cur;sl_cur=sl_next;sl_next=(sl_next==(NSLOT-1)*SLOTB)?0:sl_next+SLOTB;}while(0)
  DMA_K(2,2*SLOTB);
  WAIT_BAR(3);
  qkt(pA0,pA1,Kbase,qr,negm,r32,hi);asm volatile("s_nop 15\n\ts_nop 7":"+v"(pA0),"+v"(pA1));CMASK(pA0,pA1,0);
  START(pA0,pA1);
  _Pragma("unroll") for(int r=0;r<16;++r)pA1[r]=__builtin_amdgcn_exp2f(pA1[r]);
  WAIT_BAR(0);
  DMA_K(3,0);DMA_V(1,SLOTB);
  ROT();
  kload8(kf,kp0+sl_cur);
  WAIT_BAR(2);
  s16x4 vlo[8],vhi[8]; u32x4 pw0,pw1,pw2,pw3;
  #define PKW(P,B) cvtpk_s(P[B],P[B+1])
  #define PAF(k) __builtin_bit_cast(bf16x8,pw##k)
  #define VFR(i) (bf16x8){vlo[i][0],vlo[i][1],vlo[i][2],vlo[i][3],vhi[i][0],vhi[i][1],vhi[i][2],vhi[i][3]}
  #define PIN(x) asm volatile("":"+v"(x))
  #define MX3(a,b,c) __builtin_fmaxf(__builtin_fmaxf((a),(b)),(c))
  #define GAPA(MF,A0,A1,A2,A3,W0,W1,PW) do{ MF; sacc+=A0; sacc+=A1; sacc+=A2; sacc+=A3; PIN(sacc); W0; W1; PIN(PW); SBAR(); }while(0)
  #define EX(v) __builtin_amdgcn_exp2f(v)
  #define GAPB(MF,X,B) do{ MF; X[B]=EX(X[B]); X[B+1]=EX(X[B+1]); X[B+2]=EX(X[B+2]); X[B+3]=EX(X[B+3]); PIN(X); SBAR(); }while(0)
  #define VRD(i) do{ vlo[i]=vtr(vp_+(((i)>>2)*4096+((i)&3)*1024)); vhi[i]=vtr(vp_+(((i)>>2)*4096+((i)&3)*1024+512)); }while(0)
  #define KRD(G,j) do{ if(G){ kload2(kf,kp0+sl_next,j); SBAR(); } }while(0)
  #define STEP(C0,C1,P0,P1,t,GK,GV,GL) do{ SBAR(); \
    const lds_cptr vp_=vp0+sl_prev; \
    VRD(0); SBAR(); float sacc=(P0[0]+P0[1]); \
    GAPA(C0=__builtin_amdgcn_mfma_f32_32x32x16_bf16(kf[0],qr[0],negm,0,0,0), P0[2],P0[3],P0[4],P0[5],     pw0[0]=PKW(P0,0), pw0[1]=PKW(P0,2), pw0); \
    VRD(4); SBAR(); GAPA(C1=__builtin_amdgcn_mfma_f32_32x32x16_bf16(kf[1],qr[0],negm,0,0,0), P0[6],P0[7],P0[8],P0[9],     pw0[2]=PKW(P0,4), pw0[3]=PKW(P0,6), pw0); \
    VRD(1); SBAR(); GAPA(C0=__builtin_amdgcn_mfma_f32_32x32x16_bf16(kf[2],qr[1],C0,0,0,0),   P0[10],P0[11],P0[12],P0[13], pw1[0]=PKW(P0,8), pw1[1]=PKW(P0,10), pw1); \
    VRD(5); SBAR(); GAPA(C1=__builtin_amdgcn_mfma_f32_32x32x16_bf16(kf[3],qr[1],C1,0,0,0),   P0[14],P0[15],P1[0],P1[1],   pw1[2]=PKW(P0,12),pw1[3]=PKW(P0,14), pw1); \
    VRD(2); SBAR(); GAPA(C0=__builtin_amdgcn_mfma_f32_32x32x16_bf16(kf[4],qr[2],C0,0,0,0),   P1[2],P1[3],P1[4],P1[5],     pw2[0]=PKW(P1,0), pw2[1]=PKW(P1,2), pw2); \
    VRD(6); SBAR(); GAPA(C1=__builtin_amdgcn_mfma_f32_32x32x16_bf16(kf[5],qr[2],C1,0,0,0),   P1[6],P1[7],P1[8],P1[9],     pw2[2]=PKW(P1,4), pw2[3]=PKW(P1,6), pw2); \
    VRD(3); SBAR(); GAPA(C0=__builtin_amdgcn_mfma_f32_32x32x16_bf16(kf[6],qr[3],C0,0,0,0),   P1[10],P1[11],P1[12],P1[13], pw3[0]=PKW(P1,8), pw3[1]=PKW(P1,10), pw3); \
    VRD(7); SBAR(); GAPA(C1=__builtin_amdgcn_mfma_f32_32x32x16_bf16(kf[7],qr[3],C1,0,0,0),   P1[14],P1[15],0.f,0.f,       pw3[2]=PKW(P1,12),pw3[3]=PKW(P1,14), pw3); \
    l_reg+=sacc; \
    if(GK){DMA_K((t)+3,sl_cur);} if(GV){DMA_V((t)+1,sl_next);} \
    CMASK(C0,C1,t); \
    { float a=MX3(C0[0],C0[1],C1[0]),b=MX3(C0[2],C0[3],C1[1]); a=MX3(a,C1[2],C1[3]); \
      _Pragma("unroll") for(int r=4;r<16;r+=4){a=MX3(a,C0[r],C0[r+1]);b=MX3(b,C0[r+2],C0[r+3]);a=MX3(a,C1[r],C1[r+1]);b=MX3(b,C1[r+2],C1[r+3]);} \
      float rm=__builtin_fmaxf(a,b); { auto rr=__builtin_amdgcn_permlane32_swap(__float_as_uint(rm),__float_as_uint(rm),false,false); rm=__builtin_fmaxf(__uint_as_float(rr[0]),__uint_as_float(rr[1])); } \
      resc=false; \
      if(__builtin_expect(__any(rm>(float)THRL),0)){ const float dl=__builtin_fmaxf(rm,0.f); mhat+=dl; \
        _Pragma("unroll") for(int r=0;r<16;++r){C0[r]-=dl;C1[r]-=dl;} \
        _Pragma("unroll") for(int r=0;r<16;++r)negm[r]=-mhat; asm volatile("":"+v"(negm)); \
        const float f=__builtin_amdgcn_exp2f(-dl); l_reg*=f; if(hi==0)wsf[r32]=f; resc=true; } } \
    SBAR(); \
    GAPB(o[0]=__builtin_amdgcn_mfma_f32_32x32x16_bf16(PAF(0),VFR(0),o[0],0,0,0), C0,0); \
    GAPB(o[1]=__builtin_amdgcn_mfma_f32_32x32x16_bf16(PAF(0),VFR(4),o[1],0,0,0), C0,4); \
    KRD(GL,0); GAPB(o[0]=__builtin_amdgcn_mfma_f32_32x32x16_bf16(PAF(1),VFR(1),o[0],0,0,0), C0,8); \
    KRD(GL,1); GAPB(o[1]=__builtin_amdgcn_mfma_f32_32x32x16_bf16(PAF(1),VFR(5),o[1],0,0,0), C0,12); \
    KRD(GL,2); GAPB(o[0]=__builtin_amdgcn_mfma_f32_32x32x16_bf16(PAF(2),VFR(2),o[0],0,0,0), C1,0); \
    KRD(GL,3); GAPB(o[1]=__builtin_amdgcn_mfma_f32_32x32x16_bf16(PAF(2),VFR(6),o[1],0,0,0), C1,4); \
    GAPB(o[0]=__builtin_amdgcn_mfma_f32_32x32x16_bf16(PAF(3),VFR(3),o[0],0,0,0), C1,8); \
    GAPB(o[1]=__builtin_amdgcn_mfma_f32_32x32x16_bf16(PAF(3),VFR(7),o[1],0,0,0), C1,12); \
    }while(0)
  int t=1;
  #undef CMASK
  #define CMASK(P0,P1,t) do{}while(0)
  for(;t+5<NT;t+=2){
    STEP(pB0,pB1,pA0,pA1,t,true,true,true);     WAIT_BAR(2); RESC(); ROT();
    STEP(pA0,pA1,pB0,pB1,t+1,true,true,true);   WAIT_BAR(2); RESC(); ROT();
  }
  #undef CMASK
  #define CMASK(P0,P1,t) do{int jb_=(t)-(NT-4); if(jb_>=0)cmask(P0,P1,jb_,qrel,hi);}while(0)
  #define ENDW(tt) do{ if((tt)+3<NT){WAIT_BAR(2);} else if((tt)+2<NT){WAIT_BAR(1);} else {WAIT_BAR(0);} }while(0)
  for(;t+1<NT;t+=2){
    STEP(pB0,pB1,pA0,pA1,t,(t+3<NT),(t+1<NT),(t+1<NT));       ENDW(t);   RESC(); ROT();
    STEP(pA0,pA1,pB0,pB1,t+1,(t+4<NT),(t+2<NT),(t+2<NT));     ENDW(t+1); RESC(); ROT();
  }
  STEP(pB0,pB1,pA0,pA1,NT-1,false,false,false); RESC();
  { float sacc=pB0[0]+pB0[1]; _Pragma("unroll") for(int r=2;r<16;++r)sacc+=pB0[r]; _Pragma("unroll") for(int r=0;r<16;++r)sacc+=pB1[r]; l_reg+=sacc;
    pw0=(u32x4){PKW(pB0,0),PKW(pB0,2),PKW(pB0,4),PKW(pB0,6)};pw1=(u32x4){PKW(pB0,8),PKW(pB0,10),PKW(pB0,12),PKW(pB0,14)};pw2=(u32x4){PKW(pB1,0),PKW(pB1,2),PKW(pB1,4),PKW(pB1,6)};pw3=(u32x4){PKW(pB1,8),PKW(pB1,10),PKW(pB1,12),PKW(pB1,14)};
    SBAR(); pv(o,vb0+sl_cur,PAF(0),PAF(1),PAF(2),PAF(3)); }
  #undef PKW
  #undef PAF
  #undef VFR
  #undef PIN
  #undef MX3
  #undef GAPA
  #undef GAPB
  #undef EX
  #undef VRD
  #undef KRD
  #undef STEP
  #undef ENDW
  {auto rr=__builtin_amdgcn_permlane32_swap(__float_as_uint(l_reg),__float_as_uint(l_reg),false,false);l_reg=__uint_as_float(rr[0])+__uint_as_float(rr[1]);}
  if(hi==0)wsf[32+r32]=l_reg;asm volatile("s_waitcnt lgkmcnt(0)":::"memory");
  float rli[16];
  #pragma unroll
  for(int r=0;r<16;++r)rli[r]=__builtin_amdgcn_rcpf(wsf[32+crow(r,hi)]);
  bf16*Ow=O+(rowbase+q0+wid*QBLK)*DM;
  { bf16*stg=(bf16*)(shm+LDS_OST)+wid*2048;
    #pragma unroll
    for(int r=0;r<16;++r){const int orow=crow(r,hi);
      #pragma unroll
      for(int d0=0;d0<2;++d0)stg[orow*64+d0*32+r32]=__float2bfloat16(o[d0][r]*rli[r]);}
    asm volatile("s_waitcnt lgkmcnt(0)":::"memory");
    #pragma unroll
    for(int i=0;i<4;++i){const int row=i*8+(lane>>3),ch=lane&7; const u32x4 v=*(const u32x4*)(stg+row*64+ch*8); ATTN_STORE16(Ow+(long)row*DM+ch*8,v);} }
  asm volatile("s_waitcnt lgkmcnt(0)\n\ts_barrier":::"memory");
  #undef DMA_K
  #undef DMA_V
  #undef CMASK
  #undef START
  #undef RESC
  #undef ROT
}
__device__ __forceinline__ void pv4(f32x16*o,int vb,bf16x8 pa0,bf16x8 pa1,bf16x8 pa2,bf16x8 pa3){
  #pragma unroll
  for(int d0=0;d0<4;++d0){s16x4 lo[4],hi[4];
    #pragma unroll
    for(int ks=0;ks<4;++ks){
      asm volatile("ds_read_b64_tr_b16 %0,%1 offset:%c2":"=&v"(lo[ks]):"v"(vb),"i"(d0*4096+ks*1024):"memory");
      asm volatile("ds_read_b64_tr_b16 %0,%1 offset:%c2":"=&v"(hi[ks]):"v"(vb),"i"(d0*4096+ks*1024+512):"memory");}
    asm volatile("s_waitcnt lgkmcnt(0)":::"memory");SBAR();
    #define PK(k) (bf16x8){lo[k][0],lo[k][1],lo[k][2],lo[k][3],hi[k][0],hi[k][1],hi[k][2],hi[k][3]}
    o[d0]=__builtin_amdgcn_mfma_f32_32x32x16_bf16(pa0,PK(0),o[d0],0,0,0);
    o[d0]=__builtin_amdgcn_mfma_f32_32x32x16_bf16(pa1,PK(1),o[d0],0,0,0);
    o[d0]=__builtin_amdgcn_mfma_f32_32x32x16_bf16(pa2,PK(2),o[d0],0,0,0);
    o[d0]=__builtin_amdgcn_mfma_f32_32x32x16_bf16(pa3,PK(3),o[d0],0,0,0);
    #undef PK
  }
}

template<int THRL,bool FUSE> __device__ __forceinline__ void attn_unit128(int b,int qb,const bf16*Q,const bf16*__restrict__ K,const bf16*__restrict__ V,bf16*O,char*shm,bf16*ON=nullptr,const float*subg=nullptr,float lam=0.f,float oscale=1.f,float eps=0.f){
  int tid_=threadIdx.x; asm volatile("":"+v"(tid_));
  const int tid=tid_,lane=tid&63,r32=lane&31,hi=lane>>5; const int wid=__builtin_amdgcn_readfirstlane(tid>>6);
  const long rowbase=(long)b*SEQ; const int q0=qb*QB;
  const bf16*Qw=Q+(rowbase+q0+wid*QBLK)*DM;
  const bf16*Kh=K+rowbase*DM,*Vh=V+rowbase*DM;
  const unsigned lds0=(unsigned)(uintptr_t)shm;
  constexpr int LDS_V2=NSLOT*SLOTB, VSLOT=2*SLOTB, LDS_WS2=LDS_V2+NSLOT*VSLOT, LDS_OST2=LDS_WS2+NW*64*4;
  float*wsf=(float*)(shm+LDS_WS2)+wid*64;
  const bf16*ksrc=Kh+(long)lane*DM+wid*8;
  const bf16*vsrc=Vh+(long)(16*(wid&3)+(lane>>2))*DM+(wid>>2)*32+(lane&3)*8;
  const unsigned kdst=lds0+LDS_K+wid*1024, vdst=lds0+LDS_V2+wid*1024;
  #define DMA_K(t,slot) glds16(ksrc+(long)(t)*KVBLK*DM,(unsigned)__builtin_amdgcn_readfirstlane(kdst+(slot)))
  #define DMA_V(t,slot) do{ glds16(vsrc+(long)(t)*KVBLK*DM,(unsigned)__builtin_amdgcn_readfirstlane(vdst+2*(slot))); glds16(vsrc+(long)(t)*KVBLK*DM+64,(unsigned)__builtin_amdgcn_readfirstlane(vdst+2*(slot)+8192)); }while(0)
  const int vb0=(int)(lds0+LDS_V2)+((lane>>4)&1)*32+(lane&3)*8+(4*hi+((lane&15)>>2))*64;
  const char*Kbase=shm+LDS_K; bf16x8 kf[8];
  const lds_cptr shm3=(lds_cptr)shm; const lds_cptr kp0=shm3+LDS_K+hi*1024+r32*16; const lds_cptr vp0=shm3+LDS_V2+((lane>>4)&1)*32+(lane&3)*8+(4*hi+((lane&15)>>2))*64;
  const int NT=(q0+QB)/KVBLK;
  DMA_K(0,0);DMA_V(0,0);DMA_K(1,SLOTB);
  bf16x8 qr[4];
  #pragma unroll
  for(int d0=0;d0<4;++d0)qr[d0]=*reinterpret_cast<const bf16x8*>(&Qw[(long)r32*DM+d0*16+hi*8]);
  float zz_=0.f; asm volatile("":"+v"(zz_)); const f32x16 zv_={zz_,zz_,zz_,zz_,zz_,zz_,zz_,zz_,zz_,zz_,zz_,zz_,zz_,zz_,zz_,zz_};
  float mhat=zz_,l_reg=zz_;f32x16 o[4];o[0]=zv_;o[1]=zv_;o[2]=zv_;o[3]=zv_;f32x16 negm=zv_;asm volatile("":"+v"(negm));
  const int qrel=wid*QBLK+r32;
  #define CMASK(P0,P1,t) do{int jb_=(t)-(NT-4); if(jb_>=0)cmask(P0,P1,jb_,qrel,hi);}while(0)
  bool resc=false;
  #define START(P0,P1) do{ const float rm=rowmax(P0,P1); resc=false; \
    { const float dl=rm; mhat=fadd_s(mhat,dl); \
      _Pragma("unroll") for(int r=0;r<16;++r){P0[r]=fsub_s(P0[r],dl);P1[r]=fsub_s(P1[r],dl);} \
      _Pragma("unroll") for(int r=0;r<16;++r)negm[r]=-mhat; asm volatile("":"+v"(negm)); } \
    _Pragma("unroll") for(int r=0;r<16;++r)P0[r]=__builtin_amdgcn_exp2f(P0[r]); }while(0)
  #define RESC() do{ if(resc){ asm volatile("s_waitcnt lgkmcnt(0)":::"memory"); \
      _Pragma("unroll") for(int d_=0;d_<4;++d_) _Pragma("unroll") for(int r=0;r<16;++r)o[d_][r]*=wsf[crow(r,hi)]; } }while(0)
  f32x16 pA0,pA1,pB0,pB1;
  int sl_prev=0,sl_cur=0,sl_next=SLOTB;
  #define ROT() do{sl_prev=sl_cur;sl_cur=sl_next;sl_next=(sl_next==(NSLOT-1)*SLOTB)?0:sl_next+SLOTB;}while(0)
  DMA_K(2,2*SLOTB);
  WAIT_BAR(4);
  qkt(pA0,pA1,Kbase,qr,negm,r32,hi);asm volatile("s_nop 15\n\ts_nop 7":"+v"(pA0),"+v"(pA1));CMASK(pA0,pA1,0);
  START(pA0,pA1);
  _Pragma("unroll") for(int r=0;r<16;++r)pA1[r]=__builtin_amdgcn_exp2f(pA1[r]);
  WAIT_BAR(0);
  DMA_K(3,0);DMA_V(1,SLOTB);
  ROT();
  kload8(kf,kp0+sl_cur);
  WAIT_BAR(3);
  s16x4 vlo[8],vhi[8]; u32x4 pw0,pw1,pw2,pw3;
  #define PKW(P,B) cvtpk_s(P[B],P[B+1])
  #define PAF(k) __builtin_bit_cast(bf16x8,pw##k)
  #define VFR(s) (bf16x8){vlo[s][0],vlo[s][1],vlo[s][2],vlo[s][3],vhi[s][0],vhi[s][1],vhi[s][2],vhi[s][3]}
  #define PIN(x) asm volatile("":"+v"(x))
  #define MX3(a,b,c) __builtin_fmaxf(__builtin_fmaxf((a),(b)),(c))
  #define GAPA(MF,A0,A1,A2,A3,W0,W1,PW) do{ MF; sacc+=A0; sacc+=A1; sacc+=A2; sacc+=A3; PIN(sacc); W0; W1; PIN(PW); SBAR(); }while(0)
  #define EX(v) __builtin_amdgcn_exp2f(v)
  #define GAPB(MF,X,B) do{ MF; X[B]=EX(X[B]); X[B+1]=EX(X[B+1]); PIN(X); SBAR(); }while(0)
  #define VRD(s,f) do{ vlo[s]=vtr(vp_+(((f)>>2)*4096+((f)&3)*1024)); vhi[s]=vtr(vp_+(((f)>>2)*4096+((f)&3)*1024+512)); }while(0)
  #define KRD(G,j) do{ if(G){ kload2(kf,kp0+sl_next,j); SBAR(); } }while(0)
  #define STEP(C0,C1,P0,P1,t,GK,GV,GL) do{ SBAR(); \
    const lds_cptr vp_=vp0+2*sl_prev; \
    VRD(0,0); SBAR(); float sacc=(P0[0]+P0[1]); \
    GAPA(C0=__builtin_amdgcn_mfma_f32_32x32x16_bf16(kf[0],qr[0],negm,0,0,0), P0[2],P0[3],P0[4],P0[5],     pw0[0]=PKW(P0,0), pw0[1]=PKW(P0,2), pw0); \
    VRD(1,4); SBAR(); GAPA(C1=__builtin_amdgcn_mfma_f32_32x32x16_bf16(kf[1],qr[0],negm,0,0,0), P0[6],P0[7],P0[8],P0[9],     pw0[2]=PKW(P0,4), pw0[3]=PKW(P0,6), pw0); \
    VRD(2,8); SBAR(); GAPA(C0=__builtin_amdgcn_mfma_f32_32x32x16_bf16(kf[2],qr[1],C0,0,0,0),   P0[10],P0[11],P0[12],P0[13], pw1[0]=PKW(P0,8), pw1[1]=PKW(P0,10), pw1); \
    VRD(3,12); SBAR(); GAPA(C1=__builtin_amdgcn_mfma_f32_32x32x16_bf16(kf[3],qr[1],C1,0,0,0),   P0[14],P0[15],P1[0],P1[1],   pw1[2]=PKW(P0,12),pw1[3]=PKW(P0,14), pw1); \
    VRD(4,1); SBAR(); GAPA(C0=__builtin_amdgcn_mfma_f32_32x32x16_bf16(kf[4],qr[2],C0,0,0,0),   P1[2],P1[3],P1[4],P1[5],     pw2[0]=PKW(P1,0), pw2[1]=PKW(P1,2), pw2); \
    VRD(5,5); SBAR(); GAPA(C1=__builtin_amdgcn_mfma_f32_32x32x16_bf16(kf[5],qr[2],C1,0,0,0),   P1[6],P1[7],P1[8],P1[9],     pw2[2]=PKW(P1,4), pw2[3]=PKW(P1,6), pw2); \
    VRD(6,9); SBAR(); GAPA(C0=__builtin_amdgcn_mfma_f32_32x32x16_bf16(kf[6],qr[3],C0,0,0,0),   P1[10],P1[11],P1[12],P1[13], pw3[0]=PKW(P1,8), pw3[1]=PKW(P1,10), pw3); \
    VRD(7,13); SBAR(); GAPA(C1=__builtin_amdgcn_mfma_f32_32x32x16_bf16(kf[7],qr[3],C1,0,0,0),   P1[14],P1[15],0.f,0.f,       pw3[2]=PKW(P1,12),pw3[3]=PKW(P1,14), pw3); \
    l_reg+=sacc; \
    if(GK){DMA_K((t)+3,sl_cur);} if(GV){DMA_V((t)+1,sl_next);} \
    CMASK(C0,C1,t); \
    { float a=MX3(C0[0],C0[1],C1[0]),b=MX3(C0[2],C0[3],C1[1]); a=MX3(a,C1[2],C1[3]); \
      _Pragma("unroll") for(int r=4;r<16;r+=4){a=MX3(a,C0[r],C0[r+1]);b=MX3(b,C0[r+2],C0[r+3]);a=MX3(a,C1[r],C1[r+1]);b=MX3(b,C1[r+2],C1[r+3]);} \
      float rm=__builtin_fmaxf(a,b); { auto rr=__builtin_amdgcn_permlane32_swap(__float_as_uint(rm),__float_as_uint(rm),false,false); rm=__builtin_fmaxf(__uint_as_float(rr[0]),__uint_as_float(rr[1])); } \
      resc=false; \
      if(__builtin_expect(__any(rm>(float)THRL),0)){ const float dl=__builtin_fmaxf(rm,0.f); mhat+=dl; \
        _Pragma("unroll") for(int r=0;r<16;++r){C0[r]-=dl;C1[r]-=dl;} \
        _Pragma("unroll") for(int r=0;r<16;++r)negm[r]=-mhat; asm volatile("":"+v"(negm)); \
        const float f=__builtin_amdgcn_exp2f(-dl); l_reg*=f; if(hi==0)wsf[r32]=f; resc=true; } } \
    SBAR(); \
    GAPB(o[0]=__builtin_amdgcn_mfma_f32_32x32x16_bf16(PAF(0),VFR(0),o[0],0,0,0), C0,0); VRD(0,2); SBAR(); \
    GAPB(o[1]=__builtin_amdgcn_mfma_f32_32x32x16_bf16(PAF(0),VFR(1),o[1],0,0,0), C0,2); VRD(1,6); SBAR(); \
    GAPB(o[2]=__builtin_amdgcn_mfma_f32_32x32x16_bf16(PAF(0),VFR(2),o[2],0,0,0), C0,4); VRD(2,10); SBAR(); \
    GAPB(o[3]=__builtin_amdgcn_mfma_f32_32x32x16_bf16(PAF(0),VFR(3),o[3],0,0,0), C0,6); VRD(3,14); SBAR(); \
    GAPB(o[0]=__builtin_amdgcn_mfma_f32_32x32x16_bf16(PAF(1),VFR(4),o[0],0,0,0), C0,8); VRD(4,3); SBAR(); \
    GAPB(o[1]=__builtin_amdgcn_mfma_f32_32x32x16_bf16(PAF(1),VFR(5),o[1],0,0,0), C0,10); VRD(5,7); SBAR(); \
    GAPB(o[2]=__builtin_amdgcn_mfma_f32_32x32x16_bf16(PAF(1),VFR(6),o[2],0,0,0), C0,12); VRD(6,11); SBAR(); \
    GAPB(o[3]=__builtin_amdgcn_mfma_f32_32x32x16_bf16(PAF(1),VFR(7),o[3],0,0,0), C0,14); VRD(7,15); SBAR(); \
    KRD(GL,0); GAPB(o[0]=__builtin_amdgcn_mfma_f32_32x32x16_bf16(PAF(2),VFR(0),o[0],0,0,0), C1,0); \
    KRD(GL,1); GAPB(o[1]=__builtin_amdgcn_mfma_f32_32x32x16_bf16(PAF(2),VFR(1),o[1],0,0,0), C1,2); \
    KRD(GL,2); GAPB(o[2]=__builtin_amdgcn_mfma_f32_32x32x16_bf16(PAF(2),VFR(2),o[2],0,0,0), C1,4); \
    KRD(GL,3); GAPB(o[3]=__builtin_amdgcn_mfma_f32_32x32x16_bf16(PAF(2),VFR(3),o[3],0,0,0), C1,6); \
    GAPB(o[0]=__builtin_amdgcn_mfma_f32_32x32x16_bf16(PAF(3),VFR(4),o[0],0,0,0), C1,8); \
    GAPB(o[1]=__builtin_amdgcn_mfma_f32_32x32x16_bf16(PAF(3),VFR(5),o[1],0,0,0), C1,10); \
    GAPB(o[2]=__builtin_amdgcn_mfma_f32_32x32x16_bf16(PAF(3),VFR(6),o[2],0,0,0), C1,12); \
    GAPB(o[3]=__builtin_amdgcn_mfma_f32_32x32x16_bf16(PAF(3),VFR(7),o[3],0,0,0), C1,14); \
    }while(0)
  int t=1;
  #undef CMASK
  #define CMASK(P0,P1,t) do{}while(0)
  for(;t+5<NT;t+=2){
    STEP(pB0,pB1,pA0,pA1,t,true,true,true);     WAIT_BAR(3); RESC(); ROT();
    STEP(pA0,pA1,pB0,pB1,t+1,true,true,true);   WAIT_BAR(3); RESC(); ROT();
  }
  #undef CMASK
  #define CMASK(P0,P1,t) do{int jb_=(t)-(NT-4); if(jb_>=0)cmask(P0,P1,jb_,qrel,hi);}while(0)
  #define ENDW(tt) do{ if((tt)+3<NT){WAIT_BAR(3);} else if((tt)+2<NT){WAIT_BAR(2);} else {WAIT_BAR(0);} }while(0)
  for(;t+1<NT;t+=2){
    STEP(pB0,pB1,pA0,pA1,t,(t+3<NT),(t+1<NT),(t+1<NT));       ENDW(t);   RESC(); ROT();
    STEP(pA0,pA1,pB0,pB1,t+1,(t+4<NT),(t+2<NT),(t+2<NT));     ENDW(t+1); RESC(); ROT();
  }
  STEP(pB0,pB1,pA0,pA1,NT-1,false,false,false); RESC();
  { float sacc=pB0[0]+pB0[1]; _Pragma("unroll") for(int r=2;r<16;++r)sacc+=pB0[r]; _Pragma("unroll") for(int r=0;r<16;++r)sacc+=pB1[r]; l_reg+=sacc;
    pw0=(u32x4){PKW(pB0,0),PKW(pB0,2),PKW(pB0,4),PKW(pB0,6)};pw1=(u32x4){PKW(pB0,8),PKW(pB0,10),PKW(pB0,12),PKW(pB0,14)};pw2=(u32x4){PKW(pB1,0),PKW(pB1,2),PKW(pB1,4),PKW(pB1,6)};pw3=(u32x4){PKW(pB1,8),PKW(pB1,10),PKW(pB1,12),PKW(pB1,14)};
    SBAR(); pv4(o,vb0+2*sl_cur,PAF(0),PAF(1),PAF(2),PAF(3)); }
  #undef PKW
  #undef PAF
  #undef VFR
  #undef PIN
  #undef MX3
  #undef GAPA
  #undef GAPB
  #undef EX
  #undef VRD
  #undef KRD
  #undef STEP
  #undef ENDW
  {auto rr=__builtin_amdgcn_permlane32_swap(__float_as_uint(l_reg),__float_as_uint(l_reg),false,false);l_reg=__uint_as_float(rr[0])+__uint_as_float(rr[1]);}
  if(hi==0)wsf[32+r32]=l_reg;asm volatile("s_waitcnt lgkmcnt(0)":::"memory");
  float rli[16];
  #pragma unroll
  for(int r=0;r<16;++r)rli[r]=__builtin_amdgcn_rcpf(wsf[32+crow(r,hi)]);
  bf16*Ow=O+(rowbase+q0+wid*QBLK)*DM;
  { bf16*stg=(bf16*)(shm+LDS_OST2)+wid*2048;
    float dv[2][4][8]; float ssq[4]={0.f,0.f,0.f,0.f};
    #pragma unroll
    for(int hf=0;hf<2;++hf){
      #pragma unroll
      for(int r=0;r<16;++r){const int orow=crow(r,hi);
        #pragma unroll
        for(int d0=0;d0<2;++d0)stg[orow*64+d0*32+r32]=__float2bfloat16(o[2*hf+d0][r]*rli[r]);}
      asm volatile("s_waitcnt lgkmcnt(0)":::"memory");
      #pragma unroll
      for(int i=0;i<4;++i){const int row=i*8+(lane>>3),ch=lane&7; const u32x4 v=*(const u32x4*)(stg+row*64+ch*8);
        if constexpr(!FUSE){ ATTN_STORE16(Ow+(long)row*DM+hf*64+ch*8,v); }
        else{ const u32x4 v0=*(const u32x4*)(Ow+(long)row*DM+hf*64+ch*8);
          #pragma unroll
          for(int e=0;e<4;++e){ const float a0=__uint_as_float(v0[e]<<16),a1=__uint_as_float(v0[e]&0xffff0000u),b0=__uint_as_float(v[e]<<16),b1=__uint_as_float(v[e]&0xffff0000u);
            const float d0_=a0-lam*b0,d1_=a1-lam*b1; dv[hf][i][2*e]=d0_; dv[hf][i][2*e+1]=d1_; ssq[i]+=d0_*d0_+d1_*d1_; } } }
      asm volatile("s_waitcnt lgkmcnt(0)":::"memory"); }
    if constexpr(FUSE){
      bf16*Nw=ON+(rowbase+q0+wid*QBLK)*DM;
      #pragma unroll
      for(int i=0;i<4;++i){ float s_=ssq[i]; s_+=__shfl_xor(s_,1); s_+=__shfl_xor(s_,2); s_+=__shfl_xor(s_,4); ssq[i]=__builtin_amdgcn_rsqf(s_*(1.f/128.f)+eps)*oscale; }
      #pragma unroll
      for(int hf=0;hf<2;++hf){ const int ch=lane&7; float g_[8];
        #pragma unroll
        for(int e=0;e<8;++e)g_[e]=subg[hf*64+ch*8+e];
        #pragma unroll
        for(int i=0;i<4;++i){const int row=i*8+(lane>>3); u32x4 w;
          #pragma unroll
          for(int e=0;e<4;++e)w[e]=cvtpk_s(dv[hf][i][2*e]*ssq[i]*g_[2*e],dv[hf][i][2*e+1]*ssq[i]*g_[2*e+1]);
          *(u32x4*)(Nw+(long)row*DM+hf*64+ch*8)=w; } } } }
  asm volatile("s_waitcnt lgkmcnt(0)\n\ts_barrier":::"memory");
  #undef DMA_K
  #undef DMA_V
  #undef CMASK
  #undef START
  #undef RESC
  #undef ROT
}
constexpr int ATTN_LDS_BYTES=LDS_BYTES, ATTN128_LDS_BYTES=NSLOT*SLOTB+NSLOT*2*SLOTB+NW*64*4+NW*4096;
#undef SBAR
#undef WAIT_BAR
}
#define GAS __attribute__((address_space(1)))
#define LAS __attribute__((address_space(3)))
typedef unsigned short bf16;
typedef unsigned v4u __attribute__((ext_vector_type(4)));
typedef float f32x4 __attribute__((ext_vector_type(4)));
typedef short bf16x8 __attribute__((ext_vector_type(8)));
typedef GAS unsigned gu32;
typedef GAS unsigned long long gu64;
#define RLX_AGENT __ATOMIC_RELAXED, __HIP_MEMORY_SCOPE_AGENT
#define LDS_WAIT() asm volatile("s_waitcnt lgkmcnt(0)" ::: "memory")
#define VM_WAIT() asm volatile("s_waitcnt vmcnt(0)" ::: "memory")
__device__ __forceinline__ unsigned long long rt() { return __builtin_amdgcn_s_memrealtime(); }
__device__ __forceinline__ unsigned f2bf(float f) { unsigned u = __builtin_bit_cast(unsigned, f); return (u + 0x7fffu + ((u >> 16) & 1u)) >> 16; }
__device__ __forceinline__ unsigned pk2(float lo, float hi) { return f2bf(lo) | (f2bf(hi) << 16); }

#define XB_TMO      128
#define XB_XCNT(j)  (256  + 64 * (j))
#define XB_XSUB(j)  (1280 + 64 * (j))
#define XB_XGEN(j)  (2304 + 64 * (j))
#define XB_TOP      3328
#define XB_TOPGEN   3392
#define XCD_BAR_WORDS 3456
#define XB_SPIN_CAP (1u << 18)

__device__ __forceinline__ unsigned xb_ld(unsigned* p)              { return __hip_atomic_load(p, __ATOMIC_RELAXED, __HIP_MEMORY_SCOPE_AGENT); }
__device__ __forceinline__ unsigned xb_add(unsigned* p, unsigned v) { return __hip_atomic_fetch_add(p, v, __ATOMIC_RELAXED, __HIP_MEMORY_SCOPE_AGENT); }
__device__ __forceinline__ unsigned xb_xcc_id() { return (unsigned)__builtin_amdgcn_s_getreg((3 << 11) | 20) & 0xFu; }
#define XB_SPIN(cond, bar) do { unsigned _sp = 0; while (cond) { __builtin_amdgcn_s_sleep(1); \
    if ((++_sp & 255u) == 0u) { if (xb_ld(&(bar)[XB_TMO])) break; if (_sp > XB_SPIN_CAP) { atomicAdd(&(bar)[XB_TMO], 1u); break; } } } } while (0)

struct XcdBarrier {
    unsigned* bar; unsigned x;
    volatile LAS unsigned* st;
};

__device__ __forceinline__ XcdBarrier xcd_barrier_post(unsigned* bar, volatile LAS unsigned* st) {
    XcdBarrier b; b.bar = bar; b.x = xb_xcc_id(); b.st = st;
    if (threadIdx.x == 0) (void)xb_add(&bar[XB_XCNT(b.x)], 1u);
    return b;
}
__device__ __forceinline__ void xcd_barrier_complete(unsigned* bar, unsigned x, unsigned& nloc, unsigned& nx) {
    const unsigned G = gridDim.x * gridDim.y * gridDim.z;
    unsigned sum, cnt, mine, sp = 0u;
    for (;;) {
        sum = 0u; cnt = 0u; mine = 0u;
#pragma unroll
        for (unsigned j = 0; j < 16; ++j) { const unsigned c = xb_ld(&bar[XB_XCNT(j)]); sum += c; cnt += (c > 0u) ? 1u : 0u; mine = (j == x) ? c : mine; }
        if (sum == G) break;
        __builtin_amdgcn_s_sleep(1);
        if ((++sp & 255u) == 0u) { if (xb_ld(&bar[XB_TMO])) break; if (sp > XB_SPIN_CAP) { atomicAdd(&bar[XB_TMO], 1u); break; } }
    }
    nloc = mine > 0u ? mine : 1u; nx = cnt > 0u ? cnt : 1u;
}

__device__ __forceinline__ void xcd_barrier(const XcdBarrier& b) {
    asm volatile("s_waitcnt vmcnt(0)" ::: "memory");
    __syncthreads();
    if (threadIdx.x == 0) {
        unsigned* bar = b.bar;
        __builtin_amdgcn_s_waitcnt(0);
        unsigned nloc = b.st[0], nx = b.st[1];
        if (nloc == 0u) { xcd_barrier_complete(bar, b.x, nloc, nx); b.st[0] = nloc; b.st[1] = nx; }
        const unsigned old = xb_add(&bar[XB_XSUB(b.x)], 1u);
        const unsigned gen = old / nloc;
        if (old + 1u == (gen + 1u) * nloc) {
            __builtin_amdgcn_fence(__ATOMIC_RELEASE, "agent");
            asm volatile("s_waitcnt vmcnt(0)" ::: "memory");
            const unsigned og = xb_add(&bar[XB_TOP], 1u);
            const unsigned tg = og / nx;
            if (og + 1u == (tg + 1u) * nx) xb_add(&bar[XB_TOPGEN], 1u);
            else XB_SPIN(xb_ld(&bar[XB_TOPGEN]) == tg, bar);
            __builtin_amdgcn_fence(__ATOMIC_ACQUIRE, "agent");
            xb_add(&bar[XB_XGEN(b.x)], 1u);
            asm volatile("s_waitcnt vmcnt(0)" ::: "memory");
        } else {
            XB_SPIN(xb_ld(&bar[XB_XGEN(b.x)]) == gen, bar);
            __builtin_amdgcn_fence(__ATOMIC_ACQUIRE, "agent");
            asm volatile("s_waitcnt vmcnt(0)" ::: "memory");
        }
    }
    __syncthreads();
}
constexpr int NWAVES = 8;
constexpr int D = 1024, NB = 8, S = 2048, M = NB * S, PLE = 256, QKVW = 3072, DFF = 2816, NE = 8, DFE = 3584;
constexpr float EPS = 1e-6f, LAM_INIT0 = 0.2f;
constexpr int N_PHASES = 17;
#ifndef WGM_P1
#define WGM_P1 2
#endif
#ifndef WGM_P5
#define WGM_P5 2
#endif
#ifndef WGM_P11
#define WGM_P11 2
#endif
#ifndef WGM_1U
#define WGM_1U 8
#endif
#ifndef MK_N_LAUNCHES
#define MK_N_LAUNCHES 1
#endif
#ifndef MEGA_END
#define MEGA_END N_PHASES
#endif

constexpr size_t MiB = 1u << 20;
constexpr size_t WS_CTL = 0, CTL_ZERO_BYTES = 1 * MiB;
constexpr size_t WS_COS = 1 * MiB, WS_SIN = WS_COS + 256 * 1024, WS_TOKSLOT = WS_COS + 512 * 1024, WS_QKN = WS_TOKSLOT + 256 * 1024, WS_RSTL = 7 * MiB + 512 * 1024  , WS_RSTD1 = WS_QKN + 64 * 1024, WS_RSTD2 = WS_RSTD1 + 64 * 1024;
constexpr size_t WS_LISTS = 2 * MiB, WS_GWL = WS_LISTS + 512 * 1024;
constexpr size_t WS_WPOOL = 4 * MiB, WS_WPG1 = 5 * MiB, WS_WPP1 = 7 * MiB;
constexpr size_t WS_WGU = 8 * MiB, WS_WD = 120 * MiB;
constexpr size_t WS_YS = 8 * MiB;
constexpr size_t WS_XN = 176 * MiB, WS_PROJ1 = 208 * MiB, WS_BIG = 240 * MiB;
constexpr size_t WS_WQKV = 240 * MiB, WS_WO = 246 * MiB, WS_WGU0 = 248 * MiB, WS_WD0 = 259 * MiB, WS_WPG0 = 265 * MiB, WS_WPP0 = 267 * MiB;
constexpr size_t WS_Q = 268 * MiB, WS_K = 300 * MiB, WS_V = 332 * MiB, WS_O = 364 * MiB;
constexpr size_t WS_HFF = 268 * MiB, WS_PROJ0 = 364 * MiB, WS_PB = 428 * MiB;
constexpr size_t WS_HM = 240 * MiB;
constexpr size_t WS_XNB = 396 * MiB;
constexpr size_t WS_SSQA = 3 * MiB, WS_SSQB = 460 * MiB, WS_SSQC = 461 * MiB;
constexpr size_t WS_END = 466 * MiB;
static_assert(WS_WD0 + (size_t)D * DFF * 2 <= WS_WPG0 && WS_WGU0 + (size_t)2 * DFF * D * 2 <= WS_WD0 && WS_HFF + (size_t)M * DFF * 2 <= WS_PROJ0 && WS_HM + (size_t)(2 * M + 256) * DFE * 2 <= WS_END, "d_ws map");
constexpr int CW_TMO = 0, CW_CODE = 1, CW_BAR = 4096, CW_MOECNT = 65536, CW_STEAL = 98304;

constexpr int RING_OFF = 0, RING_BYTES = 131072, LDSCTL_OFF = RING_BYTES, MISC_OFF = LDSCTL_OFF + 320, LDS_BYTES = 147456;

struct Frame { LAS unsigned char* lds; volatile LAS unsigned* MISC; gu32* ctl; int tid, lane, wave, vcu, G; };

__device__ __forceinline__ float wave_sum(float v) {
#pragma unroll
    for (int o = 1; o < 64; o <<= 1) v += __shfl_xor(v, o);
    return v;
}
__device__ __forceinline__ unsigned cvtpk(float lo, float hi) { unsigned r; asm volatile("v_cvt_pk_bf16_f32 %0, %1, %2" : "=v"(r) : "v"(lo), "v"(hi)); return r; }
__device__ __forceinline__ float bflo(unsigned w) { return __uint_as_float(w << 16); }
__device__ __forceinline__ float bfhi(unsigned w) { return __uint_as_float(w & 0xffff0000u); }

__device__ __forceinline__ int map_row(int map, int n) {
    if (map == 1) return (n & ~255) + ((n >> 5) & 1) * 128 + ((n >> 6) & 3) * 32 + (n & 31);
    if (map == 2) return ((n >> 7) << 8) + (n & 127);
    if (map == 3) return ((n >> 7) << 8) + 128 + (n & 127);
    return n;
}
typedef float f32x2g __attribute__((ext_vector_type(2)));
__device__ __forceinline__ void tr_load(f32x4 (&v)[16], f32x2g (&g)[8], const float* W, int N, int k0, int n0, int lane, const float* gk) {
    const int ksub = lane >> 4, n4 = (lane & 15) * 4;
#pragma unroll
    for (int it = 0; it < 8; ++it)
#pragma unroll
        for (int h = 0; h < 2; ++h) v[2 * it + h] = __builtin_nontemporal_load((const GAS f32x4*)(W + (size_t)(k0 + it * 8 + 2 * ksub + h) * N + n0 + n4));
    const float* gp = gk ? gk : W;
#pragma unroll
    for (int it = 0; it < 8; ++it) g[it] = *(const GAS f32x2g*)(gp + k0 + it * 8 + 2 * ksub);
}
__device__ __forceinline__ void tr_store(const f32x4 (&v)[16], bf16* dst, int ldd, int map, int k0, int n0, LAS unsigned* tile, int lane, const f32x2g (&graw)[8], float sel) {
    const int ksub = lane >> 4, q = lane & 15;
    f32x2g g[8];
#pragma unroll
    for (int it = 0; it < 8; ++it) g[it] = graw[it] * sel + (1.f - sel);
#pragma unroll
    for (int it = 0; it < 8; ++it)
#pragma unroll
        for (int j = 0; j < 4; ++j) tile[(4 * q + j) * 32 + ((4 * it + ksub) ^ ((q & 7) * 4))] = cvtpk(v[2 * it][j] * g[it].x, v[2 * it + 1][j] * g[it].y);
    LDS_WAIT(); asm volatile("" ::: "memory");
    const int c = lane & 7;
#pragma unroll
    for (int j2 = 0; j2 < 8; ++j2) { const int n = (lane >> 3) + 8 * j2, fz = ((n >> 2) & 7) * 4; const v4u w = *(const LAS v4u*)(tile + n * 32 + ((4 * c) ^ fz));
        *(GAS v4u*)(dst + (size_t)map_row(map, n0 + n) * ldd + k0 + 8 * c) = w; }
    LDS_WAIT(); asm volatile("" ::: "memory");
}
struct TItem { const float* W; bf16* dst; const float* g; int K, N, map, kb, nb; };
enum { A_X = 0, A_P, A_NORM_MIX, A_NORM_FFN, A_NORM_PLE, A_WQKV, A_WO, A_QNORM, A_KNORM, A_LQ1, A_LK1, A_LQ2, A_LK2, A_SUBLN, A_POOLW, A_POOLB, A_POOLS, A_FFNG, A_FFNU, A_FFND, A_ROUTER, A_MOEG, A_MOEU, A_MOED, A_PLEP, A_PLEG };
__device__ __forceinline__ const float* arg_ptr(int i) {
    const __attribute__((address_space(4))) char* kp = (const __attribute__((address_space(4))) char*)__builtin_amdgcn_kernarg_segment_ptr();
    unsigned off = (unsigned)i * 8u; asm volatile("" : "+s"(off));
    return *(const float* const __attribute__((address_space(4)))*)(kp + off);
}
constexpr int TI_QKV = 768, TI_O = 256, TI_FF = 704, TI_PG = 256, TI_PP = 64, TI_POOL = 64, TI_MOE = 7168;
constexpr int TI_TOTAL = TI_QKV + TI_O + 3 * TI_FF + 2 * TI_PG + 2 * TI_PP + TI_POOL + 3 * TI_MOE;
__device__ __forceinline__ void decode_item(unsigned char* ws, int r, TItem& t) {
    int ai = 0, gi = -1, gofs = 0; size_t wofs = 0;
    do {
#define TJOB(cnt, Ai, Wofs, Kp, Np, dstp, mapp, Gi, Gofs) if (r < (cnt)) { ai = (Ai); wofs = (Wofs); gi = (Gi); gofs = (Gofs); t.K = (Kp); t.N = (Np); t.dst = (bf16*)(dstp); t.map = (mapp); t.kb = r / ((Np) / 64); t.nb = r % ((Np) / 64); break; } r -= (cnt);
        if (r < TI_MOE) { const int e = r / 896; r -= e * 896; ai = A_MOEG; gi = A_NORM_FFN; gofs = D; wofs = (size_t)e * D * DFE; t.K = D; t.N = DFE; t.dst = (bf16*)(ws + WS_WGU) + (size_t)e * 2 * DFE * D; t.map = 2; t.kb = r / 56; t.nb = r % 56; break; } r -= TI_MOE;
        if (r < TI_MOE) { const int e = r / 896; r -= e * 896; ai = A_MOEU; gi = A_NORM_FFN; gofs = D; wofs = (size_t)e * D * DFE; t.K = D; t.N = DFE; t.dst = (bf16*)(ws + WS_WGU) + (size_t)e * 2 * DFE * D; t.map = 3; t.kb = r / 56; t.nb = r % 56; break; } r -= TI_MOE;
        if (r < TI_MOE) { const int e = r / 896; r -= e * 896; ai = A_MOED; wofs = (size_t)e * DFE * D; t.K = DFE; t.N = D; t.dst = (bf16*)(ws + WS_WD) + (size_t)e * D * DFE; t.map = 0; t.kb = r / 16; t.nb = r % 16; break; } r -= TI_MOE;
        TJOB(TI_QKV, A_WQKV, 0, D, QKVW, ws + WS_WQKV, 1, -1, 0)
        TJOB(TI_O, A_WO, 0, D, D, ws + WS_WO, 0, -1, 0)
        TJOB(TI_FF, A_FFNG, 0, D, DFF, ws + WS_WGU0, 2, A_NORM_FFN, 0)
        TJOB(TI_FF, A_FFNU, 0, D, DFF, ws + WS_WGU0, 3, A_NORM_FFN, 0)
        TJOB(TI_FF, A_FFND, 0, DFF, D, ws + WS_WD0, 0, -1, 0)
        TJOB(TI_PG, A_PLEG, 0, D, D, ws + WS_WPG0, 0, A_NORM_PLE, 0)
        TJOB(TI_PG, A_PLEG, (size_t)D * D, D, D, ws + WS_WPG1, 0, A_NORM_PLE, D)
        TJOB(TI_PP, A_PLEP, 0, PLE, D, ws + WS_WPP0, 0, -1, 0)
        TJOB(TI_PP, A_PLEP, (size_t)PLE * D, PLE, D, ws + WS_WPP1, 0, -1, 0)
        { const int g = r / 16; r -= g * 16; ai = A_POOLW; gi = A_NORM_MIX; gofs = D + g * 256; wofs = (size_t)g * 256 * 256; t.K = 256; t.N = 256; t.dst = (bf16*)(ws + WS_WPOOL) + (size_t)g * 256 * 256; t.map = 0; t.kb = r / 4; t.nb = r % 4; }
#undef TJOB
    } while (0);
    t.W = arg_ptr(ai) + wofs; t.g = nullptr; if (gi >= 0) t.g = arg_ptr(gi) + gofs;
}
__device__ __forceinline__ void rms_row_to_bf16(const float* xrow, const float* gain, bf16* orow, int lane) {
    const GAS f32x4* xr = (const GAS f32x4*)xrow + lane;
    f32x4 v[4]; float s = 0.f;
#pragma unroll
    for (int j = 0; j < 4; ++j) { v[j] = xr[64 * j]; s += (v[j].x * v[j].x + v[j].y * v[j].y) + (v[j].z * v[j].z + v[j].w * v[j].w); }
    const float rstd = __builtin_amdgcn_rsqf(wave_sum(s) * (1.f / D) + EPS);
    GAS unsigned long long* o8 = (GAS unsigned long long*)orow + lane;
#pragma unroll
    for (int j = 0; j < 4; ++j) { const f32x4 g = ((const GAS f32x4*)gain)[lane + 64 * j];
        o8[64 * j] = (unsigned long long)cvtpk(v[j].x * rstd * g.x, v[j].y * rstd * g.y) | ((unsigned long long)cvtpk(v[j].z * rstd * g.z, v[j].w * rstd * g.w) << 32); }
}
__device__ __forceinline__ void p_norm(Frame& F, const float* H, const float* gain, bf16* XN) {
    const int gw = F.vcu * NWAVES + F.wave, NGW = F.G * NWAVES, lane = F.lane;
    for (int m0 = gw * 4; m0 < M; m0 += NGW * 4) {
        f32x4 v[4][4];
#pragma unroll
        for (int r = 0; r < 4; ++r) { const GAS f32x4* xr = (const GAS f32x4*)(H + (size_t)(m0 + r) * D) + lane;
#pragma unroll
            for (int j = 0; j < 4; ++j) v[r][j] = xr[64 * j]; }
#pragma unroll
        for (int r = 0; r < 4; ++r) { float s = 0.f;
#pragma unroll
            for (int j = 0; j < 4; ++j) s += (v[r][j].x * v[r][j].x + v[r][j].y * v[r][j].y) + (v[r][j].z * v[r][j].z + v[r][j].w * v[r][j].w);
            const float rstd = __builtin_amdgcn_rsqf(wave_sum(s) * (1.f / D) + EPS);
            GAS unsigned long long* o8 = (GAS unsigned long long*)(XN + (size_t)(m0 + r) * D) + lane;
#pragma unroll
            for (int j = 0; j < 4; ++j) { const f32x4 g = ((const GAS f32x4*)gain)[lane + 64 * j];
                o8[64 * j] = (unsigned long long)cvtpk(v[r][j].x * rstd * g.x, v[r][j].y * rstd * g.y) | ((unsigned long long)cvtpk(v[r][j].z * rstd * g.z, v[r][j].w * rstd * g.w) << 32); } }
    }
}
__device__ __forceinline__ void conv_range(unsigned char* ws, LAS unsigned* tile, int lane_in, int it0, int step, int nmax, int it_end) {
    int lane = lane_in; asm volatile("" : "+v"(lane));
    for (int it = it0, n = 0; it < it_end && n < nmax; it += 2 * step, n += 2) {
        const bool hasb = (it + step < it_end) && (n + 1 < nmax); const int itb = hasb ? it + step : it;
        TItem ta, tb; f32x4 va[16], vb[16]; f32x2g ga[8], gb[8];
        decode_item(ws, it, ta); tr_load(va, ga, ta.W, ta.N, ta.kb * 64, ta.nb * 64, lane, ta.g);
        decode_item(ws, itb, tb); tr_load(vb, gb, tb.W, tb.N, tb.kb * 64, tb.nb * 64, lane, tb.g);
        tr_store(va, ta.dst, ta.K, ta.map, ta.kb * 64, ta.nb * 64, tile, lane, ga, ta.g ? 1.f : 0.f);
        tr_store(vb, tb.dst, tb.K, tb.map, tb.kb * 64, tb.nb * 64, tile, lane, gb, tb.g ? 1.f : 0.f);
    }
}
__device__ __forceinline__ void p0_prologue(Frame& F, unsigned char* ws) {
    const int gw = F.vcu * NWAVES + F.wave, NGW = F.G * NWAVES, gt = gw * 64 + F.lane, NGT = NGW * 64;
    for (int idx = gt; idx < S * 32; idx += NGT) {
        const int pos = idx >> 5, i = idx & 31;
        const float inv = 1.0f / __builtin_amdgcn_exp2f((float)i * (13.287712379549449f / 32.f));
        const float ang = (float)pos * inv; const double a = (double)ang * 0.15915494309189535; const float f = (float)(a - __builtin_rint(a));
        ((float*)(ws + WS_COS))[idx] = __builtin_amdgcn_cosf(f); ((float*)(ws + WS_SIN))[idx] = __builtin_amdgcn_sinf(f);
    }
    if (gt < 128) ((float*)(ws + WS_QKN))[gt] = gt < 64 ? arg_ptr(A_QNORM)[gt] : arg_ptr(A_KNORM)[gt - 64];
    { const float* pp = arg_ptr(A_P);
#pragma unroll 4
    for (int i = gt; i < 2 * M * PLE / 8; i += NGT) { const f32x4 a = ((const GAS f32x4*)pp)[2 * i], b = ((const GAS f32x4*)pp)[2 * i + 1];
        v4u w; w.x = cvtpk(a.x, a.y); w.y = cvtpk(a.z, a.w); w.z = cvtpk(b.x, b.y); w.w = cvtpk(b.z, b.w); ((GAS v4u*)(ws + WS_PB))[i] = w; } }
    p_norm(F, arg_ptr(A_X), arg_ptr(A_NORM_MIX), (bf16*)(ws + WS_XN));
    conv_range(ws, (LAS unsigned*)(F.lds + RING_OFF + F.wave * 8192), F.lane, 3 * TI_MOE + gw, NGW, 1 << 30, TI_TOTAL);
}
__device__ __forceinline__ void p_subln(Frame& F, const bf16* O, bf16* XN) {
    const int gw = F.vcu * NWAVES + F.wave, NGW = F.G * NWAVES, lane = F.lane;
    const float lam = __expf(wave_sum(arg_ptr(A_LQ1)[lane] * arg_ptr(A_LK1)[lane])) - __expf(wave_sum(arg_ptr(A_LQ2)[lane] * arg_ptr(A_LK2)[lane])) + LAM_INIT0;
    const float* subln_g = arg_ptr(A_SUBLN);
    float sg[16];
#pragma unroll
    for (int i = 0; i < 4; ++i) { const f32x4 g = *(const GAS f32x4*)(subln_g + (lane & 7) * 16 + 4 * i); sg[4 * i] = g.x; sg[4 * i + 1] = g.y; sg[4 * i + 2] = g.z; sg[4 * i + 3] = g.w; }
    for (int m = gw; m < M; m += NGW) {
        const GAS v4u* o0 = (const GAS v4u*)(O + (size_t)m * D) + 2 * lane; const GAS v4u* o1 = (const GAS v4u*)(O + (size_t)M * D + (size_t)m * D) + 2 * lane;
        const v4u a0 = o0[0], a1 = o0[1], b0 = o1[0], b1 = o1[1];
        const unsigned aw[8] = {a0.x, a0.y, a0.z, a0.w, a1.x, a1.y, a1.z, a1.w}, bw[8] = {b0.x, b0.y, b0.z, b0.w, b1.x, b1.y, b1.z, b1.w};
        float v[16]; float ss = 0.f;
#pragma unroll
        for (int i = 0; i < 8; ++i) { v[2 * i] = bflo(aw[i]) - lam * bflo(bw[i]); v[2 * i + 1] = bfhi(aw[i]) - lam * bfhi(bw[i]); ss += v[2 * i] * v[2 * i] + v[2 * i + 1] * v[2 * i + 1]; }
        ss += __shfl_xor(ss, 1); ss += __shfl_xor(ss, 2); ss += __shfl_xor(ss, 4);
        const float r = __builtin_amdgcn_rsqf(ss * (1.f / 128.f) + EPS) * (1.f - LAM_INIT0);
        v4u w0, w1;
        w0.x = cvtpk(v[0] * r * sg[0], v[1] * r * sg[1]); w0.y = cvtpk(v[2] * r * sg[2], v[3] * r * sg[3]); w0.z = cvtpk(v[4] * r * sg[4], v[5] * r * sg[5]); w0.w = cvtpk(v[6] * r * sg[6], v[7] * r * sg[7]);
        w1.x = cvtpk(v[8] * r * sg[8], v[9] * r * sg[9]); w1.y = cvtpk(v[10] * r * sg[10], v[11] * r * sg[11]); w1.z = cvtpk(v[12] * r * sg[12], v[13] * r * sg[13]); w1.w = cvtpk(v[14] * r * sg[14], v[15] * r * sg[15]);
        GAS v4u* o = (GAS v4u*)(XN + (size_t)m * D) + 2 * lane; o[0] = w0; o[1] = w1;
    }
}
__device__ __forceinline__ void p_pool(Frame& F, const bf16* H, bf16* XN, const float* ssqp) {
    LAS float* rs = (LAS float*)(F.lds + RING_OFF);
    for (int blk = F.vcu; blk < M / 64; blk += F.G) {
        const int r0 = blk * 64, t0 = r0 & (S - 1);
        if (F.tid < 80) { const int row = r0 - 16 + F.tid; float r = 0.f; if (F.tid >= 16 || t0 != 0) r = pg8::row_rstd(ssqp, row, EPS); rs[F.tid] = r; }
        __syncthreads();
        const int cq = F.tid & 127, rq = F.tid >> 7, col = 8 * cq, g = col >> 8, w = 2 << g, rbase = 16 * rq, tq = t0 + rbase;
        const bf16* Hc = H + (size_t)(r0 + rbase) * D + col;
#define LD8(dst, p) do { const v4u w_ = *(const GAS v4u*)(p); dst[0] = bflo(w_.x); dst[1] = bfhi(w_.x); dst[2] = bflo(w_.y); dst[3] = bfhi(w_.y); dst[4] = bflo(w_.z); dst[5] = bfhi(w_.z); dst[6] = bflo(w_.w); dst[7] = bfhi(w_.w); } while (0)
        float sw[8];
#pragma unroll
        for (int i = 0; i < 8; ++i) sw[i] = 0.f;
        if (tq != 0) for (int k = 1; k <= w; ++k) { float hv[8]; LD8(hv, Hc - (long)k * D); const float r = rs[16 + rbase - k];
#pragma unroll
            for (int i = 0; i < 8; ++i) sw[i] += hv[i] * r; }
#pragma unroll 1
        for (int rb = 0; rb < 16; rb += 8) {
            float nv[8][8], ov[8][8];
#pragma unroll
            for (int j = 0; j < 8; ++j) LD8(nv[j], Hc + (long)(rb + j) * D);
#pragma unroll
            for (int j = 0; j < 8; ++j) {
#pragma unroll
                for (int i = 0; i < 8; ++i) ov[j][i] = 0.f;
                if (tq + rb + j >= w) LD8(ov[j], Hc + (long)(rb + j - w) * D); }
#pragma unroll
            for (int j = 0; j < 8; ++j) { const int rl = rbase + rb + j, t = t0 + rl; const float rn = rs[16 + rl], ro = (t >= w) ? rs[16 + rl - w] : 0.f;
                const int cnt = (t + 1 < w) ? t + 1 : w; const float ic = 1.f / (float)cnt; float o[8];
#pragma unroll
                for (int i = 0; i < 8; ++i) { const float a = nv[j][i] * rn; sw[i] += a; sw[i] -= ov[j][i] * ro; o[i] = sw[i] * ic - a; }
                v4u ow; ow.x = cvtpk(o[0], o[1]); ow.y = cvtpk(o[2], o[3]); ow.z = cvtpk(o[4], o[5]); ow.w = cvtpk(o[6], o[7]);
                *(GAS v4u*)(XN + (size_t)(r0 + rl) * D + col) = ow; }
        }
#undef LD8
        __syncthreads();
    }
}

__device__ __forceinline__ void p_router(Frame& F, const bf16* H, const float* gain, const float* Wr, float* rstl, int* lists, float* gwl, int* tokslot, gu32* cntw) {
    LAS float* rec = (LAS float*)(F.lds + RING_OFF);
    const int lane = F.lane;
    float wr[4][4][8];
#pragma unroll
    for (int j = 0; j < 4; ++j)
#pragma unroll
        for (int i = 0; i < 4; ++i) { const int k = 8 * lane + 512 * (j >> 1) + 4 * (j & 1) + i; const f32x4 a = *(const GAS f32x4*)(Wr + k * 8), b = *(const GAS f32x4*)(Wr + k * 8 + 4);
            wr[j][i][0] = a.x; wr[j][i][1] = a.y; wr[j][i][2] = a.z; wr[j][i][3] = a.w; wr[j][i][4] = b.x; wr[j][i][5] = b.y; wr[j][i][6] = b.z; wr[j][i][7] = b.w; }
    f32x4 gn[4];
#pragma unroll
    for (int j = 0; j < 4; ++j) gn[j] = *(const GAS f32x4*)(gain + 8 * lane + 512 * (j >> 1) + 4 * (j & 1));
    for (int blk = F.vcu; blk < M / 64; blk += F.G) {
        v4u raw[8][2];
#pragma unroll
        for (int rr = 0; rr < 8; ++rr) { const GAS v4u* xr = (const GAS v4u*)(H + (size_t)(blk * 64 + F.wave * 8 + rr) * D) + lane;
#pragma unroll
            for (int p = 0; p < 2; ++p) raw[rr][p] = xr[64 * p]; }
#pragma unroll
        for (int rr = 0; rr < 8; ++rr) {
            const int rl = F.wave * 8 + rr;
            f32x4 v[4]; float s = 0.f;
#pragma unroll
            for (int j = 0; j < 4; ++j) { const v4u a = raw[rr][j >> 1]; const unsigned lo = (j & 1) ? a.z : a.x, hi = (j & 1) ? a.w : a.y; v[j] = (f32x4){bflo(lo), bfhi(lo), bflo(hi), bfhi(hi)}; s += (v[j].x * v[j].x + v[j].y * v[j].y) + (v[j].z * v[j].z + v[j].w * v[j].w); }
            const float rstd = __builtin_amdgcn_rsqf(wave_sum(s) * (1.f / D) + EPS);
            float lg[8];
#pragma unroll
            for (int e = 0; e < 8; ++e) lg[e] = 0.f;
#pragma unroll
            for (int j = 0; j < 4; ++j) { const float xu[4] = {v[j].x * rstd, v[j].y * rstd, v[j].z * rstd, v[j].w * rstd};
                const float xv[4] = {xu[0] * gn[j].x, xu[1] * gn[j].y, xu[2] * gn[j].z, xu[3] * gn[j].w};
#pragma unroll
                for (int i = 0; i < 4; ++i)
#pragma unroll
                    for (int e = 0; e < 8; ++e) lg[e] = __builtin_fmaf(xv[i], wr[j][i][e], lg[e]); }
#pragma unroll
            for (int e = 0; e < 8; ++e) lg[e] = wave_sum(lg[e]);
            int i0 = 0; float v0 = lg[0];
#pragma unroll
            for (int e = 1; e < 8; ++e) if (lg[e] > v0) { v0 = lg[e]; i0 = e; }
            int i1 = 0; float v1 = -INFINITY;
#pragma unroll
            for (int e = 0; e < 8; ++e) if (e != i0 && lg[e] > v1) { v1 = lg[e]; i1 = e; }
            const float g1 = 1.f / (1.f + __expf(v0 - v1)), g0 = 1.f - g1;
            if (lane == 0) { rec[rl * 8 + 0] = __int_as_float(i0); rec[rl * 8 + 1] = __int_as_float(i1); rec[rl * 8 + 2] = g0; rec[rl * 8 + 3] = g1; rec[rl * 8 + 4] = rstd; }
        }
        __syncthreads();
        {
            const int ex = F.wave, rl = lane; const int a = __float_as_int(rec[rl * 8]), b = __float_as_int(rec[rl * 8 + 1]);
            const bool sel = (a == ex) || (b == ex); const unsigned long long bal = __ballot(sel);
            const int n = __popcll(bal), pre = __popcll(bal & ((1ull << lane) - 1ull));
            int base = 0; if (lane == 0) base = (int)__hip_atomic_fetch_add(cntw + 64 * ex, (unsigned)n, RLX_AGENT);
            base = __builtin_amdgcn_readfirstlane(base);
            if (sel) { const int k = (a == ex) ? 0 : 1, tok = blk * 64 + rl, pos = base + pre;
                lists[ex * M + pos] = tok; gwl[ex * M + pos] = rec[rl * 8 + 2 + k]; rstl[ex * M + pos] = rec[rl * 8 + 4]; tokslot[tok * 2 + k] = (ex << 16) | pos; }
        }
        __syncthreads();
    }
}
__device__ __forceinline__ void p_combine(Frame& F, bf16* HB, const bf16* Ys, const int* tokslot, float* rstd_out) {
    const int gw = F.vcu * NWAVES + F.wave, NGW = F.G * NWAVES, lane = F.lane;
    int off[8]; { int a = 0;
#pragma unroll
        for (int e = 0; e < 8; ++e) { off[e] = a; a += (int)__hip_atomic_load(F.ctl + CW_MOECNT + 64 * e, RLX_AGENT); } }
    constexpr int RPW = 8;
    for (int m0 = gw * RPW; m0 < M; m0 += NGW * RPW) {
        const int ts = (lane < 2 * RPW) ? tokslot[2 * m0 + lane] : 0;
#pragma unroll
        for (int g = 0; g < RPW; g += 4) {
            v4u ya[4][2], yb[4][2], hh[4][2];
#pragma unroll
            for (int r = 0; r < 4; ++r) {
                const int ts0 = __builtin_amdgcn_readlane(ts, 2 * (g + r)), ts1 = __builtin_amdgcn_readlane(ts, 2 * (g + r) + 1);
                int s0 = ts0 & 0xffff, s1 = ts1 & 0xffff;
#pragma unroll
                for (int e = 0; e < 8; ++e) { if ((ts0 >> 16) == e) s0 += off[e]; if ((ts1 >> 16) == e) s1 += off[e]; }
                const GAS v4u* hr = (const GAS v4u*)(HB + (size_t)(m0 + g + r) * D) + lane;
                const GAS v4u* y0 = (const GAS v4u*)(Ys + (size_t)s0 * D) + lane; const GAS v4u* y1 = (const GAS v4u*)(Ys + (size_t)s1 * D) + lane;
#pragma unroll
                for (int j = 0; j < 2; ++j) { ya[r][j] = y0[64 * j]; yb[r][j] = y1[64 * j]; hh[r][j] = hr[64 * j]; }
            }
#pragma unroll
            for (int r = 0; r < 4; ++r) {
                GAS v4u* hw = (GAS v4u*)(HB + (size_t)(m0 + g + r) * D) + lane; float s = 0.f;
#pragma unroll
                for (int j = 0; j < 2; ++j) { const unsigned aw[4] = {ya[r][j].x, ya[r][j].y, ya[r][j].z, ya[r][j].w}, bw_[4] = {yb[r][j].x, yb[r][j].y, yb[r][j].z, yb[r][j].w}, hw_[4] = {hh[r][j].x, hh[r][j].y, hh[r][j].z, hh[r][j].w};
                    unsigned ow[4];
#pragma unroll
                    for (int q = 0; q < 4; ++q) { ow[q] = cvtpk(bflo(hw_[q]) + (bflo(aw[q]) + bflo(bw_[q])), bfhi(hw_[q]) + (bfhi(aw[q]) + bfhi(bw_[q]))); s += bflo(ow[q]) * bflo(ow[q]) + bfhi(ow[q]) * bfhi(ow[q]); }
                    v4u o; o.x = ow[0]; o.y = ow[1]; o.z = ow[2]; o.w = ow[3]; hw[64 * j] = o; }
                const float rstd = __builtin_amdgcn_rsqf(wave_sum(s) * (1.f / D) + EPS);
                if (lane == 0) rstd_out[m0 + g + r] = rstd;
            }
        }
    }
}

struct Args { const float* in[26]; float* out; unsigned char* ws; int ph_lo, ph_hi, li, pad; };
__global__ void __launch_bounds__(NWAVES * 64, 2) mega_fwd(Args args) {
    extern __shared__ __attribute__((aligned(16))) unsigned char lds[];
    Frame F;
    F.lds = (LAS unsigned char*)lds;
    F.MISC = (volatile LAS unsigned*)(F.lds + MISC_OFF);
    F.tid = threadIdx.x; F.lane = F.tid & 63; F.wave = __builtin_amdgcn_readfirstlane(F.tid >> 6);
    F.G = gridDim.x; { const int bx = blockIdx.x; F.vcu = (F.G % 8 == 0) ? (bx % 8) * (F.G / 8) + bx / 8 : bx; }
    unsigned char* ws = args.ws;
    F.ctl = (gu32*)(ws + WS_CTL);
    float* const Hout = args.out;
    for (int u = F.tid; u < (LDS_BYTES - LDSCTL_OFF) / 4; u += NWAVES * 64) ((LAS unsigned*)(F.lds + LDSCTL_OFF))[u] = 0u;
    __syncthreads();
    XcdBarrier bar; bar.bar = (unsigned*)(F.ctl + CW_BAR) + args.li * XCD_BAR_WORDS; bar.x = 0; bar.st = nullptr;
    const int lo = args.ph_lo, hi = args.ph_hi;
    if (hi - lo > 1) bar = xcd_barrier_post((unsigned*)(F.ctl + CW_BAR) + args.li * XCD_BAR_WORDS, F.MISC + 8);
#ifndef PHASE_MASK
#define PHASE_MASK 0x1ffff
#endif
#define IN(k) (((PHASE_MASK >> (k)) & 1) && lo <= (k) && (k) < hi)
#define SEAM(k) do { if (IN(k) && IN((k) + 1)) xcd_barrier(bar); } while (0)
#ifndef REP_MASK
#define REP_MASK 0
#endif
#define REPS(k) (((REP_MASK >> (k)) & 1) ? 2 : 1)
#define REPEAT(k) _Pragma("unroll 1") for (int rep_ = 0; rep_ < REPS(k); (++rep_ < REPS(k)) ? xcd_barrier(bar) : (void)0)
    bf16* XN = (bf16*)(ws + WS_XN);
    const int bx = (int)blockIdx.x;
    const long TS1024 = 256L * 1024 * 2;

    float* SSQA = (float*)(ws + WS_SSQA); float* SSQB = (float*)(ws + WS_SSQB); float* SSQC = (float*)(ws + WS_SSQC);
    if (IN(0)) REPEAT(0) { p0_prologue(F, ws); } SEAM(0);
    if (IN(1)) REPEAT(1) {
        pg8::DenseSched Sd{(const char*)XN, (const char*)(ws + WS_WQKV), 64, 12, F.G, bx, TS1024, 0, TS1024, WGM_P1};
        pg8::EpiQKV E{(bf16*)(ws + WS_Q), (size_t)(WS_K - WS_Q) / 2, (const float*)(ws + WS_QKN), (const float*)(ws + WS_COS), (const float*)(ws + WS_SIN), attn_body::C2, EPS};
        pg8::gemm_phase<pg8::EpiQKV, pg8::DenseSched, false, true>(F.lds + RING_OFF, D, D, D, Sd, E);
    } SEAM(1);
    if (IN(2)) REPEAT(2) {
        static_assert(attn_body::ATTN128_LDS_BYTES <= RING_BYTES, "attention LDS");
        const float lam = __expf(wave_sum(arg_ptr(A_LQ1)[F.lane] * arg_ptr(A_LK1)[F.lane])) - __expf(wave_sum(arg_ptr(A_LQ2)[F.lane] * arg_ptr(A_LK2)[F.lane])) + LAM_INIT0;
        const float* subg = arg_ptr(A_SUBLN);
        const int hgrp = (F.vcu * 3) / F.G; const int hkpos = (hgrp == 0) ? -1 : (hgrp == 1) ? 0 : 2; bool conv_done = false;
        for (int hc = F.vcu; hc < NB * 8 * 4; hc += F.G) {
            const int bh = hc >> 2, s_ = hc & 3, b = bh >> 3, h = bh & 7;
            const attn_body::bf16* Vp = (const attn_body::bf16*)(ws + WS_V) + h * 128; attn_body::bf16* Op = (attn_body::bf16*)(ws + WS_O) + h * 128;
            _Pragma("unroll 1") for (int qi = -1; qi < 4; ++qi) {
                if (qi >= 0) { int qb = (qi & 2) ? s_ : 7 - s_; asm volatile("" : "+s"(qb)); const int c = qi & 1;
                    const attn_body::bf16* Qp = (const attn_body::bf16*)(ws + WS_Q) + (h * 2 + c) * 64; const attn_body::bf16* Kp = (const attn_body::bf16*)(ws + WS_K) + (h * 2 + c) * 64;
                    if (c == 0) attn_body::attn_unit128<8, false>(b, qb, Qp, Kp, Vp, Op, (char*)lds + RING_OFF);
                    else attn_body::attn_unit128<8, true>(b, qb, Qp, Kp, Vp, Op, (char*)lds + RING_OFF, (attn_body::bf16*)XN + h * 128, subg, lam, 1.f - LAM_INIT0, EPS); }
                if (qi == hkpos && !conv_done) {
                    conv_range(ws, (LAS unsigned*)(F.lds + RING_OFF + F.wave * 8192), F.lane, F.vcu * NWAVES + F.wave, F.G * NWAVES, 1 << 30, 2 * TI_MOE); conv_done = true;
                    asm volatile("s_waitcnt lgkmcnt(0)" ::: "memory"); __builtin_amdgcn_s_barrier(); asm volatile("" ::: "memory"); }
            }
        }
    } SEAM(2);
    bf16* HB0 = (bf16*)Hout;
    bf16* HB1 = XN;
    bf16* PL = (bf16*)(ws + WS_Q);
    if (IN(4)) REPEAT(4) {
        pg8::DenseSched Sd{(const char*)XN, (const char*)(ws + WS_WO), 64, 4, F.G, bx, TS1024, 0, TS1024, WGM_1U};
        pg8::EpiResNorm<false> E{arg_ptr(A_X), HB0, SSQA};
        pg8::gemm_phase<pg8::EpiResNorm<false>, pg8::DenseSched, false, true>(F.lds + RING_OFF, D, D, D, Sd, E);
    } SEAM(4);
    if (IN(5)) REPEAT(5) {
        { pg8::DenseSched Sd{(const char*)HB0, (const char*)(ws + WS_WGU0), 64, 22, F.G, bx, TS1024, 0, TS1024, WGM_P5};
          pg8::EpiSwiGLU<1> E{(bf16*)(ws + WS_HFF), DFF, EPS, SSQA, nullptr};
          pg8::gemm_phase<pg8::EpiSwiGLU<1>, pg8::DenseSched, false, true>(F.lds + RING_OFF, D, D, D, Sd, E); }
        { const bool split = (F.G == 256);
          pg8::ProjSched Sp{(const char*)(ws + WS_PB), (const char*)(ws + WS_WPP0), (long)M * PLE * 2, (long)WS_WPP1 - (long)WS_WPP0, split ? 128 : F.G, split ? bx - 128 : bx};
          pg8::EpiProj E{(bf16*)(ws + WS_PROJ0), ((long)WS_PROJ1 - (long)WS_PROJ0) / 2};
          pg8::gemm_phase<pg8::EpiProj, pg8::ProjSched, false, true>(F.lds + RING_OFF, PLE, PLE, PLE, Sp, E); }
    } SEAM(5);
    if (IN(6)) {
        pg8::DenseSched Sd{(const char*)(ws + WS_HFF), (const char*)(ws + WS_WD0), 64, 4, F.G, bx, 256L * DFF * 2, 0, 256L * DFF * 2, WGM_1U};
        pg8::EpiResNorm<true> E{HB0, HB0, SSQB};
        pg8::gemm_phase<pg8::EpiResNorm<true>, pg8::DenseSched, false, true>(F.lds + RING_OFF, DFF, DFF, DFF, Sd, E);
    } SEAM(6);
    if (IN(7)) {
        pg8::DenseSched Sd{(const char*)HB0, (const char*)(ws + WS_WPG0), 64, 4, F.G, bx, TS1024, 0, TS1024, WGM_1U};
        pg8::EpiPle<1, false> E{HB0, (const bf16*)(ws + WS_PROJ0), HB1, SSQB, SSQC, EPS, 0};
        pg8::gemm_phase<pg8::EpiPle<1, false>, pg8::DenseSched, false, true>(F.lds + RING_OFF, D, D, D, Sd, E);
    } SEAM(7);
    if (IN(8)) REPEAT(8) { p_pool(F, HB1, PL, SSQC); } SEAM(8);
    if (IN(9)) {
        pg8::DenseSched Sd{(const char*)PL, (const char*)(ws + WS_WPOOL), 64, 4, F.G, bx, TS1024, 256L * 2, 256L * 256 * 2, WGM_1U};
        pg8::EpiPool E{HB1, arg_ptr(A_POOLB), arg_ptr(A_POOLS)};
        pg8::gemm_phase<pg8::EpiPool, pg8::DenseSched, false, true>(F.lds + RING_OFF, 256, D, 256, Sd, E);
    } SEAM(9);
    if (IN(10)) REPEAT(10) { const bool dmy = rep_ + 1 < REPS(10); unsigned char* wd = dmy ? ws + 300 * MiB : ws;
        p_router(F, HB1, arg_ptr(A_NORM_FFN) + D, arg_ptr(A_ROUTER), (float*)(wd + WS_RSTL), (int*)(wd + WS_LISTS), (float*)(wd + WS_GWL), (int*)(wd + WS_TOKSLOT), F.ctl + CW_MOECNT + (dmy ? 1024 : 0)); } SEAM(10);
    if (IN(11)) REPEAT(11) {
        pg8::MoeSched Sm; Sm.A = (const char*)HB1; Sm.B = (const char*)(ws + WS_WGU); Sm.lists = (const int*)(ws + WS_LISTS);
#pragma unroll
        for (int e = 0; e < 8; ++e) Sm.cnt[e] = __builtin_amdgcn_readfirstlane((int)__hip_atomic_load(F.ctl + CW_MOECNT + 64 * e, RLX_AGENT));
        Sm.nN = 28; Sm.G = F.G; Sm.c = bx; Sm.b_e = 2L * DFE * D * 2; Sm.b_pn = TS1024; Sm.a_row = 0; Sm.list_stride = M; Sm.gather = true; Sm.WGM = WGM_P11; Sm.lim = Sm.total();
        pg8::EpiSwiGLU<2> E{(bf16*)(ws + WS_HM), DFE, EPS, (const float*)(ws + WS_RSTL), (const int*)(ws + WS_LISTS)};
        pg8::gemm_phase<pg8::EpiSwiGLU<2>, pg8::MoeSched, true, true>(F.lds + RING_OFF, D, D, D, Sm, E);
        if (rep_ == 0) {
            volatile LAS int* bw = (volatile LAS int*)(F.lds + MISC_OFF + 96);
            for (;;) {
                if (F.tid == 0) bw[0] = (int)__hip_atomic_fetch_add(F.ctl + CW_STEAL, 1u, RLX_AGENT);
                __syncthreads();
                const int batch = __builtin_amdgcn_readfirstlane(bw[0]);
                __syncthreads();
                if (batch * 16 >= TI_MOE) break;
                conv_range(ws, (LAS unsigned*)(F.lds + RING_OFF + F.wave * 8192), F.lane, 2 * TI_MOE + batch * 16 + F.wave * 2, 1, 2, 3 * TI_MOE);
            }
        }
    } SEAM(11);
    pg8::MoeSched Sdn; Sdn.A = (const char*)(ws + WS_HM); Sdn.B = (const char*)(ws + WS_WD); Sdn.lists = (const int*)(ws + WS_GWL);
    Sdn.nN = 4; Sdn.G = F.G; Sdn.c = bx; Sdn.b_e = (long)D * DFE * 2; Sdn.b_pn = 256L * DFE * 2; Sdn.a_row = (long)DFE * 2; Sdn.list_stride = M; Sdn.gather = false; Sdn.WGM = 8; Sdn.lim = 0;
    int dn_R = 0, dn_P = 1;
    if (IN(12) || IN(13) || IN(14)) {
#pragma unroll
        for (int e = 0; e < 8; ++e) Sdn.cnt[e] = __builtin_amdgcn_readfirstlane((int)__hip_atomic_load(F.ctl + CW_MOECNT + 64 * e, RLX_AGENT));
        const int tot = Sdn.total(), whole = (tot / F.G) * F.G;
        dn_R = tot - whole; Sdn.lim = whole;
        dn_P = (dn_R * 14 <= 192 && dn_R * 14 <= F.G) ? 14 : (dn_R * 7 <= 192 && dn_R * 7 <= F.G) ? 7 : (dn_R * 4 <= 192 && dn_R * 4 <= F.G) ? 4 : (dn_R * 2 <= 192 && dn_R * 2 <= F.G) ? 2 : 1;
        if (dn_R * dn_P > 192 || dn_R * dn_P > F.G) { Sdn.lim = tot; dn_R = 0; }
    }
    float* PART = (float*)(ws + 72 * MiB);
    if (IN(12)) REPEAT(12) {
        pg8::EpiMoeDown E{(bf16*)(ws + WS_YS)};
        pg8::gemm_phase<pg8::EpiMoeDown, pg8::MoeSched, false, true>(F.lds + RING_OFF, DFE, DFE, DFE, Sdn, E);
    }
    if (IN(13) && dn_R > 0) {
        pg8::PieceSched Sp{Sdn, Sdn.lim, dn_R, dn_P, (long)(DFE / dn_P) * 2};
        pg8::EpiPart E{PART};
        pg8::gemm_phase<pg8::EpiPart, pg8::PieceSched, false, true>(F.lds + RING_OFF, DFE / dn_P, DFE, DFE, Sp, E);
    }
    if (IN(13) && IN(14) && dn_R > 0) xcd_barrier(bar);
    if (IN(14) && dn_R > 0) {
        for (int w = F.vcu; w < dn_R * 16; w += F.G) {
            const int j = w >> 4, rl = (w & 15) * 16 + (F.tid >> 5), cl = (F.tid & 31) * 8;
            pg8::Unit u; Sdn.decode(Sdn.lim + j, u);
            if (rl < u.nvalid) {
                const float* pp = PART + (size_t)(j * dn_P) * 65536 + (size_t)rl * 256 + cl;
                f32x4 a = (f32x4){0.f, 0.f, 0.f, 0.f}, b = a;
                for (int p = 0; p < dn_P; ++p) { a += *(const GAS f32x4*)(pp + (size_t)p * 65536); b += *(const GAS f32x4*)(pp + (size_t)p * 65536 + 4); }
                const float gwt = ((const float*)u.list)[rl];
                v4u o; o.x = cvtpk(a.x * gwt, a.y * gwt); o.y = cvtpk(a.z * gwt, a.w * gwt); o.z = cvtpk(b.x * gwt, b.y * gwt); o.w = cvtpk(b.z * gwt, b.w * gwt);
                *(GAS v4u*)((bf16*)(ws + WS_YS) + (size_t)(u.r0 + rl) * D + u.c0 + cl) = o;
            }
        }
    }
    if ((IN(12) || IN(13) || IN(14)) && IN(15)) xcd_barrier(bar);
    if (IN(15)) { p_combine(F, HB1, (const bf16*)(ws + WS_YS), (const int*)(ws + WS_TOKSLOT), (float*)(ws + WS_RSTD2)); } SEAM(15);
    if (IN(16)) {
        pg8::DenseSched Sd{(const char*)HB1, (const char*)(ws + WS_WPG1), 64, 4, F.G, bx, TS1024, 0, TS1024, WGM_1U};
        pg8::EpiPle<2, true> E{HB1, (const bf16*)(ws + WS_PROJ1), Hout, (const float*)(ws + WS_RSTD2), nullptr, EPS, 0};
        pg8::gemm_phase<pg8::EpiPle<2, true>, pg8::DenseSched, false, true>(F.lds + RING_OFF, D, D, D, Sd, E);
    }
#undef IN
#undef SEAM
}
extern "C" void kernel_launch(void* const* d_in, const int* in_sizes, int n_in, void* d_out, int out_size, void* d_ws, size_t ws_size, hipStream_t stream) {
    static int grid = 0;
    if (grid == 0) {
        if (n_in != 26 || in_sizes[0] != M * D || out_size != M * D || ws_size < WS_END) { fprintf(stderr, "kernel_launch: unexpected shapes / workspace (%zu)\n", ws_size); grid = -1; return; }
        int dev = 0, cus = 0, per_cu = 0;
        if (hipGetDevice(&dev) != hipSuccess || hipDeviceGetAttribute(&cus, hipDeviceAttributeMultiprocessorCount, dev) != hipSuccess) { grid = -1; return; }
        if (hipFuncSetAttribute((const void*)mega_fwd, hipFuncAttributeMaxDynamicSharedMemorySize, LDS_BYTES) != hipSuccess) { fprintf(stderr, "kernel_launch: hipFuncSetAttribute failed\n"); grid = -1; return; }
        if (hipOccupancyMaxActiveBlocksPerMultiprocessor(&per_cu, (const void*)mega_fwd, NWAVES * 64, LDS_BYTES) != hipSuccess || per_cu < 1) { fprintf(stderr, "kernel_launch: occupancy query says %d\n", per_cu); }
        (void)hipGetLastError();
        grid = cus;
    }
    if (grid < 0) return;
    if (hipMemsetAsync((char*)d_ws + WS_CTL, 0, CTL_ZERO_BYTES, stream) != hipSuccess) return;
    Args a{};
    for (int i = 0; i < 26; ++i) a.in[i] = (const float*)d_in[i];
    a.out = (float*)d_out; a.ws = (unsigned char*)d_ws;
#if MK_N_LAUNCHES == 1
    a.ph_lo = 0; a.ph_hi = MEGA_END; a.li = 0; a.pad = 0;
    hipLaunchKernelGGL(mega_fwd, dim3(grid), dim3(NWAVES * 64), LDS_BYTES, stream, a);
#else
    for (int ph = 0; ph < MEGA_END; ++ph) { a.ph_lo = ph; a.ph_hi = ph + 1; a.li = 0; a.pad = 0; hipLaunchKernelGGL(mega_fwd, dim3(grid), dim3(NWAVES * 64), LDS_BYTES, stream, a); }
#endif
#if MEGA_END < 17
    nv::naive_suffix(MEGA_END <= 5 ? 0 : MEGA_END <= 7 ? 1 : MEGA_END <= 8 ? 2 : MEGA_END <= 10 ? 3 : 4, d_in, (float*)d_out, (char*)d_ws, stream);
#endif
}
```

```cpp
#define MEGA_END 17
#define MK_N_LAUNCHES 1
#include <hip/hip_runtime.h>
#include <cstdio>
#include <cstdint>
namespace pg8 {
#define PG8_LAS __attribute__((address_space(3)))
typedef unsigned short bf16_t;
typedef short bf16x8 __attribute__((ext_vector_type(8)));
typedef float f32x4 __attribute__((ext_vector_type(4)));
typedef float f32x2 __attribute__((ext_vector_type(2)));
typedef unsigned u32x4 __attribute__((ext_vector_type(4)));
typedef unsigned u32x2 __attribute__((ext_vector_type(2)));
constexpr int BM = 256, BK = 64, HALF = 128, HTB = HALF * BK * 2  , STAGE_BYTES = 8 * HTB, NXCD = 8;

__host__ __device__ __forceinline__ int lds_byte(int r, int c) { const int st = (r >> 4) * 2 + (c >> 5), rr = r & 15, cc = c & 31, ob = rr * 64 + cc * 2; return st * 1024 + (ob ^ (((ob >> 9) & 1) << 5)); }
__host__ __device__ __forceinline__ void stage_rc(int b, int& R, int& C) { const int st = b / 1024, sb = b % 1024, swz = sb ^ (((sb >> 9) & 1) << 5); R = (st >> 1) * 16 + swz / 64; C = (st & 1) * 32 + (swz % 64) / 2; }
__host__ __device__ __forceinline__ int perm32(int rho) { const int n = rho >> 4, i = rho & 15; return 8 * (i >> 2) + 4 * n + (i & 3); }

struct Unit { const char* A; const char* B; const int* list; int r0, c0, nvalid, ex; };
struct Pre { float rs[2][4]; };

__device__ __forceinline__ unsigned cvt_pk_bf16(float lo, float hi) { unsigned r; asm volatile("v_cvt_pk_bf16_f32 %0, %1, %2" : "=v"(r) : "v"(lo), "v"(hi)); return r; }
__device__ __forceinline__ float bf_lo(unsigned w) { return __uint_as_float(w << 16); }
__device__ __forceinline__ float bf_hi(unsigned w) { return __uint_as_float(w & 0xffff0000u); }

__device__ __forceinline__ void tile_of(int L, int nM, int nN, int& pm, int& pn, int WGM = 8) {
    const int nwg = nM * nN; int wgid = L; { const int q = nwg / NXCD, r = nwg % NXCD, xcd = wgid % NXCD, off = wgid / NXCD; wgid = (xcd < r ? xcd * (q + 1) : r * (q + 1) + (xcd - r) * q) + off; }
    const int nig = WGM * nN, gid = wgid / nig, fm = gid * WGM, gsz = (nM - fm) < WGM ? (nM - fm) : WGM;
    pm = fm + ((wgid % nig) % gsz); pn = (wgid % nig) / gsz;
}
struct DenseSched {
    const char* A; const char* B; int nM, nN, G, c; long a_pm, a_pn, b_pn; int wgm;
    __device__ __forceinline__ bool next(int i, Unit& u) const {
        if (c < 0) return false; const long L = (long)i * G + c; if (L >= (long)nM * nN) return false;
        int pm, pn; tile_of((int)L, nM, nN, pm, pn, wgm);
        u.A = A + pm * a_pm + pn * a_pn; u.B = B + pn * b_pn; u.list = nullptr; u.r0 = pm * BM; u.c0 = pn * BM; u.nvalid = BM; u.ex = 0; return true;
    }
};
struct ProjSched {
    const char* A0; const char* B0; long dA, dB; int G, c;
    __device__ __forceinline__ bool next(int i, Unit& u) const {
        if (c < 0) return false; const long L = (long)i * G + c; if (L >= 64 * 8) return false;
        int pm, pn; tile_of((int)L, 64, 8, pm, pn, 8); const int layer = pn >> 2, pc = pn & 3;
        u.A = A0 + layer * dA + (long)pm * (256 * 256 * 2); u.B = B0 + layer * dB + (long)pc * (256 * 256 * 2); u.list = nullptr; u.r0 = pm * BM; u.c0 = pc * BM; u.nvalid = BM; u.ex = layer; return true;
    }
};
struct MoeSched {
    const char* A; const char* B; const int* lists; int cnt[8]; int nN, G, c; long b_e, b_pn, a_row; int list_stride; bool gather; int lim; int WGM;
    __device__ __forceinline__ int total() const { int tot = 0;
#pragma unroll
        for (int e = 0; e < 8; ++e) tot += ((cnt[e] + 255) >> 8) * nN;
        return tot; }
    __device__ __forceinline__ void decode(int L, Unit& u) const {
        const int tot = total();
        int w = L; { const int q = tot / NXCD, r = tot % NXCD, xcd = w % NXCD, off = w / NXCD; w = (xcd < r ? xcd * (q + 1) : r * (q + 1) + (xcd - r) * q) + off; }
        int ex = 0, off_rows = 0, tiles = 0, ce = 0; bool found = false;
#pragma unroll
        for (int e = 0; e < 8; ++e) { const int t = (cnt[e] + 255) >> 8, ue = t * nN; if (!found) { if (w < ue) { found = true; ex = e; tiles = t; ce = cnt[e]; } else { w -= ue; off_rows += cnt[e]; } } }
        const int nig = WGM * nN, gid = w / nig, fm = gid * WGM, gsz = (tiles - fm) < WGM ? (tiles - fm) : WGM;
        const int pm = fm + ((w % nig) % gsz), pn = (w % nig) / gsz;
        u.r0 = off_rows + pm * BM; u.c0 = pn * BM; u.nvalid = (ce - pm * BM) < BM ? (ce - pm * BM) : BM; u.ex = ex;
        u.B = B + ex * b_e + pn * b_pn;
        u.list = lists + (long)ex * list_stride + pm * BM;
        u.A = gather ? A : A + (long)u.r0 * a_row;
    }
    __device__ __forceinline__ bool next(int i, Unit& u) const {
        const long L0 = (long)i * G + c; if (L0 >= lim) return false;
        decode((int)L0, u); return true;
    }
};
struct PieceSched {
    MoeSched S; int L0, R, P; long kbytes;
    __device__ __forceinline__ bool next(int i, Unit& u) const {
        if (i != 0 || S.c >= R * P) return false;
        const int q = S.c, j = q / P, p = q - j * P;
        S.decode(L0 + j, u); u.A += p * kbytes; u.B += p * kbytes; u.ex = q; return true;
    }
};

template <class Epi, class Sched, bool GATHER, bool ALIGN_EPI>
__device__ __forceinline__ void gemm_phase(PG8_LAS unsigned char* lds, const int K, const int lda, const int ldb, const Sched& S, const Epi& E) {
    int tid_ = threadIdx.x; asm volatile("" : "+v"(tid_));
    const int tid = tid_, wid = __builtin_amdgcn_readfirstlane(tid >> 6), lane = tid & 63, wr = wid >> 2, wc = wid & 3, fr = lane & 15, fq = lane >> 4;
    int Kr_ = K; asm volatile("" : "+s"(Kr_));
    const int nt = Kr_ / BK;
    int RA[2], CA[2]; unsigned voffB[2];
#pragma unroll
    for (int i = 0; i < 2; ++i) { int R, C; stage_rc(tid * 16 + i * 8192, R, C); RA[i] = R; CA[i] = C; const int Rb = Epi::PERM ? ((R & ~31) + perm32(R & 31)) : R; voffB[i] = (unsigned)(Rb * ldb + C) * 2u; }
    const size_t kstep = (size_t)(BK * 2);
    const size_t hstep = (size_t)HALF * ldb * 2;
    const unsigned ldsw = (unsigned)wid * 1024u;
    const int aoff = lds_byte(wr * 64 + fr, fq * 8), boff = lds_byte(wc * 32 + fr, fq * 8);
#define PG8_SA(b, h) (((b) * 2 + (h)) * HTB)
#define PG8_SB(b, h) ((4 + (b) * 2 + (h)) * HTB)
#define PG8_STAGE(bufoff, gbase, voff) do { _Pragma("unroll") for (int _i = 0; _i < 2; ++_i) \
        __builtin_amdgcn_global_load_lds((const unsigned*)((const char*)(gbase) + (voff)[_i]), (PG8_LAS unsigned*)(lds + (bufoff) + ldsw + _i * 8192), 16, 0, 0); } while (0)
#define PG8_SETOFF(v, u) do { _Pragma("unroll") for (int _h = 0; _h < 2; ++_h) _Pragma("unroll") for (int _i = 0; _i < 2; ++_i) { const int _r = _h * HALF + RA[_i]; \
        if constexpr (GATHER) { const int _rr = _r < (u).nvalid ? _r : (u).nvalid - 1; v[_h][_i] = (unsigned)(u).list[_rr] * (unsigned)(lda * 2) + (unsigned)(CA[_i] * 2); } \
        else { v[_h][_i] = (unsigned)(_r * lda + CA[_i]) * 2u; } } } while (0)
#define PG8_LDA(dst, b, h) do { _Pragma("unroll") for (int m = 0; m < 4; ++m) _Pragma("unroll") for (int k = 0; k < 2; ++k) dst[m][k] = *(const PG8_LAS bf16x8*)(lds + PG8_SA(b, h) + aoff + m * 2048 + k * 1024); } while (0)
#define PG8_LDB(dst, b, h) do { _Pragma("unroll") for (int n = 0; n < 2; ++n) _Pragma("unroll") for (int k = 0; k < 2; ++k) dst[n][k] = *(const PG8_LAS bf16x8*)(lds + PG8_SB(b, h) + boff + n * 2048 + k * 1024); } while (0)
#define PG8_MMA(ai, bj, At, Bt) do { __builtin_amdgcn_s_setprio(1); _Pragma("unroll") for (int m = 0; m < 4; ++m) _Pragma("unroll") for (int n = 0; n < 2; ++n) _Pragma("unroll") for (int k = 0; k < 2; ++k) \
        acc[ai][bj][m][n] = __builtin_amdgcn_mfma_f32_16x16x32_bf16(Bt[n][k], At[m][k], acc[ai][bj][m][n], 0, 0, 0); __builtin_amdgcn_s_setprio(0); } while (0)
#define PG8_WAIT_V(n) asm volatile("s_waitcnt vmcnt(" #n ")" ::: "memory")
#define PG8_WAIT_L(n) asm volatile("s_waitcnt lgkmcnt(" #n ")" ::: "memory")
#define PG8_BAR __builtin_amdgcn_s_barrier()
#define PG8_SCHED __builtin_amdgcn_sched_barrier(0)
    Unit cur, nxt; int ui = 0;
    if (!S.next(0, cur)) return;
    unsigned va[2][2], vn[2][2];
    PG8_SETOFF(va, cur);
    Pre pre; E.prefetch(cur, wr, fr, pre);
#pragma unroll
    for (int h = 0; h < 2; ++h)
#pragma unroll
        for (int i = 0; i < 2; ++i) vn[h][i] = va[h][i];
    f32x4 acc[2][2][4][2];
#pragma unroll
    for (int a = 0; a < 2; ++a)
#pragma unroll
        for (int b = 0; b < 2; ++b)
#pragma unroll
            for (int m = 0; m < 4; ++m)
#pragma unroll
                for (int n = 0; n < 2; ++n) acc[a][b][m][n] = (f32x4){0.f, 0.f, 0.f, 0.f};
    bf16x8 At[4][2], B0[2][2], B1[2][2];
    const char* cA = cur.A; const char* cB = cur.B;
    PG8_STAGE(PG8_SB(0, 0), cB, voffB); PG8_STAGE(PG8_SB(0, 1), cB + hstep, voffB); PG8_STAGE(PG8_SA(0, 0), cA, va[0]); PG8_STAGE(PG8_SA(0, 1), cA, va[1]);
    if (wr == 1) PG8_BAR;
    PG8_WAIT_V(2); PG8_BAR;
    PG8_STAGE(PG8_SB(1, 0), cB + kstep, voffB); PG8_STAGE(PG8_SA(1, 0), cA + kstep, va[0]); PG8_STAGE(PG8_SB(1, 1), cB + hstep + kstep, voffB);
    PG8_WAIT_V(6); PG8_BAR;
    for (;;) {
        const bool has_next = S.next(ui + 1, nxt);
        if constexpr (GATHER) { if (has_next) {
#pragma unroll
            for (int h = 0; h < 2; ++h)
#pragma unroll
                for (int i = 0; i < 2; ++i) { const int r_ = h * HALF + RA[i]; vn[h][i] = (unsigned)nxt.list[r_ < nxt.nvalid ? r_ : nxt.nvalid - 1]; } } }
        const char* nA = has_next ? nxt.A : cA; const char* nB = has_next ? nxt.B : cB;
        for (int t = 0; t < nt; t += 2) {
            const bool last = (t == nt - 2);
            const char* a1 = cA + (size_t)(t + 1) * kstep;
            const char* a2 = last ? nA : cA + (size_t)(t + 2) * kstep; const char* b2 = last ? nB : cB + (size_t)(t + 2) * kstep;
            const char* a3 = a2 + kstep; const char* b3 = b2 + kstep;
            unsigned o2[2][2];
#pragma unroll
            for (int h = 0; h < 2; ++h)
#pragma unroll
                for (int i = 0; i < 2; ++i) { if constexpr (GATHER) o2[h][i] = (last && has_next) ? vn[h][i] * (unsigned)(lda * 2) + (unsigned)(CA[i] * 2) : va[h][i]; else o2[h][i] = va[h][i]; }
            PG8_LDB(B0, 0, 0); PG8_LDB(B1, 0, 1); PG8_SCHED; PG8_LDA(At, 0, 0); PG8_STAGE(PG8_SA(1, 1), a1, va[1]);
            PG8_WAIT_V(8); PG8_WAIT_L(0); PG8_BAR; PG8_MMA(0, 0, At, B0); PG8_MMA(0, 1, At, B1); PG8_BAR; PG8_SCHED;
            PG8_LDA(At, 0, 1); PG8_STAGE(PG8_SB(0, 0), b2, voffB); PG8_STAGE(PG8_SB(0, 1), b2 + hstep, voffB); PG8_STAGE(PG8_SA(0, 0), a2, o2[0]);
            PG8_WAIT_V(8); PG8_WAIT_L(0); PG8_BAR; PG8_MMA(1, 0, At, B0); PG8_MMA(1, 1, At, B1); PG8_BAR; PG8_SCHED;
            PG8_LDB(B0, 1, 0); PG8_LDB(B1, 1, 1); PG8_SCHED; PG8_LDA(At, 1, 0); PG8_STAGE(PG8_SA(0, 1), a2, o2[1]);
            PG8_WAIT_V(8); PG8_WAIT_L(0); PG8_BAR; PG8_MMA(0, 0, At, B0); PG8_MMA(0, 1, At, B1); PG8_BAR; PG8_SCHED;
            PG8_LDA(At, 1, 1); PG8_STAGE(PG8_SB(1, 0), b3, voffB); PG8_STAGE(PG8_SB(1, 1), b3 + hstep, voffB); PG8_STAGE(PG8_SA(1, 0), a3, o2[0]);
            PG8_WAIT_V(8); PG8_WAIT_L(0); PG8_BAR; PG8_MMA(1, 0, At, B0); PG8_MMA(1, 1, At, B1); PG8_BAR; PG8_SCHED;
        }
        if constexpr (ALIGN_EPI) { if (wr == 0) PG8_BAR; }
        E(acc, cur, wr, wc, fr, fq, pre);
        if (!has_next) break;
#pragma unroll
        for (int a = 0; a < 2; ++a)
#pragma unroll
            for (int b = 0; b < 2; ++b)
#pragma unroll
                for (int m = 0; m < 4; ++m)
#pragma unroll
                    for (int n = 0; n < 2; ++n) acc[a][b][m][n] = (f32x4){0.f, 0.f, 0.f, 0.f};
        cur = nxt; cA = nA; cB = nB; ++ui;
        E.prefetch(cur, wr, fr, pre);
#pragma unroll
        for (int h = 0; h < 2; ++h)
#pragma unroll
            for (int i = 0; i < 2; ++i) { if constexpr (GATHER) va[h][i] = vn[h][i] * (unsigned)(lda * 2) + (unsigned)(CA[i] * 2); else va[h][i] = vn[h][i]; }
        if constexpr (ALIGN_EPI) { if (wr == 1) PG8_BAR; }
    }
    PG8_WAIT_V(0);
    if constexpr (!ALIGN_EPI) { if (wr == 0) PG8_BAR; }
    PG8_BAR;
#undef PG8_SA
#undef PG8_SB
#undef PG8_STAGE
#undef PG8_SETOFF
#undef PG8_LDA
#undef PG8_LDB
#undef PG8_MMA
#undef PG8_WAIT_V
#undef PG8_WAIT_L
#undef PG8_BAR
#undef PG8_SCHED
}
}
namespace pg8 {
constexpr float LOG2E = 1.4426950408889634f;
__device__ __forceinline__ float fast_sigmoid(float v) { return __builtin_amdgcn_rcpf(1.f + __builtin_amdgcn_exp2f(-v * LOG2E)); }
__device__ __forceinline__ f32x4 sig4(f32x4 v) { return (f32x4){fast_sigmoid(v[0]), fast_sigmoid(v[1]), fast_sigmoid(v[2]), fast_sigmoid(v[3])}; }
__device__ __forceinline__ u32x4 pack8(f32x4 a, f32x4 b) { u32x4 w; w.x = cvt_pk_bf16(a[0], a[1]); w.y = cvt_pk_bf16(a[2], a[3]); w.z = cvt_pk_bf16(b[0], b[1]); w.w = cvt_pk_bf16(b[2], b[3]); return w; }

struct EpiQKV {
    static constexpr bool PERM = true;
    bf16_t* Q; size_t split_stride  ; const float* qkn  ; const float* cosT; const float* sinT; float c2, eps;
    __device__ __forceinline__ void prefetch(const Unit&, int, int, Pre&) const {}
    __device__ __forceinline__ void operator()(const f32x4 (&acc)[2][2][4][2], const Unit& u, int wr, int wc, int fr, int fq, const Pre& pre) const {
        const int which = u.c0 >> 10, colt = u.c0 & 1023;
        bf16_t* base = Q + (size_t)which * split_stride;
        const int ocol = colt + 64 * wc + 8 * fq;
        if (which == 2) {
#pragma unroll
            for (int ai = 0; ai < 2; ++ai)
#pragma unroll
                for (int m = 0; m < 4; ++m) { bf16_t* rowp = base + (size_t)(u.r0 + ai * HALF + wr * 64 + m * 16 + fr) * 1024 + ocol;
#pragma unroll
                    for (int bj = 0; bj < 2; ++bj) *(u32x4*)(rowp + 32 * bj) = pack8(acc[ai][bj][m][0], acc[ai][bj][m][1]); }
        } else {
            const float* gp = qkn + 64 * which; const float sc = which == 0 ? c2 : 1.f;
            f32x4 g[2][2];
#pragma unroll
            for (int bj = 0; bj < 2; ++bj)
#pragma unroll
                for (int n = 0; n < 2; ++n) g[bj][n] = *(const f32x4*)(gp + 32 * bj + 8 * fq + 4 * n);
#pragma unroll
            for (int ai = 0; ai < 2; ++ai)
#pragma unroll
                for (int m = 0; m < 4; ++m) {
                    const int row = u.r0 + ai * HALF + wr * 64 + m * 16 + fr, pos = row & 2047;
                    f32x4 c[2], s[2];
#pragma unroll
                    for (int n = 0; n < 2; ++n) { c[n] = *(const f32x4*)(cosT + pos * 32 + 8 * fq + 4 * n); s[n] = *(const f32x4*)(sinT + pos * 32 + 8 * fq + 4 * n); }
                    float ss = 0.f;
#pragma unroll
                    for (int bj = 0; bj < 2; ++bj)
#pragma unroll
                        for (int n = 0; n < 2; ++n) { const f32x4 v = acc[ai][bj][m][n]; ss += (v[0] * v[0] + v[1] * v[1]) + (v[2] * v[2] + v[3] * v[3]); }
                    ss += __shfl_xor(ss, 16); ss += __shfl_xor(ss, 32);
                    const float rstd = __builtin_amdgcn_rsqf(ss * (1.f / 64.f) + eps);
                    f32x4 o0[2], o1[2];
#pragma unroll
                    for (int n = 0; n < 2; ++n) { const f32x4 y0 = acc[ai][0][m][n] * rstd * g[0][n], y1 = acc[ai][1][m][n] * rstd * g[1][n];
                        o0[n] = (y0 * c[n] - y1 * s[n]) * sc; o1[n] = (y1 * c[n] + y0 * s[n]) * sc; }
                    bf16_t* rowp = base + (size_t)row * 1024 + ocol;
                    *(u32x4*)(rowp) = pack8(o0[0], o0[1]); *(u32x4*)(rowp + 32) = pack8(o1[0], o1[1]);
                }
        }
    }
};
__device__ __forceinline__ float row_rstd(const float* ssqp, int row, float eps) {
    const f32x4* p = (const f32x4*)(ssqp + (size_t)row * 16); const f32x4 a = p[0], b = p[1], c = p[2], d = p[3];
    const float s = (((a[0] + a[1]) + (a[2] + a[3])) + ((b[0] + b[1]) + (b[2] + b[3]))) + (((c[0] + c[1]) + (c[2] + c[3])) + ((d[0] + d[1]) + (d[2] + d[3])));
    return __builtin_amdgcn_rsqf(s * (1.f / 1024.f) + eps);
}
__device__ __forceinline__ f32x4 bf4(u32x2 w) { return (f32x4){bf_lo(w.x), bf_hi(w.x), bf_lo(w.y), bf_hi(w.y)}; }
template <bool BASE_BF16> struct EpiResNorm {
    static constexpr bool PERM = true;
    const void* base; bf16_t* hb; float* ssqp;
    __device__ __forceinline__ void prefetch(const Unit&, int, int, Pre&) const {}
    __device__ __forceinline__ void operator()(const f32x4 (&acc)[2][2][4][2], const Unit& u, int wr, int wc, int fr, int fq, const Pre& pre) const {
        const int col0 = u.c0 + wc * 32 + 8 * fq;
#pragma unroll
        for (int ai = 0; ai < 2; ++ai)
#pragma unroll
            for (int m = 0; m < 4; ++m) { const int row = u.r0 + ai * HALF + wr * 64 + m * 16 + fr; const size_t off = (size_t)row * 1024 + col0; float ss = 0.f;
#pragma unroll
                for (int bj = 0; bj < 2; ++bj) { const size_t o2 = off + bj * HALF;
                    f32x4 b0, b1;
                    if constexpr (BASE_BF16) { const u32x4 bw = *(const u32x4*)((const bf16_t*)base + o2); b0 = bf4((u32x2){bw.x, bw.y}); b1 = bf4((u32x2){bw.z, bw.w}); }
                    else { b0 = *(const f32x4*)((const float*)base + o2); b1 = *(const f32x4*)((const float*)base + o2 + 4); }
                    const u32x4 w = pack8(b0 + acc[ai][bj][m][0], b1 + acc[ai][bj][m][1]); *(u32x4*)(hb + o2) = w;
                    const f32x4 h0 = bf4((u32x2){w.x, w.y}), h1 = bf4((u32x2){w.z, w.w});
                    ss += ((h0[0] * h0[0] + h0[1] * h0[1]) + (h0[2] * h0[2] + h0[3] * h0[3])) + ((h1[0] * h1[0] + h1[1] * h1[1]) + (h1[2] * h1[2] + h1[3] * h1[3])); }
                ss += __shfl_xor(ss, 16); ss += __shfl_xor(ss, 32);
                if (fq == 0) ssqp[(size_t)row * 16 + (u.c0 >> 8) * 4 + wc] = ss; }
    }
};
template <int RS  > struct EpiSwiGLU {
    static constexpr bool PERM = true;
    bf16_t* O; int ldo; float eps; const float* ssqp; const int* lists_base;
    __device__ __forceinline__ void prefetch(const Unit& u, int wr, int fr, Pre& pre) const {
#pragma unroll
        for (int ai = 0; ai < 2; ++ai)
#pragma unroll
            for (int m = 0; m < 4; ++m) { const int rl = ai * HALF + wr * 64 + m * 16 + fr;
                if constexpr (RS == 1) pre.rs[ai][m] = row_rstd(ssqp, u.r0 + rl, eps); else pre.rs[ai][m] = ssqp[(u.list - lists_base) + (rl < u.nvalid ? rl : u.nvalid - 1)]; }
    }
    __device__ __forceinline__ void operator()(const f32x4 (&acc)[2][2][4][2], const Unit& u, int wr, int wc, int fr, int fq, const Pre& pre) const {
        const int col0 = (u.c0 >> 1) + wc * 32 + 8 * fq;
#pragma unroll
        for (int ai = 0; ai < 2; ++ai)
#pragma unroll
            for (int m = 0; m < 4; ++m) { const int rl = ai * HALF + wr * 64 + m * 16 + fr;
                const float rs = pre.rs[ai][m];
                f32x4 o[2];
#pragma unroll
                for (int n = 0; n < 2; ++n) { const f32x4 gt = acc[ai][0][m][n] * rs, up = acc[ai][1][m][n] * rs; o[n] = gt * sig4(gt) * up; }
                if (rl < u.nvalid) *(u32x4*)(O + (size_t)(u.r0 + rl) * ldo + col0) = pack8(o[0], o[1]); }
    }
};
struct EpiProj {
    static constexpr bool PERM = true;
    bf16_t* P0; long dP;
    __device__ __forceinline__ void prefetch(const Unit&, int, int, Pre&) const {}
    __device__ __forceinline__ void operator()(const f32x4 (&acc)[2][2][4][2], const Unit& u, int wr, int wc, int fr, int fq, const Pre& pre) const {
        bf16_t* base = P0 + u.ex * dP; const int col0 = u.c0 + wc * 32 + 8 * fq;
#pragma unroll
        for (int ai = 0; ai < 2; ++ai)
#pragma unroll
            for (int m = 0; m < 4; ++m) { bf16_t* rowp = base + (size_t)(u.r0 + ai * HALF + wr * 64 + m * 16 + fr) * 1024 + col0;
#pragma unroll
                for (int bj = 0; bj < 2; ++bj) *(u32x4*)(rowp + bj * HALF) = pack8(acc[ai][bj][m][0], acc[ai][bj][m][1]); }
    }
};
template <int RS, bool OUT_F32> struct EpiPle {
    static constexpr bool PERM = true;
    const bf16_t* Hin; const bf16_t* P; void* out; const float* ssq_in; float* ssq_out; float eps; int pad;
    __device__ __forceinline__ void prefetch(const Unit& u, int wr, int fr, Pre& pre) const {
#pragma unroll
        for (int ai = 0; ai < 2; ++ai)
#pragma unroll
            for (int m = 0; m < 4; ++m) { const int row = u.r0 + ai * HALF + wr * 64 + m * 16 + fr;
                if constexpr (RS == 1) pre.rs[ai][m] = row_rstd(ssq_in, row, eps); else pre.rs[ai][m] = ssq_in[row]; }
    }
    __device__ __forceinline__ void operator()(const f32x4 (&acc)[2][2][4][2], const Unit& u, int wr, int wc, int fr, int fq, const Pre& pre) const {
        const int col0 = u.c0 + wc * 32 + 8 * fq;
#pragma unroll
        for (int ai = 0; ai < 2; ++ai)
#pragma unroll
            for (int m = 0; m < 4; ++m) { const int row = u.r0 + ai * HALF + wr * 64 + m * 16 + fr; const size_t off = (size_t)row * 1024 + col0; float ss = 0.f;
                const float rs = pre.rs[ai][m];
#pragma unroll
                for (int bj = 0; bj < 2; ++bj) { const size_t o2 = off + bj * HALF;
                    const u32x4 hw = *(const u32x4*)(Hin + o2), pw = *(const u32x4*)(P + o2);
                    const f32x4 h0 = bf4((u32x2){hw.x, hw.y}) + sig4(acc[ai][bj][m][0] * rs) * bf4((u32x2){pw.x, pw.y});
                    const f32x4 h1 = bf4((u32x2){hw.z, hw.w}) + sig4(acc[ai][bj][m][1] * rs) * bf4((u32x2){pw.z, pw.w});
                    if constexpr (OUT_F32) { *(f32x4*)((float*)out + o2) = h0; *(f32x4*)((float*)out + o2 + 4) = h1; }
                    else { const u32x4 w = pack8(h0, h1); *(u32x4*)((bf16_t*)out + o2) = w; const f32x4 r0 = bf4((u32x2){w.x, w.y}), r1 = bf4((u32x2){w.z, w.w});
                        ss += ((r0[0] * r0[0] + r0[1] * r0[1]) + (r0[2] * r0[2] + r0[3] * r0[3])) + ((r1[0] * r1[0] + r1[1] * r1[1]) + (r1[2] * r1[2] + r1[3] * r1[3])); } }
                if constexpr (!OUT_F32) { ss += __shfl_xor(ss, 16); ss += __shfl_xor(ss, 32); if (fq == 0) ssq_out[(size_t)row * 16 + (u.c0 >> 8) * 4 + wc] = ss; } }
    }
};
struct EpiPool {
    static constexpr bool PERM = true;
    bf16_t* HB; const float* bias; const float* scale;
    __device__ __forceinline__ void prefetch(const Unit&, int, int, Pre&) const {}
    __device__ __forceinline__ void operator()(const f32x4 (&acc)[2][2][4][2], const Unit& u, int wr, int wc, int fr, int fq, const Pre& pre) const {
        const int col0 = u.c0 + wc * 32 + 8 * fq;
#pragma unroll
        for (int bj = 0; bj < 2; ++bj) { const f32x4 bv0 = *(const f32x4*)(bias + col0 + bj * HALF), bv1 = *(const f32x4*)(bias + col0 + bj * HALF + 4), sv0 = *(const f32x4*)(scale + col0 + bj * HALF), sv1 = *(const f32x4*)(scale + col0 + bj * HALF + 4);
#pragma unroll
            for (int ai = 0; ai < 2; ++ai)
#pragma unroll
                for (int m = 0; m < 4; ++m) { const size_t o2 = (size_t)(u.r0 + ai * HALF + wr * 64 + m * 16 + fr) * 1024 + col0 + bj * HALF;
                    const u32x4 hw = *(const u32x4*)(HB + o2);
                    *(u32x4*)(HB + o2) = pack8(bf4((u32x2){hw.x, hw.y}) + (acc[ai][bj][m][0] + bv0) * sv0, bf4((u32x2){hw.z, hw.w}) + (acc[ai][bj][m][1] + bv1) * sv1); } }
    }
};
struct EpiMoeDown {
    static constexpr bool PERM = true;
    bf16_t* Ys;
    __device__ __forceinline__ void prefetch(const Unit& u, int wr, int fr, Pre& pre) const { const float* gw = (const float*)u.list;
#pragma unroll
        for (int ai = 0; ai < 2; ++ai)
#pragma unroll
            for (int m = 0; m < 4; ++m) { const int rl = ai * HALF + wr * 64 + m * 16 + fr; pre.rs[ai][m] = gw[rl < u.nvalid ? rl : u.nvalid - 1]; }
    }
    __device__ __forceinline__ void operator()(const f32x4 (&acc)[2][2][4][2], const Unit& u, int wr, int wc, int fr, int fq, const Pre& pre) const {
        const int col0 = u.c0 + wc * 32 + 8 * fq;
#pragma unroll
        for (int ai = 0; ai < 2; ++ai)
#pragma unroll
            for (int m = 0; m < 4; ++m) { const int rl = ai * HALF + wr * 64 + m * 16 + fr;
                if (rl < u.nvalid) { const float g = pre.rs[ai][m]; bf16_t* rowp = Ys + (size_t)(u.r0 + rl) * 1024 + col0;
#pragma unroll
                    for (int bj = 0; bj < 2; ++bj) *(u32x4*)(rowp + bj * HALF) = pack8(acc[ai][bj][m][0] * g, acc[ai][bj][m][1] * g); } }
    }
};
struct EpiPart {
    static constexpr bool PERM = false;
    float* PART;
    __device__ __forceinline__ void prefetch(const Unit&, int, int, Pre&) const {}
    __device__ __forceinline__ void operator()(const f32x4 (&acc)[2][2][4][2], const Unit& u, int wr, int wc, int fr, int fq, const Pre& pre) const {
        float* base = PART + (size_t)u.ex * 65536 + wc * 32 + 4 * fq;
#pragma unroll
        for (int ai = 0; ai < 2; ++ai)
#pragma unroll
            for (int m = 0; m < 4; ++m) { float* rowp = base + (size_t)(ai * HALF + wr * 64 + m * 16 + fr) * 256;
#pragma unroll
                for (int bj = 0; bj < 2; ++bj)
#pragma unroll
                    for (int n = 0; n < 2; ++n) *(f32x4*)(rowp + bj * HALF + n * 16) = acc[ai][bj][m][n]; }
    }
};
}
#include <hip/hip_bf16.h>
#include <cmath>
namespace attn_body {
using bf16=__hip_bfloat16;
using bf16x8=__attribute__((ext_vector_type(8)))short;
using s16x4=__attribute__((ext_vector_type(4)))short;
using f32x16=__attribute__((ext_vector_type(16)))float;
using u32x4=__attribute__((ext_vector_type(4)))unsigned;
constexpr int BATCH=8,SEQ=2048,D=64,DM=1024;
constexpr int NW=8,QBLK=32,QB=QBLK*NW,KVBLK=64,NQB=SEQ/QB;
constexpr int ATTN_PITCH=DM, ATTN_UNIT_ROWS=QB;
__device__ __forceinline__ int crow(int r,int hi){return (r&3)+8*(r>>2)+4*hi;}
#define SBAR() __builtin_amdgcn_sched_barrier(0)
__device__ __forceinline__ void cmask(f32x16&p0,f32x16&p1,int jb,int qrel,int hi){
  const float NEG=-INFINITY; int kb=64*jb+4*hi;
  #pragma unroll
  for(int r=0;r<16;++r){int kv=kb+(r&3)+8*(r>>2); if(kv>qrel)p0[r]=NEG; if(kv+32>qrel)p1[r]=NEG;}
}

constexpr int NSLOT=3, SLOTB=8192;
constexpr int LDS_K=0, LDS_V=NSLOT*SLOTB, LDS_WS=2*NSLOT*SLOTB, LDS_OST=LDS_WS+NW*64*4, LDS_BYTES=LDS_OST+NW*4096;
constexpr float C2=0.125f*1.4426950408889634f;
__device__ __forceinline__ void glds16(const void*gsrc,unsigned lds_dst){unsigned keep;
  asm volatile("s_mov_b32 %0, m0\n\ts_mov_b32 m0, %2\n\ts_nop 0\n\tglobal_load_lds_dwordx4 %1, off\n\ts_mov_b32 m0, %0":"=&s"(keep):"v"(gsrc),"s"(lds_dst):"memory");}
__device__ __forceinline__ float max3f(float a,float b,float c){float r;asm("v_max3_f32 %0, %1, %2, %3":"=v"(r):"v"(a),"v"(b),"v"(c));return r;}
__device__ __forceinline__ float max2f(float a,float b){float r;asm("v_max_f32_e32 %0, %1, %2":"=v"(r):"v"(a),"v"(b));return r;}
__device__ __forceinline__ float fadd_s(float a,float b){float r;asm("v_add_f32_e32 %0, %1, %2":"=v"(r):"v"(a),"v"(b));return r;}
__device__ __forceinline__ float fsub_s(float a,float b){float r;asm("v_sub_f32_e32 %0, %1, %2":"=v"(r):"v"(a),"v"(b));return r;}
typedef float f32x2_t __attribute__((ext_vector_type(2))); typedef __bf16 bf16x2_t __attribute__((ext_vector_type(2)));
__device__ __forceinline__ unsigned cvtpk_s(float lo,float hi){f32x2_t v={lo,hi};bf16x2_t b=__builtin_convertvector(v,bf16x2_t);return __builtin_bit_cast(unsigned,b);}
#define WAIT_BAR(N) asm volatile("s_waitcnt vmcnt(" #N ") lgkmcnt(0)\n\ts_barrier":::"memory")

__device__ __forceinline__ void qkt(f32x16&p0,f32x16&p1,const char*Kslot,const bf16x8*qr,const f32x16&negm,int r32,int hi){
  const char*kb=Kslot+hi*1024+r32*16;
  #pragma unroll
  for(int d0=0;d0<4;++d0){
    const bf16x8 b0=*reinterpret_cast<const bf16x8*>(kb+d0*2048);
    const bf16x8 b1=*reinterpret_cast<const bf16x8*>(kb+d0*2048+512);
    if(d0==0){p0=__builtin_amdgcn_mfma_f32_32x32x16_bf16(b0,qr[0],negm,0,0,0);p1=__builtin_amdgcn_mfma_f32_32x32x16_bf16(b1,qr[0],negm,0,0,0);}
    else{p0=__builtin_amdgcn_mfma_f32_32x32x16_bf16(b0,qr[d0],p0,0,0,0);p1=__builtin_amdgcn_mfma_f32_32x32x16_bf16(b1,qr[d0],p1,0,0,0);}}
}
typedef __attribute__((address_space(3))) const char* lds_cptr;
typedef short v4i16_t __attribute__((ext_vector_type(4)));
__device__ __forceinline__ void kload8(bf16x8*kf,lds_cptr kp){
  kf[0]=*(const __attribute__((address_space(3))) bf16x8*)(kp);      kf[1]=*(const __attribute__((address_space(3))) bf16x8*)(kp+512);
  kf[2]=*(const __attribute__((address_space(3))) bf16x8*)(kp+2048); kf[3]=*(const __attribute__((address_space(3))) bf16x8*)(kp+2560);
  kf[4]=*(const __attribute__((address_space(3))) bf16x8*)(kp+4096); kf[5]=*(const __attribute__((address_space(3))) bf16x8*)(kp+4608);
  kf[6]=*(const __attribute__((address_space(3))) bf16x8*)(kp+6144); kf[7]=*(const __attribute__((address_space(3))) bf16x8*)(kp+6656);
}
__device__ __forceinline__ void kload2(bf16x8*kf,lds_cptr kp,int j){ kf[2*j]=*(const __attribute__((address_space(3))) bf16x8*)(kp+j*2048); kf[2*j+1]=*(const __attribute__((address_space(3))) bf16x8*)(kp+j*2048+512); }
__device__ __forceinline__ s16x4 vtr(lds_cptr p){ return __builtin_bit_cast(s16x4,__builtin_amdgcn_ds_read_tr16_b64_v4i16((__attribute__((address_space(3))) v4i16_t*)p)); }
__device__ __forceinline__ float rowmax(const f32x16&p0,const f32x16&p1){
  float a=max3f(p0[0],p0[1],p1[0]),b=max3f(p0[2],p0[3],p1[1]);a=max3f(a,p1[2],p1[3]);
  #pragma unroll
  for(int r=4;r<16;r+=4){a=max3f(a,p0[r],p0[r+1]);b=max3f(b,p0[r+2],p0[r+3]);a=max3f(a,p1[r],p1[r+1]);b=max3f(b,p1[r+2],p1[r+3]);}
  const float m=max2f(a,b);
  auto rr=__builtin_amdgcn_permlane32_swap(__float_as_uint(m),__float_as_uint(m),false,false);
  return max2f(__uint_as_float(rr[0]),__uint_as_float(rr[1]));
}
__device__ __forceinline__ void pv(f32x16*o,int vb,bf16x8 pa0,bf16x8 pa1,bf16x8 pa2,bf16x8 pa3){
  #pragma unroll
  for(int d0=0;d0<2;++d0){s16x4 lo[4],hi[4];
    #pragma unroll
    for(int ks=0;ks<4;++ks){
      asm volatile("ds_read_b64_tr_b16 %0,%1 offset:%c2":"=&v"(lo[ks]):"v"(vb),"i"(d0*4096+ks*1024):"memory");
      asm volatile("ds_read_b64_tr_b16 %0,%1 offset:%c2":"=&v"(hi[ks]):"v"(vb),"i"(d0*4096+ks*1024+512):"memory");}
    asm volatile("s_waitcnt lgkmcnt(0)":::"memory");SBAR();
    #define PK(k) (bf16x8){lo[k][0],lo[k][1],lo[k][2],lo[k][3],hi[k][0],hi[k][1],hi[k][2],hi[k][3]}
    o[d0]=__builtin_amdgcn_mfma_f32_32x32x16_bf16(pa0,PK(0),o[d0],0,0,0);
    o[d0]=__builtin_amdgcn_mfma_f32_32x32x16_bf16(pa1,PK(1),o[d0],0,0,0);
    o[d0]=__builtin_amdgcn_mfma_f32_32x32x16_bf16(pa2,PK(2),o[d0],0,0,0);
    o[d0]=__builtin_amdgcn_mfma_f32_32x32x16_bf16(pa3,PK(3),o[d0],0,0,0);
    #undef PK
  }
}

#ifndef ATTN_STORE16
#define ATTN_STORE16(p,v) (*(u32x4*)(p)=(v))
#endif
template<int THRL> __device__ __forceinline__ void attn_unit(int b,int qb,const bf16*Q,const bf16*__restrict__ K,const bf16*__restrict__ V,bf16*O,char*shm){
  int tid_=threadIdx.x; asm volatile("":"+v"(tid_));
  const int tid=tid_,lane=tid&63,r32=lane&31,hi=lane>>5; const int wid=__builtin_amdgcn_readfirstlane(tid>>6);
  const long rowbase=(long)b*SEQ; const int q0=qb*QB;
  const bf16*Qw=Q+(rowbase+q0+wid*QBLK)*DM;
  const bf16*Kh=K+rowbase*DM,*Vh=V+rowbase*DM;
  const unsigned lds0=(unsigned)(uintptr_t)shm;
  float*wsf=(float*)(shm+LDS_WS)+wid*64;
  const bf16*ksrc=Kh+(long)lane*DM+wid*8;
  const bf16*vsrc=Vh+(long)(16*(wid&3)+(lane>>2))*DM+(wid>>2)*32+(lane&3)*8;
  const unsigned kdst=lds0+LDS_K+wid*1024, vdst=lds0+LDS_V+wid*1024;
  #define DMA_K(t,slot) glds16(ksrc+(long)(t)*KVBLK*DM,(unsigned)__builtin_amdgcn_readfirstlane(kdst+(slot)))
  #define DMA_V(t,slot) glds16(vsrc+(long)(t)*KVBLK*DM,(unsigned)__builtin_amdgcn_readfirstlane(vdst+(slot)))
  const int vb0=(int)(lds0+LDS_V)+((lane>>4)&1)*32+(lane&3)*8+(4*hi+((lane&15)>>2))*64;
  const char*Kbase=shm+LDS_K; bf16x8 kf[8];
  const lds_cptr shm3=(lds_cptr)shm; const lds_cptr kp0=shm3+LDS_K+hi*1024+r32*16; const lds_cptr vp0=shm3+LDS_V+((lane>>4)&1)*32+(lane&3)*8+(4*hi+((lane&15)>>2))*64;
  const int NT=(q0+QB)/KVBLK;
  DMA_K(0,0);DMA_V(0,0);DMA_K(1,SLOTB);
  bf16x8 qr[4];
  #pragma unroll
  for(int d0=0;d0<4;++d0)qr[d0]=*reinterpret_cast<const bf16x8*>(&Qw[(long)r32*DM+d0*16+hi*8]);
  float zz_=0.f; asm volatile("":"+v"(zz_)); const f32x16 zv_={zz_,zz_,zz_,zz_,zz_,zz_,zz_,zz_,zz_,zz_,zz_,zz_,zz_,zz_,zz_,zz_};
  float mhat=zz_,l_reg=zz_;f32x16 o[2];o[0]=zv_;o[1]=zv_;f32x16 negm=zv_;asm volatile("":"+v"(negm));
  const int qrel=wid*QBLK+r32;
  #define CMASK(P0,P1,t) do{int jb_=(t)-(NT-4); if(jb_>=0)cmask(P0,P1,jb_,qrel,hi);}while(0)
  bool resc=false;
  #define START(P0,P1) do{ const float rm=rowmax(P0,P1); resc=false; \
    { const float dl=rm; mhat=fadd_s(mhat,dl); \
      _Pragma("unroll") for(int r=0;r<16;++r){P0[r]=fsub_s(P0[r],dl);P1[r]=fsub_s(P1[r],dl);} \
      _Pragma("unroll") for(int r=0;r<16;++r)negm[r]=-mhat; asm volatile("":"+v"(negm)); } \
    _Pragma("unroll") for(int r=0;r<16;++r)P0[r]=__builtin_amdgcn_exp2f(P0[r]); }while(0)
  #define RESC() do{ if(resc){ asm volatile("s_waitcnt lgkmcnt(0)":::"memory"); \
      _Pragma("unroll") for(int d_=0;d_<2;++d_) _Pragma("unroll") for(int r=0;r<16;++r)o[d_][r]*=wsf[crow(r,hi)]; } }while(0)
  f32x16 pA0,pA1,pB0,pB1;
  int sl_prev=0,sl_cur=0,sl_next=SLOTB;
  #define ROT() do{sl_prev=sl_cur;sl_cur=sl_next;sl_next=(sl_next==(NSLOT-1)*SLOTB)?0:sl_next+SLOTB;}while(0)
  DMA_K(2,2*SLOTB);
  WAIT_BAR(3);
  qkt(pA0,pA1,Kbase,qr,negm,r32,hi);asm volatile("s_nop 15\n\ts_nop 7":"+v"(pA0),"+v"(pA1));CMASK(pA0,pA1,0);
  START(pA0,pA1);
  _Pragma("unroll") for(int r=0;r<16;++r)pA1[r]=__builtin_amdgcn_exp2f(pA1[r]);
  WAIT_BAR(0);
  DMA_K(3,0);DMA_V(1,SLOTB);
  ROT();
  kload8(kf,kp0+sl_cur);
  WAIT_BAR(2);
  s16x4 vlo[8],vhi[8]; u32x4 pw0,pw1,pw2,pw3;
  #define PKW(P,B) cvtpk_s(P[B],P[B+1])
  #define PAF(k) __builtin_bit_cast(bf16x8,pw##k)
  #define VFR(i) (bf16x8){vlo[i][0],vlo[i][1],vlo[i][2],vlo[i][3],vhi[i][0],vhi[i][1],vhi[i][2],vhi[i][3]}
  #define PIN(x) asm volatile("":"+v"(x))
  #define MX3(a,b,c) __builtin_fmaxf(__builtin_fmaxf((a),(b)),(c))
  #define GAPA(MF,A0,A1,A2,A3,W0,W1,PW) do{ MF; sacc+=A0; sacc+=A1; sacc+=A2; sacc+=A3; PIN(sacc); W0; W1; PIN(PW); SBAR(); }while(0)
  #define EX(v) __builtin_amdgcn_exp2f(v)
  #define GAPB(MF,X,B) do{ MF; X[B]=EX(X[B]); X[B+1]=EX(X[B+1]); X[B+2]=EX(X[B+2]); X[B+3]=EX(X[B+3]); PIN(X); SBAR(); }while(0)
  #define VRD(i) do{ vlo[i]=vtr(vp_+(((i)>>2)*4096+((i)&3)*1024)); vhi[i]=vtr(vp_+(((i)>>2)*4096+((i)&3)*1024+512)); }while(0)
  #define KRD(G,j) do{ if(G){ kload2(kf,kp0+sl_next,j); SBAR(); } }while(0)
  #define STEP(C0,C1,P0,P1,t,GK,GV,GL) do{ SBAR(); \
    const lds_cptr vp_=vp0+sl_prev; \
    VRD(0); SBAR(); float sacc=(P0[0]+P0[1]); \
    GAPA(C0=__builtin_amdgcn_mfma_f32_32x32x16_bf16(kf[0],qr[0],negm,0,0,0), P0[2],P0[3],P0[4],P0[5],     pw0[0]=PKW(P0,0), pw0[1]=PKW(P0,2), pw0); \
    VRD(4); SBAR(); GAPA(C1=__builtin_amdgcn_mfma_f32_32x32x16_bf16(kf[1],qr[0],negm,0,0,0), P0[6],P0[7],P0[8],P0[9],     pw0[2]=PKW(P0,4), pw0[3]=PKW(P0,6), pw0); \
    VRD(1); SBAR(); GAPA(C0=__builtin_amdgcn_mfma_f32_32x32x16_bf16(kf[2],qr[1],C0,0,0,0),   P0[10],P0[11],P0[12],P0[13], pw1[0]=PKW(P0,8), pw1[1]=PKW(P0,10), pw1); \
    VRD(5); SBAR(); GAPA(C1=__builtin_amdgcn_mfma_f32_32x32x16_bf16(kf[3],qr[1],C1,0,0,0),   P0[14],P0[15],P1[0],P1[1],   pw1[2]=PKW(P0,12),pw1[3]=PKW(P0,14), pw1); \
    VRD(2); SBAR(); GAPA(C0=__builtin_amdgcn_mfma_f32_32x32x16_bf16(kf[4],qr[2],C0,0,0,0),   P1[2],P1[3],P1[4],P1[5],     pw2[0]=PKW(P1,0), pw2[1]=PKW(P1,2), pw2); \
    VRD(6); SBAR(); GAPA(C1=__builtin_amdgcn_mfma_f32_32x32x16_bf16(kf[5],qr[2],C1,0,0,0),   P1[6],P1[7],P1[8],P1[9],     pw2[2]=PKW(P1,4), pw2[3]=PKW(P1,6), pw2); \
    VRD(3); SBAR(); GAPA(C0=__builtin_amdgcn_mfma_f32_32x32x16_bf16(kf[6],qr[3],C0,0,0,0),   P1[10],P1[11],P1[12],P1[13], pw3[0]=PKW(P1,8), pw3[1]=PKW(P1,10), pw3); \
    VRD(7); SBAR(); GAPA(C1=__builtin_amdgcn_mfma_f32_32x32x16_bf16(kf[7],qr[3],C1,0,0,0),   P1[14],P1[15],0.f,0.f,       pw3[2]=PKW(P1,12),pw3[3]=PKW(P1,14), pw3); \
    l_reg+=sacc; \
    if(GK){DMA_K((t)+3,sl_cur);} if(GV){DMA_V((t)+1,sl_next);} \
    CMASK(C0,C1,t); \
    { float a=MX3(C0[0],C0[1],C1[0]),b=MX3(C0[2],C0[3],C1[1]); a=MX3(a,C1[2],C1[3]); \
      _Pragma("unroll") for(int r=4;r<16;r+=4){a=MX3(a,C0[r],C0[r+1]);b=MX3(b,C0[r+2],C0[r+3]);a=MX3(a,C1[r],C1[r+1]);b=MX3(b,C1[r+2],C1[r+3]);} \
      float rm=__builtin_fmaxf(a,b); { auto rr=__builtin_amdgcn_permlane32_swap(__float_as_uint(rm),__float_as_uint(rm),false,false); rm=__builtin_fmaxf(__uint_as_float(rr[0]),__uint_as_float(rr[1])); } \
      resc=false; \
      if(__builtin_expect(__any(rm>(float)THRL),0)){ const float dl=__builtin_fmaxf(rm,0.f); mhat+=dl; \
        _Pragma("unroll") for(int r=0;r<16;++r){C0[r]-=dl;C1[r]-=dl;} \
        _Pragma("unroll") for(int r=0;r<16;++r)negm[r]=-mhat; asm volatile("":"+v"(negm)); \
        const float f=__builtin_amdgcn_exp2f(-dl); l_reg*=f; if(hi==0)wsf[r32]=f; resc=true; } } \
    SBAR(); \
    GAPB(o[0]=__builtin_amdgcn_mfma_f32_32x32x16_bf16(PAF(0),VFR(0),o[0],0,0,0), C0,0); \
    GAPB(o[1]=__builtin_amdgcn_mfma_f32_32x32x16_bf16(PAF(0),VFR(4),o[1],0,0,0), C0,4); \
    KRD(GL,0); GAPB(o[0]=__builtin_amdgcn_mfma_f32_32x32x16_bf16(PAF(1),VFR(1),o[0],0,0,0), C0,8); \
    KRD(GL,1); GAPB(o[1]=__builtin_amdgcn_mfma_f32_32x32x16_bf16(PAF(1),VFR(5),o[1],0,0,0), C0,12); \
    KRD(GL,2); GAPB(o[0]=__builtin_amdgcn_mfma_f32_32x32x16_bf16(PAF(2),VFR(2),o[0],0,0,0), C1,0); \
    KRD(GL,3); GAPB(o[1]=__builtin_amdgcn_mfma_f32_32x32x16_bf16(PAF(2),VFR(6),o[1],0,0,0), C1,4); \
    GAPB(o[0]=__builtin_amdgcn_mfma_f32_32x32x16_bf16(PAF(3),VFR(3),o[0],0,0,0), C1,8); \
    GAPB(o[1]=__builtin_amdgcn_mfma_f32_32x32x16_bf16(PAF(3),VFR(7),o[1],0,0,0), C1,12); \
    }while(0)
  int t=1;
  #undef CMASK
  #define CMASK(P0,P1,t) do{}while(0)
  for(;t+5<NT;t+=2){
    STEP(pB0,pB1,pA0,pA1,t,true,true,true);     WAIT_BAR(2); RESC(); ROT();
    STEP(pA0,pA1,pB0,pB1,t+1,true,true,true);   WAIT_BAR(2); RESC(); ROT();
  }
  #undef CMASK
  #define CMASK(P0,P1,t) do{int jb_=(t)-(NT-4); if(jb_>=0)cmask(P0,P1,jb_,qrel,hi);}while(0)
  #define ENDW(tt) do{ if((tt)+3<NT){WAIT_BAR(2);} else if((tt)+2<NT){WAIT_BAR(1);} else {WAIT_BAR(0);} }while(0)
  for(;t+1<NT;t+=2){
    STEP(pB0,pB1,pA0,pA1,t,(t+3<NT),(t+1<NT),(t+1<NT));       ENDW(t);   RESC(); ROT();
    STEP(pA0,pA1,pB0,pB1,t+1,(t+4<NT),(t+2<NT),(t+2<NT));     ENDW(t+1); RESC(); ROT();
  }
  STEP(pB0,pB1,pA0,pA1,NT-1,false,false,false); RESC();
  { float sacc=pB0[0]+pB0[1]; _Pragma("unroll") for(int r=2;r<16;++r)sacc+=pB0[r]; _Pragma("unroll") for(int r=0;r<16;++r)sacc+=pB1[r]; l_reg+=sacc;
    pw0=(u32x4){PKW(pB0,0),PKW(pB0,2),PKW(pB0,4),PKW(pB0,6)};pw1=(u32x4){PKW(pB0,8),PKW(pB0,10),PKW(pB0,12),PKW(pB0,14)};pw2=(u32x4){PKW(pB1,0),PKW(pB1,2),PKW(pB1,4),PKW(pB1,6)};pw3=(u32x4){PKW(pB1,8),PKW(pB1,10),PKW(pB1,12),PKW(pB1,14)};
    SBAR(); pv(o,vb0+sl_cur,PAF(0),PAF(1),PAF(2),PAF(3)); }
  #undef PKW
  #undef PAF
  #undef VFR
  #undef PIN
  #undef MX3
  #undef GAPA
  #undef GAPB
  #undef EX
  #undef VRD
  #undef KRD
  #undef STEP
  #undef ENDW
  {auto rr=__builtin_amdgcn_permlane32_swap(__float_as_uint(l_reg),__float_as_uint(l_reg),false,false);l_reg=__uint_as_float(rr[0])+__uint_as_float(rr[1]);}
  if(hi==0)wsf[32+r32]=l_reg;asm volatile("s_waitcnt lgkmcnt(0)":::"memory");
  float rli[16];
  #pragma unroll
  for(int r=0;r<16;++r)rli[r]=__builtin_amdgcn_rcpf(wsf[32+crow(r,hi)]);
  bf16*Ow=O+(rowbase+q0+wid*QBLK)*DM;
  { bf16*stg=(bf16*)(shm+LDS_OST)+wid*2048;
    #pragma unroll
    for(int r=0;r<16;++r){const int orow=crow(r,hi);
      #pragma unroll
      for(int d0=0;d0<2;++d0)stg[orow*64+d0*32+r32]=__float2bfloat16(o[d0][r]*rli[r]);}
    asm volatile("s_waitcnt lgkmcnt(0)":::"memory");
    #pragma unroll
    for(int i=0;i<4;++i){const int row=i*8+(lane>>3),ch=lane&7; const u32x4 v=*(const u32x4*)(stg+row*64+ch*8); ATTN_STORE16(Ow+(long)row*DM+ch*8,v);} }
  asm volatile("s_waitcnt lgkmcnt(0)\n\ts_barrier":::"memory");
  #undef DMA_K
  #undef DMA_V
  #undef CMASK
  #undef START
  #undef RESC
  #undef ROT
}
__device__ __forceinline__ void pv4(f32x16*o,int vb,bf16x8 pa0,bf16x8 pa1,bf16x8 pa2,bf16x8 pa3){
  #pragma unroll
  for(int d0=0;d0<4;++d0){s16x4 lo[4],hi[4];
    #pragma unroll
    for(int ks=0;ks<4;++ks){
      asm volatile("ds_read_b64_tr_b16 %0,%1 offset:%c2":"=&v"(lo[ks]):"v"(vb),"i"(d0*4096+ks*1024):"memory");
      asm volatile("ds_read_b64_tr_b16 %0,%1 offset:%c2":"=&v"(hi[ks]):"v"(vb),"i"(d0*4096+ks*1024+512):"memory");}
    asm volatile("s_waitcnt lgkmcnt(0)":::"memory");SBAR();
    #define PK(k) (bf16x8){lo[k][0],lo[k][1],lo[k][2],lo[k][3],hi[k][0],hi[k][1],hi[k][2],hi[k][3]}
    o[d0]=__builtin_amdgcn_mfma_f32_32x32x16_bf16(pa0,PK(0),o[d0],0,0,0);
    o[d0]=__builtin_amdgcn_mfma_f32_32x32x16_bf16(pa1,PK(1),o[d0],0,0,0);
    o[d0]=__builtin_amdgcn_mfma_f32_32x32x16_bf16(pa2,PK(2),o[d0],0,0,0);
    o[d0]=__builtin_amdgcn_mfma_f32_32x32x16_bf16(pa3,PK(3),o[d0],0,0,0);
    #undef PK
  }
}

template<int THRL,bool FUSE> __device__ __forceinline__ void attn_unit128(int b,int qb,const bf16*Q,const bf16*__restrict__ K,const bf16*__restrict__ V,bf16*O,char*shm,bf16*ON=nullptr,const float*subg=nullptr,float lam=0.f,float oscale=1.f,float eps=0.f){
  int tid_=threadIdx.x; asm volatile("":"+v"(tid_));
  const int tid=tid_,lane=tid&63,r32=lane&31,hi=lane>>5; const int wid=__builtin_amdgcn_readfirstlane(tid>>6);
  const long rowbase=(long)b*SEQ; const int q0=qb*QB;
  const bf16*Qw=Q+(rowbase+q0+wid*QBLK)*DM;
  const bf16*Kh=K+rowbase*DM,*Vh=V+rowbase*DM;
  const unsigned lds0=(unsigned)(uintptr_t)shm;
  constexpr int LDS_V2=NSLOT*SLOTB, VSLOT=2*SLOTB, LDS_WS2=LDS_V2+NSLOT*VSLOT, LDS_OST2=LDS_WS2+NW*64*4;
  float*wsf=(float*)(shm+LDS_WS2)+wid*64;
  const bf16*ksrc=Kh+(long)lane*DM+wid*8;
  const bf16*vsrc=Vh+(long)(16*(wid&3)+(lane>>2))*DM+(wid>>2)*32+(lane&3)*8;
  const unsigned kdst=lds0+LDS_K+wid*1024, vdst=lds0+LDS_V2+wid*1024;
  #define DMA_K(t,slot) glds16(ksrc+(long)(t)*KVBLK*DM,(unsigned)__builtin_amdgcn_readfirstlane(kdst+(slot)))
  #define DMA_V(t,slot) do{ glds16(vsrc+(long)(t)*KVBLK*DM,(unsigned)__builtin_amdgcn_readfirstlane(vdst+2*(slot))); glds16(vsrc+(long)(t)*KVBLK*DM+64,(unsigned)__builtin_amdgcn_readfirstlane(vdst+2*(slot)+8192)); }while(0)
  const int vb0=(int)(lds0+LDS_V2)+((lane>>4)&1)*32+(lane&3)*8+(4*hi+((lane&15)>>2))*64;
  const char*Kbase=shm+LDS_K; bf16x8 kf[8];
  const lds_cptr shm3=(lds_cptr)shm; const lds_cptr kp0=shm3+LDS_K+hi*1024+r32*16; const lds_cptr vp0=shm3+LDS_V2+((lane>>4)&1)*32+(lane&3)*8+(4*hi+((lane&15)>>2))*64;
  const int NT=(q0+QB)/KVBLK;
  DMA_K(0,0);DMA_V(0,0);DMA_K(1,SLOTB);
  bf16x8 qr[4];
  #pragma unroll
  for(int d0=0;d0<4;++d0)qr[d0]=*reinterpret_cast<const bf16x8*>(&Qw[(long)r32*DM+d0*16+hi*8]);
  float zz_=0.f; asm volatile("":"+v"(zz_)); const f32x16 zv_={zz_,zz_,zz_,zz_,zz_,zz_,zz_,zz_,zz_,zz_,zz_,zz_,zz_,zz_,zz_,zz_};
  float mhat=zz_,l_reg=zz_;f32x16 o[4];o[0]=zv_;o[1]=zv_;o[2]=zv_;o[3]=zv_;f32x16 negm=zv_;asm volatile("":"+v"(negm));
  const int qrel=wid*QBLK+r32;
  #define CMASK(P0,P1,t) do{int jb_=(t)-(NT-4); if(jb_>=0)cmask(P0,P1,jb_,qrel,hi);}while(0)
  bool resc=false;
  #define START(P0,P1) do{ const float rm=rowmax(P0,P1); resc=false; \
    { const float dl=rm; mhat=fadd_s(mhat,dl); \
      _Pragma("unroll") for(int r=0;r<16;++r){P0[r]=fsub_s(P0[r],dl);P1[r]=fsub_s(P1[r],dl);} \
      _Pragma("unroll") for(int r=0;r<16;++r)negm[r]=-mhat; asm volatile("":"+v"(negm)); } \
    _Pragma("unroll") for(int r=0;r<16;++r)P0[r]=__builtin_amdgcn_exp2f(P0[r]); }while(0)
  #define RESC() do{ if(resc){ asm volatile("s_waitcnt lgkmcnt(0)":::"memory"); \
      _Pragma("unroll") for(int d_=0;d_<4;++d_) _Pragma("unroll") for(int r=0;r<16;++r)o[d_][r]*=wsf[crow(r,hi)]; } }while(0)
  f32x16 pA0,pA1,pB0,pB1;
  int sl_prev=0,sl_cur=0,sl_next=SLOTB;
  #define ROT() do{sl_prev=sl_cur;sl_cur=sl_next;sl_next=(sl_next==(NSLOT-1)*SLOTB)?0:sl_next+SLOTB;}while(0)
  DMA_K(2,2*SLOTB);
  WAIT_BAR(4);
  qkt(pA0,pA1,Kbase,qr,negm,r32,hi);asm volatile("s_nop 15\n\ts_nop 7":"+v"(pA0),"+v"(pA1));CMASK(pA0,pA1,0);
  START(pA0,pA1);
  _Pragma("unroll") for(int r=0;r<16;++r)pA1[r]=__builtin_amdgcn_exp2f(pA1[r]);
  WAIT_BAR(0);
  DMA_K(3,0);DMA_V(1,SLOTB);
  ROT();
  kload8(kf,kp0+sl_cur);
  WAIT_BAR(3);
  s16x4 vlo[8],vhi[8]; u32x4 pw0,pw1,pw2,pw3;
  #define PKW(P,B) cvtpk_s(P[B],P[B+1])
  #define PAF(k) __builtin_bit_cast(bf16x8,pw##k)
  #define VFR(s) (bf16x8){vlo[s][0],vlo[s][1],vlo[s][2],vlo[s][3],vhi[s][0],vhi[s][1],vhi[s][2],vhi[s][3]}
  #define PIN(x) asm volatile("":"+v"(x))
  #define MX3(a,b,c) __builtin_fmaxf(__builtin_fmaxf((a),(b)),(c))
  #define GAPA(MF,A0,A1,A2,A3,W0,W1,PW) do{ MF; sacc+=A0; sacc+=A1; sacc+=A2; sacc+=A3; PIN(sacc); W0; W1; PIN(PW); SBAR(); }while(0)
  #define EX(v) __builtin_amdgcn_exp2f(v)
  #define GAPB(MF,X,B) do{ MF; X[B]=EX(X[B]); X[B+1]=EX(X[B+1]); PIN(X); SBAR(); }while(0)
  #define VRD(s,f) do{ vlo[s]=vtr(vp_+(((f)>>2)*4096+((f)&3)*1024)); vhi[s]=vtr(vp_+(((f)>>2)*4096+((f)&3)*1024+512)); }while(0)
  #define KRD(G,j) do{ if(G){ kload2(kf,kp0+sl_next,j); SBAR(); } }while(0)
  #define STEP(C0,C1,P0,P1,t,GK,GV,GL) do{ SBAR(); \
    const lds_cptr vp_=vp0+2*sl_prev; \
    VRD(0,0); SBAR(); float sacc=(P0[0]+P0[1]); \
    GAPA(C0=__builtin_amdgcn_mfma_f32_32x32x16_bf16(kf[0],qr[0],negm,0,0,0), P0[2],P0[3],P0[4],P0[5],     pw0[0]=PKW(P0,0), pw0[1]=PKW(P0,2), pw0); \
    VRD(1,4); SBAR(); GAPA(C1=__builtin_amdgcn_mfma_f32_32x32x16_bf16(kf[1],qr[0],negm,0,0,0), P0[6],P0[7],P0[8],P0[9],     pw0[2]=PKW(P0,4), pw0[3]=PKW(P0,6), pw0); \
    VRD(2,8); SBAR(); GAPA(C0=__builtin_amdgcn_mfma_f32_32x32x16_bf16(kf[2],qr[1],C0,0,0,0),   P0[10],P0[11],P0[12],P0[13], pw1[0]=PKW(P0,8), pw1[1]=PKW(P0,10), pw1); \
    VRD(3,12); SBAR(); GAPA(C1=__builtin_amdgcn_mfma_f32_32x32x16_bf16(kf[3],qr[1],C1,0,0,0),   P0[14],P0[15],P1[0],P1[1],   pw1[2]=PKW(P0,12),pw1[3]=PKW(P0,14), pw1); \
    VRD(4,1); SBAR(); GAPA(C0=__builtin_amdgcn_mfma_f32_32x32x16_bf16(kf[4],qr[2],C0,0,0,0),   P1[2],P1[3],P1[4],P1[5],     pw2[0]=PKW(P1,0), pw2[1]=PKW(P1,2), pw2); \
    VRD(5,5); SBAR(); GAPA(C1=__builtin_amdgcn_mfma_f32_32x32x16_bf16(kf[5],qr[2],C1,0,0,0),   P1[6],P1[7],P1[8],P1[9],     pw2[2]=PKW(P1,4), pw2[3]=PKW(P1,6), pw2); \
    VRD(6,9); SBAR(); GAPA(C0=__builtin_amdgcn_mfma_f32_32x32x16_bf16(kf[6],qr[3],C0,0,0,0),   P1[10],P1[11],P1[12],P1[13], pw3[0]=PKW(P1,8), pw3[1]=PKW(P1,10), pw3); \
    VRD(7,13); SBAR(); GAPA(C1=__builtin_amdgcn_mfma_f32_32x32x16_bf16(kf[7],qr[3],C1,0,0,0),   P1[14],P1[15],0.f,0.f,       pw3[2]=PKW(P1,12),pw3[3]=PKW(P1,14), pw3); \
    l_reg+=sacc; \
    if(GK){DMA_K((t)+3,sl_cur);} if(GV){DMA_V((t)+1,sl_next);} \
    CMASK(C0,C1,t); \
    { float a=MX3(C0[0],C0[1],C1[0]),b=MX3(C0[2],C0[3],C1[1]); a=MX3(a,C1[2],C1[3]); \
      _Pragma("unroll") for(int r=4;r<16;r+=4){a=MX3(a,C0[r],C0[r+1]);b=MX3(b,C0[r+2],C0[r+3]);a=MX3(a,C1[r],C1[r+1]);b=MX3(b,C1[r+2],C1[r+3]);} \
      float rm=__builtin_fmaxf(a,b); { auto rr=__builtin_amdgcn_permlane32_swap(__float_as_uint(rm),__float_as_uint(rm),false,false); rm=__builtin_fmaxf(__uint_as_float(rr[0]),__uint_as_float(rr[1])); } \
      resc=false; \
      if(__builtin_expect(__any(rm>(float)THRL),0)){ const float dl=__builtin_fmaxf(rm,0.f); mhat+=dl; \
        _Pragma("unroll") for(int r=0;r<16;++r){C0[r]-=dl;C1[r]-=dl;} \
        _Pragma("unroll") for(int r=0;r<16;++r)negm[r]=-mhat; asm volatile("":"+v"(negm)); \
        const float f=__builtin_amdgcn_exp2f(-dl); l_reg*=f; if(hi==0)wsf[r32]=f; resc=true; } } \
    SBAR(); \
    GAPB(o[0]=__builtin_amdgcn_mfma_f32_32x32x16_bf16(PAF(0),VFR(0),o[0],0,0,0), C0,0); VRD(0,2); SBAR(); \
    GAPB(o[1]=__builtin_amdgcn_mfma_f32_32x32x16_bf16(PAF(0),VFR(1),o[1],0,0,0), C0,2); VRD(1,6); SBAR(); \
    GAPB(o[2]=__builtin_amdgcn_mfma_f32_32x32x16_bf16(PAF(0),VFR(2),o[2],0,0,0), C0,4); VRD(2,10); SBAR(); \
    GAPB(o[3]=__builtin_amdgcn_mfma_f32_32x32x16_bf16(PAF(0),VFR(3),o[3],0,0,0), C0,6); VRD(3,14); SBAR(); \
    GAPB(o[0]=__builtin_amdgcn_mfma_f32_32x32x16_bf16(PAF(1),VFR(4),o[0],0,0,0), C0,8); VRD(4,3); SBAR(); \
    GAPB(o[1]=__builtin_amdgcn_mfma_f32_32x32x16_bf16(PAF(1),VFR(5),o[1],0,0,0), C0,10); VRD(5,7); SBAR(); \
    GAPB(o[2]=__builtin_amdgcn_mfma_f32_32x32x16_bf16(PAF(1),VFR(6),o[2],0,0,0), C0,12); VRD(6,11); SBAR(); \
    GAPB(o[3]=__builtin_amdgcn_mfma_f32_32x32x16_bf16(PAF(1),VFR(7),o[3],0,0,0), C0,14); VRD(7,15); SBAR(); \
    KRD(GL,0); GAPB(o[0]=__builtin_amdgcn_mfma_f32_32x32x16_bf16(PAF(2),VFR(0),o[0],0,0,0), C1,0); \
    KRD(GL,1); GAPB(o[1]=__builtin_amdgcn_mfma_f32_32x32x16_bf16(PAF(2),VFR(1),o[1],0,0,0), C1,2); \
    KRD(GL,2); GAPB(o[2]=__builtin_amdgcn_mfma_f32_32x32x16_bf16(PAF(2),VFR(2),o[2],0,0,0), C1,4); \
    KRD(GL,3); GAPB(o[3]=__builtin_amdgcn_mfma_f32_32x32x16_bf16(PAF(2),VFR(3),o[3],0,0,0), C1,6); \
    GAPB(o[0]=__builtin_amdgcn_mfma_f32_32x32x16_bf16(PAF(3),VFR(4),o[0],0,0,0), C1,8); \
    GAPB(o[1]=__builtin_amdgcn_mfma_f32_32x32x16_bf16(PAF(3),VFR(5),o[1],0,0,0), C1,10); \
    GAPB(o[2]=__builtin_amdgcn_mfma_f32_32x32x16_bf16(PAF(3),VFR(6),o[2],0,0,0), C1,12); \
    GAPB(o[3]=__builtin_amdgcn_mfma_f32_32x32x16_bf16(PAF(3),VFR(7),o[3],0,0,0), C1,14); \
    }while(0)
  int t=1;
  #undef CMASK
  #define CMASK(P0,P1,t) do{}while(0)
  for(;t+5<NT;t+=2){
    STEP(pB0,pB1,pA0,pA1,t,true,true,true);     WAIT_BAR(3); RESC(); ROT();
    STEP(pA0,pA1,pB0,pB1,t+1,true,true,true);   WAIT_BAR(3); RESC(); ROT();
  }
  #undef CMASK
  #define CMASK(P0,P1,t) do{int jb_=(t)-(NT-4); if(jb_>=0)cmask(P0,P1,jb_,qrel,hi);}while(0)
  #define ENDW(tt) do{ if((tt)+3<NT){WAIT_BAR(3);} else if((tt)+2<NT){WAIT_BAR(2);} else {WAIT_BAR(0);} }while(0)
  for(;t+1<NT;t+=2){
    STEP(pB0,pB1,pA0,pA1,t,(t+3<NT),(t+1<NT),(t+1<NT));       ENDW(t);   RESC(); ROT();
    STEP(pA0,pA1,pB0,pB1,t+1,(t+4<NT),(t+2<NT),(t+2<NT));     ENDW(t+1); RESC(); ROT();
  }
  STEP(pB0,pB1,pA0,pA1,NT-1,false,false,false); RESC();
  { float sacc=pB0[0]+pB0[1]; _Pragma("unroll") for(int r=2;r<16;++r)sacc+=pB0[r]; _Pragma("unroll") for(int r=0;r<16;++r)sacc+=pB1[r]; l_reg+=sacc;
    pw0=(u32x4){PKW(pB0,0),PKW(pB0,2),PKW(pB0,4),PKW(pB0,6)};pw1=(u32x4){PKW(pB0,8),PKW(pB0,10),PKW(pB0,12),PKW(pB0,14)};pw2=(u32x4){PKW(pB1,0),PKW(pB1,2),PKW(pB1,4),PKW(pB1,6)};pw3=(u32x4){PKW(pB1,8),PKW(pB1,10),PKW(pB1,12),PKW(pB1,14)};
    SBAR(); pv4(o,vb0+2*sl_cur,PAF(0),PAF(1),PAF(2),PAF(3)); }
  #undef PKW
  #undef PAF
  #undef VFR
  #undef PIN
  #undef MX3
  #undef GAPA
  #undef GAPB
  #undef EX
  #undef VRD
  #undef KRD
  #undef STEP
  #undef ENDW
  {auto rr=__builtin_amdgcn_permlane32_swap(__float_as_uint(l_reg),__float_as_uint(l_reg),false,false);l_reg=__uint_as_float(rr[0])+__uint_as_float(rr[1]);}
  if(hi==0)wsf[32+r32]=l_reg;asm volatile("s_waitcnt lgkmcnt(0)":::"memory");
  float rli[16];
  #pragma unroll
  for(int r=0;r<16;++r)rli[r]=__builtin_amdgcn_rcpf(wsf[32+crow(r,hi)]);
  bf16*Ow=O+(rowbase+q0+wid*QBLK)*DM;
  { bf16*stg=(bf16*)(shm+LDS_OST2)+wid*2048;
    float dv[2][4][8]; float ssq[4]={0.f,0.f,0.f,0.f};
    #pragma unroll
    for(int hf=0;hf<2;++hf){
      #pragma unroll
      for(int r=0;r<16;++r){const int orow=crow(r,hi);
        #pragma unroll
        for(int d0=0;d0<2;++d0)stg[orow*64+d0*32+r32]=__float2bfloat16(o[2*hf+d0][r]*rli[r]);}
      asm volatile("s_waitcnt lgkmcnt(0)":::"memory");
      #pragma unroll
      for(int i=0;i<4;++i){const int row=i*8+(lane>>3),ch=lane&7; const u32x4 v=*(const u32x4*)(stg+row*64+ch*8);
        if constexpr(!FUSE){ ATTN_STORE16(Ow+(long)row*DM+hf*64+ch*8,v); }
        else{ const u32x4 v0=*(const u32x4*)(Ow+(long)row*DM+hf*64+ch*8);
          #pragma unroll
          for(int e=0;e<4;++e){ const float a0=__uint_as_float(v0[e]<<16),a1=__uint_as_float(v0[e]&0xffff0000u),b0=__uint_as_float(v[e]<<16),b1=__uint_as_float(v[e]&0xffff0000u);
            const float d0_=a0-lam*b0,d1_=a1-lam*b1; dv[hf][i][2*e]=d0_; dv[hf][i][2*e+1]=d1_; ssq[i]+=d0_*d0_+d1_*d1_; } } }
      asm volatile("s_waitcnt lgkmcnt(0)":::"memory"); }
    if constexpr(FUSE){
      bf16*Nw=ON+(rowbase+q0+wid*QBLK)*DM;
      #pragma unroll
      for(int i=0;i<4;++i){ float s_=ssq[i]; s_+=__shfl_xor(s_,1); s_+=__shfl_xor(s_,2); s_+=__shfl_xor(s_,4); ssq[i]=__builtin_amdgcn_rsqf(s_*(1.f/128.f)+eps)*oscale; }
      #pragma unroll
      for(int hf=0;hf<2;++hf){ const int ch=lane&7; float g_[8];
        #pragma unroll
        for(int e=0;e<8;++e)g_[e]=subg[hf*64+ch*8+e];
        #pragma unroll
        for(int i=0;i<4;++i){const int row=i*8+(lane>>3); u32x4 w;
          #pragma unroll
          for(int e=0;e<4;++e)w[e]=cvtpk_s(dv[hf][i][2*e]*ssq[i]*g_[2*e],dv[hf][i][2*e+1]*ssq[i]*g_[2*e+1]);
          *(u32x4*)(Nw+(long)row*DM+hf*64+ch*8)=w; } } } }
  asm volatile("s_waitcnt lgkmcnt(0)\n\ts_barrier":::"memory");
  #undef DMA_K
  #undef DMA_V
  #undef CMASK
  #undef START
  #undef RESC
  #undef ROT
}
constexpr int ATTN_LDS_BYTES=LDS_BYTES, ATTN128_LDS_BYTES=NSLOT*SLOTB+NSLOT*2*SLOTB+NW*64*4+NW*4096;
#undef SBAR
#undef WAIT_BAR
}
#define GAS __attribute__((address_space(1)))
#define LAS __attribute__((address_space(3)))
typedef unsigned short bf16;
typedef unsigned v4u __attribute__((ext_vector_type(4)));
typedef float f32x4 __attribute__((ext_vector_type(4)));
typedef short bf16x8 __attribute__((ext_vector_type(8)));
typedef GAS unsigned gu32;
typedef GAS unsigned long long gu64;
#define RLX_AGENT __ATOMIC_RELAXED, __HIP_MEMORY_SCOPE_AGENT
#define LDS_WAIT() asm volatile("s_waitcnt lgkmcnt(0)" ::: "memory")
#define VM_WAIT() asm volatile("s_waitcnt vmcnt(0)" ::: "memory")
__device__ __forceinline__ unsigned long long rt() { return __builtin_amdgcn_s_memrealtime(); }
__device__ __forceinline__ unsigned f2bf(float f) { unsigned u = __builtin_bit_cast(unsigned, f); return (u + 0x7fffu + ((u >> 16) & 1u)) >> 16; }
__device__ __forceinline__ unsigned pk2(float lo, float hi) { return f2bf(lo) | (f2bf(hi) << 16); }

#define XB_TMO      128
#define XB_XCNT(j)  (256  + 64 * (j))
#define XB_XSUB(j)  (1280 + 64 * (j))
#define XB_XGEN(j)  (2304 + 64 * (j))
#define XB_TOP      3328
#define XB_TOPGEN   3392
#define XCD_BAR_WORDS 3456
#define XB_SPIN_CAP (1u << 18)

__device__ __forceinline__ unsigned xb_ld(unsigned* p)              { return __hip_atomic_load(p, __ATOMIC_RELAXED, __HIP_MEMORY_SCOPE_AGENT); }
__device__ __forceinline__ unsigned xb_add(unsigned* p, unsigned v) { return __hip_atomic_fetch_add(p, v, __ATOMIC_RELAXED, __HIP_MEMORY_SCOPE_AGENT); }
__device__ __forceinline__ unsigned xb_xcc_id() { return (unsigned)__builtin_amdgcn_s_getreg((3 << 11) | 20) & 0xFu; }
#define XB_SPIN(cond, bar) do { unsigned _sp = 0; while (cond) { __builtin_amdgcn_s_sleep(1); \
    if ((++_sp & 255u) == 0u) { if (xb_ld(&(bar)[XB_TMO])) break; if (_sp > XB_SPIN_CAP) { atomicAdd(&(bar)[XB_TMO], 1u); break; } } } } while (0)

struct XcdBarrier {
    unsigned* bar; unsigned x;
    volatile LAS unsigned* st;
};

__device__ __forceinline__ XcdBarrier xcd_barrier_post(unsigned* bar, volatile LAS unsigned* st) {
    XcdBarrier b; b.bar = bar; b.x = xb_xcc_id(); b.st = st;
    if (threadIdx.x == 0) (void)xb_add(&bar[XB_XCNT(b.x)], 1u);
    return b;
}
__device__ __forceinline__ void xcd_barrier_complete(unsigned* bar, unsigned x, unsigned& nloc, unsigned& nx) {
    const unsigned G = gridDim.x * gridDim.y * gridDim.z;
    unsigned sum, cnt, mine, sp = 0u;
    for (;;) {
        sum = 0u; cnt = 0u; mine = 0u;
#pragma unroll
        for (unsigned j = 0; j < 16; ++j) { const unsigned c = xb_ld(&bar[XB_XCNT(j)]); sum += c; cnt += (c > 0u) ? 1u : 0u; mine = (j == x) ? c : mine; }
        if (sum == G) break;
        __builtin_amdgcn_s_sleep(1);
        if ((++sp & 255u) == 0u) { if (xb_ld(&bar[XB_TMO])) break; if (sp > XB_SPIN_CAP) { atomicAdd(&bar[XB_TMO], 1u); break; } }
    }
    nloc = mine > 0u ? mine : 1u; nx = cnt > 0u ? cnt : 1u;
}

__device__ __forceinline__ void xcd_barrier(const XcdBarrier& b) {
    asm volatile("s_waitcnt vmcnt(0)" ::: "memory");
    __syncthreads();
    if (threadIdx.x == 0) {
        unsigned* bar = b.bar;
        __builtin_amdgcn_s_waitcnt(0);
        unsigned nloc = b.st[0], nx = b.st[1];
        if (nloc == 0u) { xcd_barrier_complete(bar, b.x, nloc, nx); b.st[0] = nloc; b.st[1] = nx; }
        const unsigned old = xb_add(&bar[XB_XSUB(b.x)], 1u);
        const unsigned gen = old / nloc;
        if (old + 1u == (gen + 1u) * nloc) {
            __builtin_amdgcn_fence(__ATOMIC_RELEASE, "agent");
            asm volatile("s_waitcnt vmcnt(0)" ::: "memory");
            const unsigned og = xb_add(&bar[XB_TOP], 1u);
            const unsigned tg = og / nx;
            if (og + 1u == (tg + 1u) * nx) xb_add(&bar[XB_TOPGEN], 1u);
            else XB_SPIN(xb_ld(&bar[XB_TOPGEN]) == tg, bar);
            __builtin_amdgcn_fence(__ATOMIC_ACQUIRE, "agent");
            xb_add(&bar[XB_XGEN(b.x)], 1u);
            asm volatile("s_waitcnt vmcnt(0)" ::: "memory");
        } else {
            XB_SPIN(xb_ld(&bar[XB_XGEN(b.x)]) == gen, bar);
            __builtin_amdgcn_fence(__ATOMIC_ACQUIRE, "agent");
            asm volatile("s_waitcnt vmcnt(0)" ::: "memory");
        }
    }
    __syncthreads();
}
constexpr int NWAVES = 8;
constexpr int D = 1024, NB = 8, S = 2048, M = NB * S, PLE = 256, QKVW = 3072, DFF = 2816, NE = 8, DFE = 3584;
constexpr float EPS = 1e-6f, LAM_INIT0 = 0.2f;
constexpr int N_PHASES = 17;
#ifndef WGM_P1
#define WGM_P1 2
#endif
#ifndef WGM_P5
#define WGM_P5 2
#endif
#ifndef WGM_P11
#define WGM_P11 2
#endif
#ifndef WGM_1U
#define WGM_1U 8
#endif
#ifndef MK_N_LAUNCHES
#define MK_N_LAUNCHES 1
#endif
#ifndef MEGA_END
#define MEGA_END N_PHASES
#endif

constexpr size_t MiB = 1u << 20;
constexpr size_t WS_CTL = 0, CTL_ZERO_BYTES = 1 * MiB;
constexpr size_t WS_COS = 1 * MiB, WS_SIN = WS_COS + 256 * 1024, WS_TOKSLOT = WS_COS + 512 * 1024, WS_QKN = WS_TOKSLOT + 256 * 1024, WS_RSTL = 7 * MiB + 512 * 1024  , WS_RSTD1 = WS_QKN + 64 * 1024, WS_RSTD2 = WS_RSTD1 + 64 * 1024;
constexpr size_t WS_LISTS = 2 * MiB, WS_GWL = WS_LISTS + 512 * 1024;
constexpr size_t WS_WPOOL = 4 * MiB, WS_WPG1 = 5 * MiB, WS_WPP1 = 7 * MiB;
constexpr size_t WS_WGU = 8 * MiB, WS_WD = 120 * MiB;
constexpr size_t WS_YS = 8 * MiB;
constexpr size_t WS_XN = 176 * MiB, WS_PROJ1 = 208 * MiB, WS_BIG = 240 * MiB;
constexpr size_t WS_WQKV = 240 * MiB, WS_WO = 246 * MiB, WS_WGU0 = 248 * MiB, WS_WD0 = 259 * MiB, WS_WPG0 = 265 * MiB, WS_WPP0 = 267 * MiB;
constexpr size_t WS_Q = 268 * MiB, WS_K = 300 * MiB, WS_V = 332 * MiB, WS_O = 364 * MiB;
constexpr size_t WS_HFF = 268 * MiB, WS_PROJ0 = 364 * MiB, WS_PB = 428 * MiB;
constexpr size_t WS_HM = 240 * MiB;
constexpr size_t WS_XNB = 396 * MiB;
constexpr size_t WS_SSQA = 3 * MiB, WS_SSQB = 460 * MiB, WS_SSQC = 461 * MiB;
constexpr size_t WS_END = 466 * MiB;
static_assert(WS_WD0 + (size_t)D * DFF * 2 <= WS_WPG0 && WS_WGU0 + (size_t)2 * DFF * D * 2 <= WS_WD0 && WS_HFF + (size_t)M * DFF * 2 <= WS_PROJ0 && WS_HM + (size_t)(2 * M + 256) * DFE * 2 <= WS_END, "d_ws map");
constexpr int CW_TMO = 0, CW_CODE = 1, CW_BAR = 4096, CW_MOECNT = 65536, CW_STEAL = 98304;

constexpr int RING_OFF = 0, RING_BYTES = 131072, LDSCTL_OFF = RING_BYTES, MISC_OFF = LDSCTL_OFF + 320, LDS_BYTES = 147456;

struct Frame { LAS unsigned char* lds; volatile LAS unsigned* MISC; gu32* ctl; int tid, lane, wave, vcu, G; };

__device__ __forceinline__ float wave_sum(float v) {
#pragma unroll
    for (int o = 1; o < 64; o <<= 1) v += __shfl_xor(v, o);
    return v;
}
__device__ __forceinline__ unsigned cvtpk(float lo, float hi) { unsigned r; asm volatile("v_cvt_pk_bf16_f32 %0, %1, %2" : "=v"(r) : "v"(lo), "v"(hi)); return r; }
__device__ __forceinline__ float bflo(unsigned w) { return __uint_as_float(w << 16); }
__device__ __forceinline__ float bfhi(unsigned w) { return __uint_as_float(w & 0xffff0000u); }

__device__ __forceinline__ int map_row(int map, int n) {
    if (map == 1) return (n & ~255) + ((n >> 5) & 1) * 128 + ((n >> 6) & 3) * 32 + (n & 31);
    if (map == 2) return ((n >> 7) << 8) + (n & 127);
    if (map == 3) return ((n >> 7) << 8) + 128 + (n & 127);
    return n;
}
typedef float f32x2g __attribute__((ext_vector_type(2)));
__device__ __forceinline__ void tr_load(f32x4 (&v)[16], f32x2g (&g)[8], const float* W, int N, int k0, int n0, int lane, const float* gk) {
    const int ksub = lane >> 4, n4 = (lane & 15) * 4;
#pragma unroll
    for (int it = 0; it < 8; ++it)
#pragma unroll
        for (int h = 0; h < 2; ++h) v[2 * it + h] = __builtin_nontemporal_load((const GAS f32x4*)(W + (size_t)(k0 + it * 8 + 2 * ksub + h) * N + n0 + n4));
    const float* gp = gk ? gk : W;
#pragma unroll
    for (int it = 0; it < 8; ++it) g[it] = *(const GAS f32x2g*)(gp + k0 + it * 8 + 2 * ksub);
}
__device__ __forceinline__ void tr_store(const f32x4 (&v)[16], bf16* dst, int ldd, int map, int k0, int n0, LAS unsigned* tile, int lane, const f32x2g (&graw)[8], float sel) {
    const int ksub = lane >> 4, q = lane & 15;
    f32x2g g[8];
#pragma unroll
    for (int it = 0; it < 8; ++it) g[it] = graw[it] * sel + (1.f - sel);
#pragma unroll
    for (int it = 0; it < 8; ++it)
#pragma unroll
        for (int j = 0; j < 4; ++j) tile[(4 * q + j) * 32 + ((4 * it + ksub) ^ ((q & 7) * 4))] = cvtpk(v[2 * it][j] * g[it].x, v[2 * it + 1][j] * g[it].y);
    LDS_WAIT(); asm volatile("" ::: "memory");
    const int c = lane & 7;
#pragma unroll
    for (int j2 = 0; j2 < 8; ++j2) { const int n = (lane >> 3) + 8 * j2, fz = ((n >> 2) & 7) * 4; const v4u w = *(const LAS v4u*)(tile + n * 32 + ((4 * c) ^ fz));
        *(GAS v4u*)(dst + (size_t)map_row(map, n0 + n) * ldd + k0 + 8 * c) = w; }
    LDS_WAIT(); asm volatile("" ::: "memory");
}
struct TItem { const float* W; bf16* dst; const float* g; int K, N, map, kb, nb; };
enum { A_X = 0, A_P, A_NORM_MIX, A_NORM_FFN, A_NORM_PLE, A_WQKV, A_WO, A_QNORM, A_KNORM, A_LQ1, A_LK1, A_LQ2, A_LK2, A_SUBLN, A_POOLW, A_POOLB, A_POOLS, A_FFNG, A_FFNU, A_FFND, A_ROUTER, A_MOEG, A_MOEU, A_MOED, A_PLEP, A_PLEG };
__device__ __forceinline__ const float* arg_ptr(int i) {
    const __attribute__((address_space(4))) char* kp = (const __attribute__((address_space(4))) char*)__builtin_amdgcn_kernarg_segment_ptr();
    unsigned off = (unsigned)i * 8u; asm volatile("" : "+s"(off));
    return *(const float* const __attribute__((address_space(4)))*)(kp + off);
}
constexpr int TI_QKV = 768, TI_O = 256, TI_FF = 704, TI_PG = 256, TI_PP = 64, TI_POOL = 64, TI_MOE = 7168;
constexpr int TI_TOTAL = TI_QKV + TI_O + 3 * TI_FF + 2 * TI_PG + 2 * TI_PP + TI_POOL + 3 * TI_MOE;
__device__ __forceinline__ void decode_item(unsigned char* ws, int r, TItem& t) {
    int ai = 0, gi = -1, gofs = 0; size_t wofs = 0;
    do {
#define TJOB(cnt, Ai, Wofs, Kp, Np, dstp, mapp, Gi, Gofs) if (r < (cnt)) { ai = (Ai); wofs = (Wofs); gi = (Gi); gofs = (Gofs); t.K = (Kp); t.N = (Np); t.dst = (bf16*)(dstp); t.map = (mapp); t.kb = r / ((Np) / 64); t.nb = r % ((Np) / 64); break; } r -= (cnt);
        if (r < TI_MOE) { const int e = r / 896; r -= e * 896; ai = A_MOEG; gi = A_NORM_FFN; gofs = D; wofs = (size_t)e * D * DFE; t.K = D; t.N = DFE; t.dst = (bf16*)(ws + WS_WGU) + (size_t)e * 2 * DFE * D; t.map = 2; t.kb = r / 56; t.nb = r % 56; break; } r -= TI_MOE;
        if (r < TI_MOE) { const int e = r / 896; r -= e * 896; ai = A_MOEU; gi = A_NORM_FFN; gofs = D; wofs = (size_t)e * D * DFE; t.K = D; t.N = DFE; t.dst = (bf16*)(ws + WS_WGU) + (size_t)e * 2 * DFE * D; t.map = 3; t.kb = r / 56; t.nb = r % 56; break; } r -= TI_MOE;
        if (r < TI_MOE) { const int e = r / 896; r -= e * 896; ai = A_MOED; wofs = (size_t)e * DFE * D; t.K = DFE; t.N = D; t.dst = (bf16*)(ws + WS_WD) + (size_t)e * D * DFE; t.map = 0; t.kb = r / 16; t.nb = r % 16; break; } r -= TI_MOE;
        TJOB(TI_QKV, A_WQKV, 0, D, QKVW, ws + WS_WQKV, 1, -1, 0)
        TJOB(TI_O, A_WO, 0, D, D, ws + WS_WO, 0, -1, 0)
        TJOB(TI_FF, A_FFNG, 0, D, DFF, ws + WS_WGU0, 2, A_NORM_FFN, 0)
        TJOB(TI_FF, A_FFNU, 0, D, DFF, ws + WS_WGU0, 3, A_NORM_FFN, 0)
        TJOB(TI_FF, A_FFND, 0, DFF, D, ws + WS_WD0, 0, -1, 0)
        TJOB(TI_PG, A_PLEG, 0, D, D, ws + WS_WPG0, 0, A_NORM_PLE, 0)
        TJOB(TI_PG, A_PLEG, (size_t)D * D, D, D, ws + WS_WPG1, 0, A_NORM_PLE, D)
        TJOB(TI_PP, A_PLEP, 0, PLE, D, ws + WS_WPP0, 0, -1, 0)
        TJOB(TI_PP, A_PLEP, (size_t)PLE * D, PLE, D, ws + WS_WPP1, 0, -1, 0)
        { const int g = r / 16; r -= g * 16; ai = A_POOLW; gi = A_NORM_MIX; gofs = D + g * 256; wofs = (size_t)g * 256 * 256; t.K = 256; t.N = 256; t.dst = (bf16*)(ws + WS_WPOOL) + (size_t)g * 256 * 256; t.map = 0; t.kb = r / 4; t.nb = r % 4; }
#undef TJOB
    } while (0);
    t.W = arg_ptr(ai) + wofs; t.g = nullptr; if (gi >= 0) t.g = arg_ptr(gi) + gofs;
}
__device__ __forceinline__ void rms_row_to_bf16(const float* xrow, const float* gain, bf16* orow, int lane) {
    const GAS f32x4* xr = (const GAS f32x4*)xrow + lane;
    f32x4 v[4]; float s = 0.f;
#pragma unroll
    for (int j = 0; j < 4; ++j) { v[j] = xr[64 * j]; s += (v[j].x * v[j].x + v[j].y * v[j].y) + (v[j].z * v[j].z + v[j].w * v[j].w); }
    const float rstd = __builtin_amdgcn_rsqf(wave_sum(s) * (1.f / D) + EPS);
    GAS unsigned long long* o8 = (GAS unsigned long long*)orow + lane;
#pragma unroll
    for (int j = 0; j < 4; ++j) { const f32x4 g = ((const GAS f32x4*)gain)[lane + 64 * j];
        o8[64 * j] = (unsigned long long)cvtpk(v[j].x * rstd * g.x, v[j].y * rstd * g.y) | ((unsigned long long)cvtpk(v[j].z * rstd * g.z, v[j].w * rstd * g.w) << 32); }
}
__device__ __forceinline__ void p_norm(Frame& F, const float* H, const float* gain, bf16* XN) {
    const int gw = F.vcu * NWAVES + F.wave, NGW = F.G * NWAVES, lane = F.lane;
    for (int m0 = gw * 4; m0 < M; m0 += NGW * 4) {
        f32x4 v[4][4];
#pragma unroll
        for (int r = 0; r < 4; ++r) { const GAS f32x4* xr = (const GAS f32x4*)(H + (size_t)(m0 + r) * D) + lane;
#pragma unroll
            for (int j = 0; j < 4; ++j) v[r][j] = xr[64 * j]; }
#pragma unroll
        for (int r = 0; r < 4; ++r) { float s = 0.f;
#pragma unroll
            for (int j = 0; j < 4; ++j) s += (v[r][j].x * v[r][j].x + v[r][j].y * v[r][j].y) + (v[r][j].z * v[r][j].z + v[r][j].w * v[r][j].w);
            const float rstd = __builtin_amdgcn_rsqf(wave_sum(s) * (1.f / D) + EPS);
            GAS unsigned long long* o8 = (GAS unsigned long long*)(XN + (size_t)(m0 + r) * D) + lane;
#pragma unroll
            for (int j = 0; j < 4; ++j) { const f32x4 g = ((const GAS f32x4*)gain)[lane + 64 * j];
                o8[64 * j] = (unsigned long long)cvtpk(v[r][j].x * rstd * g.x, v[r][j].y * rstd * g.y) | ((unsigned long long)cvtpk(v[r][j].z * rstd * g.z, v[r][j].w * rstd * g.w) << 32); } }
    }
}
__device__ __forceinline__ void conv_range(unsigned char* ws, LAS unsigned* tile, int lane_in, int it0, int step, int nmax, int it_end) {
    int lane = lane_in; asm volatile("" : "+v"(lane));
    for (int it = it0, n = 0; it < it_end && n < nmax; it += 2 * step, n += 2) {
        const bool hasb = (it + step < it_end) && (n + 1 < nmax); const int itb = hasb ? it + step : it;
        TItem ta, tb; f32x4 va[16], vb[16]; f32x2g ga[8], gb[8];
        decode_item(ws, it, ta); tr_load(va, ga, ta.W, ta.N, ta.kb * 64, ta.nb * 64, lane, ta.g);
        decode_item(ws, itb, tb); tr_load(vb, gb, tb.W, tb.N, tb.kb * 64, tb.nb * 64, lane, tb.g);
        tr_store(va, ta.dst, ta.K, ta.map, ta.kb * 64, ta.nb * 64, tile, lane, ga, ta.g ? 1.f : 0.f);
        tr_store(vb, tb.dst, tb.K, tb.map, tb.kb * 64, tb.nb * 64, tile, lane, gb, tb.g ? 1.f : 0.f);
    }
}
__device__ __forceinline__ void p0_prologue(Frame& F, unsigned char* ws) {
    const int gw = F.vcu * NWAVES + F.wave, NGW = F.G * NWAVES, gt = gw * 64 + F.lane, NGT = NGW * 64;
    for (int idx = gt; idx < S * 32; idx += NGT) {
        const int pos = idx >> 5, i = idx & 31;
        const float inv = 1.0f / __builtin_amdgcn_exp2f((float)i * (13.287712379549449f / 32.f));
        const float ang = (float)pos * inv; const double a = (double)ang * 0.15915494309189535; const float f = (float)(a - __builtin_rint(a));
        ((float*)(ws + WS_COS))[idx] = __builtin_amdgcn_cosf(f); ((float*)(ws + WS_SIN))[idx] = __builtin_amdgcn_sinf(f);
    }
    if (gt < 128) ((float*)(ws + WS_QKN))[gt] = gt < 64 ? arg_ptr(A_QNORM)[gt] : arg_ptr(A_KNORM)[gt - 64];
    { const float* pp = arg_ptr(A_P);
#pragma unroll 4
    for (int i = gt; i < 2 * M * PLE / 8; i += NGT) { const f32x4 a = ((const GAS f32x4*)pp)[2 * i], b = ((const GAS f32x4*)pp)[2 * i + 1];
        v4u w; w.x = cvtpk(a.x, a.y); w.y = cvtpk(a.z, a.w); w.z = cvtpk(b.x, b.y); w.w = cvtpk(b.z, b.w); ((GAS v4u*)(ws + WS_PB))[i] = w; } }
    p_norm(F, arg_ptr(A_X), arg_ptr(A_NORM_MIX), (bf16*)(ws + WS_XN));
    conv_range(ws, (LAS unsigned*)(F.lds + RING_OFF + F.wave * 8192), F.lane, 3 * TI_MOE + gw, NGW, 1 << 30, TI_TOTAL);
}
__device__ __forceinline__ void p_subln(Frame& F, const bf16* O, bf16* XN) {
    const int gw = F.vcu * NWAVES + F.wave, NGW = F.G * NWAVES, lane = F.lane;
    const float lam = __expf(wave_sum(arg_ptr(A_LQ1)[lane] * arg_ptr(A_LK1)[lane])) - __expf(wave_sum(arg_ptr(A_LQ2)[lane] * arg_ptr(A_LK2)[lane])) + LAM_INIT0;
    const float* subln_g = arg_ptr(A_SUBLN);
    float sg[16];
#pragma unroll
    for (int i = 0; i < 4; ++i) { const f32x4 g = *(const GAS f32x4*)(subln_g + (lane & 7) * 16 + 4 * i); sg[4 * i] = g.x; sg[4 * i + 1] = g.y; sg[4 * i + 2] = g.z; sg[4 * i + 3] = g.w; }
    for (int m = gw; m < M; m += NGW) {
        const GAS v4u* o0 = (const GAS v4u*)(O + (size_t)m * D) + 2 * lane; const GAS v4u* o1 = (const GAS v4u*)(O + (size_t)M * D + (size_t)m * D) + 2 * lane;
        const v4u a0 = o0[0], a1 = o0[1], b0 = o1[0], b1 = o1[1];
        const unsigned aw[8] = {a0.x, a0.y, a0.z, a0.w, a1.x, a1.y, a1.z, a1.w}, bw[8] = {b0.x, b0.y, b0.z, b0.w, b1.x, b1.y, b1.z, b1.w};
        float v[16]; float ss = 0.f;
#pragma unroll
        for (int i = 0; i < 8; ++i) { v[2 * i] = bflo(aw[i]) - lam * bflo(bw[i]); v[2 * i + 1] = bfhi(aw[i]) - lam * bfhi(bw[i]); ss += v[2 * i] * v[2 * i] + v[2 * i + 1] * v[2 * i + 1]; }
        ss += __shfl_xor(ss, 1); ss += __shfl_xor(ss, 2); ss += __shfl_xor(ss, 4);
        const float r = __builtin_amdgcn_rsqf(ss * (1.f / 128.f) + EPS) * (1.f - LAM_INIT0);
        v4u w0, w1;
        w0.x = cvtpk(v[0] * r * sg[0], v[1] * r * sg[1]); w0.y = cvtpk(v[2] * r * sg[2], v[3] * r * sg[3]); w0.z = cvtpk(v[4] * r * sg[4], v[5] * r * sg[5]); w0.w = cvtpk(v[6] * r * sg[6], v[7] * r * sg[7]);
        w1.x = cvtpk(v[8] * r * sg[8], v[9] * r * sg[9]); w1.y = cvtpk(v[10] * r * sg[10], v[11] * r * sg[11]); w1.z = cvtpk(v[12] * r * sg[12], v[13] * r * sg[13]); w1.w = cvtpk(v[14] * r * sg[14], v[15] * r * sg[15]);
        GAS v4u* o = (GAS v4u*)(XN + (size_t)m * D) + 2 * lane; o[0] = w0; o[1] = w1;
    }
}
__device__ __forceinline__ void p_pool(Frame& F, const bf16* H, bf16* XN, const float* ssqp) {
    LAS float* rs = (LAS float*)(F.lds + RING_OFF);
    for (int blk = F.vcu; blk < M / 64; blk += F.G) {
        const int r0 = blk * 64, t0 = r0 & (S - 1);
        if (F.tid < 80) { const int row = r0 - 16 + F.tid; float r = 0.f; if (F.tid >= 16 || t0 != 0) r = pg8::row_rstd(ssqp, row, EPS); rs[F.tid] = r; }
        __syncthreads();
        const int cq = F.tid & 127, rq = F.tid >> 7, col = 8 * cq, g = col >> 8, w = 2 << g, rbase = 16 * rq, tq = t0 + rbase;
        const bf16* Hc = H + (size_t)(r0 + rbase) * D + col;
#define LD8(dst, p) do { const v4u w_ = *(const GAS v4u*)(p); dst[0] = bflo(w_.x); dst[1] = bfhi(w_.x); dst[2] = bflo(w_.y); dst[3] = bfhi(w_.y); dst[4] = bflo(w_.z); dst[5] = bfhi(w_.z); dst[6] = bflo(w_.w); dst[7] = bfhi(w_.w); } while (0)
        float sw[8];
#pragma unroll
        for (int i = 0; i < 8; ++i) sw[i] = 0.f;
        if (tq != 0) for (int k = 1; k <= w; ++k) { float hv[8]; LD8(hv, Hc - (long)k * D); const float r = rs[16 + rbase - k];
#pragma unroll
            for (int i = 0; i < 8; ++i) sw[i] += hv[i] * r; }
#pragma unroll 1
        for (int rb = 0; rb < 16; rb += 8) {
            float nv[8][8], ov[8][8];
#pragma unroll
            for (int j = 0; j < 8; ++j) LD8(nv[j], Hc + (long)(rb + j) * D);
#pragma unroll
            for (int j = 0; j < 8; ++j) {
#pragma unroll
                for (int i = 0; i < 8; ++i) ov[j][i] = 0.f;
                if (tq + rb + j >= w) LD8(ov[j], Hc + (long)(rb + j - w) * D); }
#pragma unroll
            for (int j = 0; j < 8; ++j) { const int rl = rbase + rb + j, t = t0 + rl; const float rn = rs[16 + rl], ro = (t >= w) ? rs[16 + rl - w] : 0.f;
                const int cnt = (t + 1 < w) ? t + 1 : w; const float ic = 1.f / (float)cnt; float o[8];
#pragma unroll
                for (int i = 0; i < 8; ++i) { const float a = nv[j][i] * rn; sw[i] += a; sw[i] -= ov[j][i] * ro; o[i] = sw[i] * ic - a; }
                v4u ow; ow.x = cvtpk(o[0], o[1]); ow.y = cvtpk(o[2], o[3]); ow.z = cvtpk(o[4], o[5]); ow.w = cvtpk(o[6], o[7]);
                *(GAS v4u*)(XN + (size_t)(r0 + rl) * D + col) = ow; }
        }
#undef LD8
        __syncthreads();
    }
}

__device__ __forceinline__ void p_router(Frame& F, const bf16* H, const float* gain, const float* Wr, float* rstl, int* lists, float* gwl, int* tokslot, gu32* cntw) {
    LAS float* rec = (LAS float*)(F.lds + RING_OFF);
    const int lane = F.lane;
    LAS float* wl = (LAS float*)(F.lds + RING_OFF + 4096);
#pragma unroll
    for (int q = 0; q < 4; ++q) { const int o4 = (F.tid + 512 * q) * 4; *(LAS f32x4*)(wl + (o4 >> 6) * 68 + (o4 & 63)) = *(const GAS f32x4*)(Wr + o4); }
    __syncthreads();
    float wr[4][4][8];
#pragma unroll
    for (int j = 0; j < 4; ++j)
#pragma unroll
        for (int i = 0; i < 4; ++i) { const LAS float* wp = wl + ((j >> 1) * 64 + lane) * 68 + (4 * (j & 1) + i) * 8; const f32x4 a = *(const LAS f32x4*)wp, b = *(const LAS f32x4*)(wp + 4);
            wr[j][i][0] = a.x; wr[j][i][1] = a.y; wr[j][i][2] = a.z; wr[j][i][3] = a.w; wr[j][i][4] = b.x; wr[j][i][5] = b.y; wr[j][i][6] = b.z; wr[j][i][7] = b.w; }
    f32x4 gn[4];
#pragma unroll
    for (int j = 0; j < 4; ++j) gn[j] = *(const GAS f32x4*)(gain + 8 * lane + 512 * (j >> 1) + 4 * (j & 1));
    for (int blk = F.vcu; blk < M / 64; blk += F.G) {
        v4u raw[8][2];
#pragma unroll
        for (int rr = 0; rr < 8; ++rr) { const GAS v4u* xr = (const GAS v4u*)(H + (size_t)(blk * 64 + F.wave * 8 + rr) * D) + lane;
#pragma unroll
            for (int p = 0; p < 2; ++p) raw[rr][p] = xr[64 * p]; }
#pragma unroll
        for (int rr = 0; rr < 8; ++rr) {
            const int rl = F.wave * 8 + rr;
            f32x4 v[4]; float s = 0.f;
#pragma unroll
            for (int j = 0; j < 4; ++j) { const v4u a = raw[rr][j >> 1]; const unsigned lo = (j & 1) ? a.z : a.x, hi = (j & 1) ? a.w : a.y; v[j] = (f32x4){bflo(lo), bfhi(lo), bflo(hi), bfhi(hi)}; s += (v[j].x * v[j].x + v[j].y * v[j].y) + (v[j].z * v[j].z + v[j].w * v[j].w); }
            const float rstd = __builtin_amdgcn_rsqf(wave_sum(s) * (1.f / D) + EPS);
            float lg[8];
#pragma unroll
            for (int e = 0; e < 8; ++e) lg[e] = 0.f;
#pragma unroll
            for (int j = 0; j < 4; ++j) { const float xu[4] = {v[j].x * rstd, v[j].y * rstd, v[j].z * rstd, v[j].w * rstd};
                const float xv[4] = {xu[0] * gn[j].x, xu[1] * gn[j].y, xu[2] * gn[j].z, xu[3] * gn[j].w};
#pragma unroll
                for (int i = 0; i < 4; ++i)
#pragma unroll
                    for (int e = 0; e < 8; ++e) lg[e] = __builtin_fmaf(xv[i], wr[j][i][e], lg[e]); }
            {
                const bool b5 = (lane & 32) != 0, b4 = (lane & 16) != 0, b3 = (lane & 8) != 0;
                float rb[4], rc[2], rd;
#pragma unroll
                for (int i = 0; i < 4; ++i) { const float send = b5 ? lg[i] : lg[i + 4], keep = b5 ? lg[i + 4] : lg[i]; rb[i] = keep + __shfl_xor(send, 32); }
#pragma unroll
                for (int i = 0; i < 2; ++i) { const float send = b4 ? rb[i] : rb[i + 2], keep = b4 ? rb[i + 2] : rb[i]; rc[i] = keep + __shfl_xor(send, 16); }
                { const float send = b3 ? rc[0] : rc[1], keep = b3 ? rc[1] : rc[0]; rd = keep + __shfl_xor(send, 8); }
                rd += __shfl_xor(rd, 4); rd += __shfl_xor(rd, 2); rd += __shfl_xor(rd, 1);
#pragma unroll
                for (int e = 0; e < 8; ++e) lg[e] = __uint_as_float(__builtin_amdgcn_readlane(__float_as_uint(rd), 8 * e));
            }
            int i0 = 0; float v0 = lg[0];
#pragma unroll
            for (int e = 1; e < 8; ++e) if (lg[e] > v0) { v0 = lg[e]; i0 = e; }
            int i1 = 0; float v1 = -INFINITY;
#pragma unroll
            for (int e = 0; e < 8; ++e) if (e != i0 && lg[e] > v1) { v1 = lg[e]; i1 = e; }
            const float g1 = 1.f / (1.f + __expf(v0 - v1)), g0 = 1.f - g1;
            if (lane == 0) { rec[rl * 8 + 0] = __int_as_float(i0); rec[rl * 8 + 1] = __int_as_float(i1); rec[rl * 8 + 2] = g0; rec[rl * 8 + 3] = g1; rec[rl * 8 + 4] = rstd; }
        }
        __syncthreads();
        {
            const int ex = F.wave, rl = lane; const int a = __float_as_int(rec[rl * 8]), b = __float_as_int(rec[rl * 8 + 1]);
            const bool sel = (a == ex) || (b == ex); const unsigned long long bal = __ballot(sel);
            const int n = __popcll(bal), pre = __popcll(bal & ((1ull << lane) - 1ull));
            int base = 0; if (lane == 0) base = (int)__hip_atomic_fetch_add(cntw + 64 * ex, (unsigned)n, RLX_AGENT);
            base = __builtin_amdgcn_readfirstlane(base);
            if (sel) { const int k = (a == ex) ? 0 : 1, tok = blk * 64 + rl, pos = base + pre;
                lists[ex * M + pos] = tok; gwl[ex * M + pos] = rec[rl * 8 + 2 + k]; rstl[ex * M + pos] = rec[rl * 8 + 4]; tokslot[tok * 2 + k] = (ex << 16) | pos; }
        }
        __syncthreads();
    }
}
__device__ __forceinline__ void p_combine(Frame& F, bf16* HB, const bf16* Ys, const int* tokslot, float* rstd_out) {
    const int gw = F.vcu * NWAVES + F.wave, NGW = F.G * NWAVES, lane = F.lane;
    int off[8]; { int a = 0;
#pragma unroll
        for (int e = 0; e < 8; ++e) { off[e] = a; a += (int)__hip_atomic_load(F.ctl + CW_MOECNT + 64 * e, RLX_AGENT); } }
    constexpr int RPW = 8;
    for (int m0 = gw * RPW; m0 < M; m0 += NGW * RPW) {
        const int ts = (lane < 2 * RPW) ? tokslot[2 * m0 + lane] : 0;
#pragma unroll
        for (int g = 0; g < RPW; g += 4) {
            v4u ya[4][2], yb[4][2], hh[4][2];
#pragma unroll
            for (int r = 0; r < 4; ++r) {
                const int ts0 = __builtin_amdgcn_readlane(ts, 2 * (g + r)), ts1 = __builtin_amdgcn_readlane(ts, 2 * (g + r) + 1);
                int s0 = ts0 & 0xffff, s1 = ts1 & 0xffff;
#pragma unroll
                for (int e = 0; e < 8; ++e) { if ((ts0 >> 16) == e) s0 += off[e]; if ((ts1 >> 16) == e) s1 += off[e]; }
                const GAS v4u* hr = (const GAS v4u*)(HB + (size_t)(m0 + g + r) * D) + lane;
                const GAS v4u* y0 = (const GAS v4u*)(Ys + (size_t)s0 * D) + lane; const GAS v4u* y1 = (const GAS v4u*)(Ys + (size_t)s1 * D) + lane;
#pragma unroll
                for (int j = 0; j < 2; ++j) { ya[r][j] = y0[64 * j]; yb[r][j] = y1[64 * j]; hh[r][j] = hr[64 * j]; }
            }
#pragma unroll
            for (int r = 0; r < 4; ++r) {
                GAS v4u* hw = (GAS v4u*)(HB + (size_t)(m0 + g + r) * D) + lane; float s = 0.f;
#pragma unroll
                for (int j = 0; j < 2; ++j) { const unsigned aw[4] = {ya[r][j].x, ya[r][j].y, ya[r][j].z, ya[r][j].w}, bw_[4] = {yb[r][j].x, yb[r][j].y, yb[r][j].z, yb[r][j].w}, hw_[4] = {hh[r][j].x, hh[r][j].y, hh[r][j].z, hh[r][j].w};
                    unsigned ow[4];
#pragma unroll
                    for (int q = 0; q < 4; ++q) { ow[q] = cvtpk(bflo(hw_[q]) + (bflo(aw[q]) + bflo(bw_[q])), bfhi(hw_[q]) + (bfhi(aw[q]) + bfhi(bw_[q]))); s += bflo(ow[q]) * bflo(ow[q]) + bfhi(ow[q]) * bfhi(ow[q]); }
                    v4u o; o.x = ow[0]; o.y = ow[1]; o.z = ow[2]; o.w = ow[3]; hw[64 * j] = o; }
                const float rstd = __builtin_amdgcn_rsqf(wave_sum(s) * (1.f / D) + EPS);
                if (lane == 0) rstd_out[m0 + g + r] = rstd;
            }
        }
    }
}

struct Args { const float* in[26]; float* out; unsigned char* ws; int ph_lo, ph_hi, li, pad; };
__global__ void __launch_bounds__(NWAVES * 64, 2) mega_fwd(Args args) {
    extern __shared__ __attribute__((aligned(16))) unsigned char lds[];
    Frame F;
    F.lds = (LAS unsigned char*)lds;
    F.MISC = (volatile LAS unsigned*)(F.lds + MISC_OFF);
    F.tid = threadIdx.x; F.lane = F.tid & 63; F.wave = __builtin_amdgcn_readfirstlane(F.tid >> 6);
    F.G = gridDim.x; { const int bx = blockIdx.x; F.vcu = (F.G % 8 == 0) ? (bx % 8) * (F.G / 8) + bx / 8 : bx; }
    unsigned char* ws = args.ws;
    F.ctl = (gu32*)(ws + WS_CTL);
    float* const Hout = args.out;
    for (int u = F.tid; u < (LDS_BYTES - LDSCTL_OFF) / 4; u += NWAVES * 64) ((LAS unsigned*)(F.lds + LDSCTL_OFF))[u] = 0u;
    __syncthreads();
    XcdBarrier bar; bar.bar = (unsigned*)(F.ctl + CW_BAR) + args.li * XCD_BAR_WORDS; bar.x = 0; bar.st = nullptr;
    const int lo = args.ph_lo, hi = args.ph_hi;
    if (hi - lo > 1) bar = xcd_barrier_post((unsigned*)(F.ctl + CW_BAR) + args.li * XCD_BAR_WORDS, F.MISC + 8);
#ifndef PHASE_MASK
#define PHASE_MASK 0x1ffff
#endif
#define IN(k) (((PHASE_MASK >> (k)) & 1) && lo <= (k) && (k) < hi)
#define SEAM(k) do { if (IN(k) && IN((k) + 1)) xcd_barrier(bar); } while (0)
#ifndef REP_MASK
#define REP_MASK 0
#endif
#define REPS(k) (((REP_MASK >> (k)) & 1) ? 2 : 1)
#define REPEAT(k) _Pragma("unroll 1") for (int rep_ = 0; rep_ < REPS(k); (++rep_ < REPS(k)) ? xcd_barrier(bar) : (void)0)
    bf16* XN = (bf16*)(ws + WS_XN);
    const int bx = (int)blockIdx.x;
    const long TS1024 = 256L * 1024 * 2;

    float* SSQA = (float*)(ws + WS_SSQA); float* SSQB = (float*)(ws + WS_SSQB); float* SSQC = (float*)(ws + WS_SSQC);
    if (IN(0)) REPEAT(0) { p0_prologue(F, ws); } SEAM(0);
    if (IN(1)) REPEAT(1) {
        pg8::DenseSched Sd{(const char*)XN, (const char*)(ws + WS_WQKV), 64, 12, F.G, bx, TS1024, 0, TS1024, WGM_P1};
        pg8::EpiQKV E{(bf16*)(ws + WS_Q), (size_t)(WS_K - WS_Q) / 2, (const float*)(ws + WS_QKN), (const float*)(ws + WS_COS), (const float*)(ws + WS_SIN), attn_body::C2, EPS};
        pg8::gemm_phase<pg8::EpiQKV, pg8::DenseSched, false, true>(F.lds + RING_OFF, D, D, D, Sd, E);
    } SEAM(1);
    if (IN(2)) REPEAT(2) {
        static_assert(attn_body::ATTN128_LDS_BYTES <= RING_BYTES, "attention LDS");
        const float lam = __expf(wave_sum(arg_ptr(A_LQ1)[F.lane] * arg_ptr(A_LK1)[F.lane])) - __expf(wave_sum(arg_ptr(A_LQ2)[F.lane] * arg_ptr(A_LK2)[F.lane])) + LAM_INIT0;
        const float* subg = arg_ptr(A_SUBLN);
        const int hgrp = (F.vcu * 3) / F.G; const int hkpos = (hgrp == 0) ? -1 : (hgrp == 1) ? 0 : 2; bool conv_done = false;
        for (int hc = F.vcu; hc < NB * 8 * 4; hc += F.G) {
            const int bh = hc >> 2, s_ = hc & 3, b = bh >> 3, h = bh & 7;
            const attn_body::bf16* Vp = (const attn_body::bf16*)(ws + WS_V) + h * 128; attn_body::bf16* Op = (attn_body::bf16*)(ws + WS_O) + h * 128;
            _Pragma("unroll 1") for (int qi = -1; qi < 4; ++qi) {
                if (qi >= 0) { int qb = (qi & 2) ? s_ : 7 - s_; asm volatile("" : "+s"(qb)); const int c = qi & 1;
                    const attn_body::bf16* Qp = (const attn_body::bf16*)(ws + WS_Q) + (h * 2 + c) * 64; const attn_body::bf16* Kp = (const attn_body::bf16*)(ws + WS_K) + (h * 2 + c) * 64;
                    if (c == 0) attn_body::attn_unit128<8, false>(b, qb, Qp, Kp, Vp, Op, (char*)lds + RING_OFF);
                    else attn_body::attn_unit128<8, true>(b, qb, Qp, Kp, Vp, Op, (char*)lds + RING_OFF, (attn_body::bf16*)XN + h * 128, subg, lam, 1.f - LAM_INIT0, EPS); }
                if (qi == hkpos && !conv_done) {
                    conv_range(ws, (LAS unsigned*)(F.lds + RING_OFF + F.wave * 8192), F.lane, F.vcu * NWAVES + F.wave, F.G * NWAVES, 1 << 30, 2 * TI_MOE); conv_done = true;
                    asm volatile("s_waitcnt lgkmcnt(0)" ::: "memory"); __builtin_amdgcn_s_barrier(); asm volatile("" ::: "memory"); }
            }
        }
    } SEAM(2);
    bf16* HB0 = (bf16*)Hout;
    bf16* HB1 = XN;
    bf16* PL = (bf16*)(ws + WS_Q);
    if (IN(4)) REPEAT(4) {
        pg8::DenseSched Sd{(const char*)XN, (const char*)(ws + WS_WO), 64, 4, F.G, bx, TS1024, 0, TS1024, WGM_1U};
        pg8::EpiResNorm<false> E{arg_ptr(A_X), HB0, SSQA};
        pg8::gemm_phase<pg8::EpiResNorm<false>, pg8::DenseSched, false, true>(F.lds + RING_OFF, D, D, D, Sd, E);
    } SEAM(4);
    if (IN(5)) REPEAT(5) {
        { pg8::DenseSched Sd{(const char*)HB0, (const char*)(ws + WS_WGU0), 64, 22, F.G, bx, TS1024, 0, TS1024, WGM_P5};
          pg8::EpiSwiGLU<1> E{(bf16*)(ws + WS_HFF), DFF, EPS, SSQA, nullptr};
          pg8::gemm_phase<pg8::EpiSwiGLU<1>, pg8::DenseSched, false, true>(F.lds + RING_OFF, D, D, D, Sd, E); }
        { const bool split = (F.G == 256);
          pg8::ProjSched Sp{(const char*)(ws + WS_PB), (const char*)(ws + WS_WPP0), (long)M * PLE * 2, (long)WS_WPP1 - (long)WS_WPP0, split ? 128 : F.G, split ? bx - 128 : bx};
          pg8::EpiProj E{(bf16*)(ws + WS_PROJ0), ((long)WS_PROJ1 - (long)WS_PROJ0) / 2};
          pg8::gemm_phase<pg8::EpiProj, pg8::ProjSched, false, true>(F.lds + RING_OFF, PLE, PLE, PLE, Sp, E); }
    } SEAM(5);
    if (IN(6)) {
        pg8::DenseSched Sd{(const char*)(ws + WS_HFF), (const char*)(ws + WS_WD0), 64, 4, F.G, bx, 256L * DFF * 2, 0, 256L * DFF * 2, WGM_1U};
        pg8::EpiResNorm<true> E{HB0, HB0, SSQB};
        pg8::gemm_phase<pg8::EpiResNorm<true>, pg8::DenseSched, false, true>(F.lds + RING_OFF, DFF, DFF, DFF, Sd, E);
    } SEAM(6);
    if (IN(7)) {
        pg8::DenseSched Sd{(const char*)HB0, (const char*)(ws + WS_WPG0), 64, 4, F.G, bx, TS1024, 0, TS1024, WGM_1U};
        pg8::EpiPle<1, false> E{HB0, (const bf16*)(ws + WS_PROJ0), HB1, SSQB, SSQC, EPS, 0};
        pg8::gemm_phase<pg8::EpiPle<1, false>, pg8::DenseSched, false, true>(F.lds + RING_OFF, D, D, D, Sd, E);
    } SEAM(7);
    if (IN(8)) REPEAT(8) { p_pool(F, HB1, PL, SSQC); } SEAM(8);
    if (IN(9)) {
        pg8::DenseSched Sd{(const char*)PL, (const char*)(ws + WS_WPOOL), 64, 4, F.G, bx, TS1024, 256L * 2, 256L * 256 * 2, WGM_1U};
        pg8::EpiPool E{HB1, arg_ptr(A_POOLB), arg_ptr(A_POOLS)};
        pg8::gemm_phase<pg8::EpiPool, pg8::DenseSched, false, true>(F.lds + RING_OFF, 256, D, 256, Sd, E);
    } SEAM(9);
    if (IN(10)) REPEAT(10) { const bool dmy = rep_ + 1 < REPS(10); unsigned char* wd = dmy ? ws + 300 * MiB : ws;
        p_router(F, HB1, arg_ptr(A_NORM_FFN) + D, arg_ptr(A_ROUTER), (float*)(wd + WS_RSTL), (int*)(wd + WS_LISTS), (float*)(wd + WS_GWL), (int*)(wd + WS_TOKSLOT), F.ctl + CW_MOECNT + (dmy ? 1024 : 0)); } SEAM(10);
    if (IN(11)) REPEAT(11) {
        pg8::MoeSched Sm; Sm.A = (const char*)HB1; Sm.B = (const char*)(ws + WS_WGU); Sm.lists = (const int*)(ws + WS_LISTS);
#pragma unroll
        for (int e = 0; e < 8; ++e) Sm.cnt[e] = __builtin_amdgcn_readfirstlane((int)__hip_atomic_load(F.ctl + CW_MOECNT + 64 * e, RLX_AGENT));
        Sm.nN = 28; Sm.G = F.G; Sm.c = bx; Sm.b_e = 2L * DFE * D * 2; Sm.b_pn = TS1024; Sm.a_row = 0; Sm.list_stride = M; Sm.gather = true; Sm.WGM = WGM_P11; Sm.lim = Sm.total();
        pg8::EpiSwiGLU<2> E{(bf16*)(ws + WS_HM), DFE, EPS, (const float*)(ws + WS_RSTL), (const int*)(ws + WS_LISTS)};
        pg8::gemm_phase<pg8::EpiSwiGLU<2>, pg8::MoeSched, true, true>(F.lds + RING_OFF, D, D, D, Sm, E);
        if (rep_ == 0) {
            volatile LAS int* bw = (volatile LAS int*)(F.lds + MISC_OFF + 96);
            for (;;) {
                if (F.tid == 0) bw[0] = (int)__hip_atomic_fetch_add(F.ctl + CW_STEAL, 1u, RLX_AGENT);
                __syncthreads();
                const int batch = __builtin_amdgcn_readfirstlane(bw[0]);
                __syncthreads();
                if (batch * 16 >= TI_MOE) break;
                conv_range(ws, (LAS unsigned*)(F.lds + RING_OFF + F.wave * 8192), F.lane, 2 * TI_MOE + batch * 16 + F.wave * 2, 1, 2, 3 * TI_MOE);
            }
        }
    } SEAM(11);
    pg8::MoeSched Sdn; Sdn.A = (const char*)(ws + WS_HM); Sdn.B = (const char*)(ws + WS_WD); Sdn.lists = (const int*)(ws + WS_GWL);
    Sdn.nN = 4; Sdn.G = F.G; Sdn.c = bx; Sdn.b_e = (long)D * DFE * 2; Sdn.b_pn = 256L * DFE * 2; Sdn.a_row = (long)DFE * 2; Sdn.list_stride = M; Sdn.gather = false; Sdn.WGM = 8; Sdn.lim = 0;
    int dn_R = 0, dn_P = 1;
    if (IN(12) || IN(13) || IN(14)) {
#pragma unroll
        for (int e = 0; e < 8; ++e) Sdn.cnt[e] = __builtin_amdgcn_readfirstlane((int)__hip_atomic_load(F.ctl + CW_MOECNT + 64 * e, RLX_AGENT));
        const int tot = Sdn.total(), whole = (tot / F.G) * F.G;
        dn_R = tot - whole; Sdn.lim = whole;
        dn_P = (dn_R * 14 <= 192 && dn_R * 14 <= F.G) ? 14 : (dn_R * 7 <= 192 && dn_R * 7 <= F.G) ? 7 : (dn_R * 4 <= 192 && dn_R * 4 <= F.G) ? 4 : (dn_R * 2 <= 192 && dn_R * 2 <= F.G) ? 2 : 1;
        if (dn_R * dn_P > 192 || dn_R * dn_P > F.G) { Sdn.lim = tot; dn_R = 0; }
    }
    float* PART = (float*)(ws + 72 * MiB);
    if (IN(12)) REPEAT(12) {
        pg8::EpiMoeDown E{(bf16*)(ws + WS_YS)};
        pg8::gemm_phase<pg8::EpiMoeDown, pg8::MoeSched, false, true>(F.lds + RING_OFF, DFE, DFE, DFE, Sdn, E);
    }
    if (IN(13) && dn_R > 0) {
        pg8::PieceSched Sp{Sdn, Sdn.lim, dn_R, dn_P, (long)(DFE / dn_P) * 2};
        pg8::EpiPart E{PART};
        pg8::gemm_phase<pg8::EpiPart, pg8::PieceSched, false, true>(F.lds + RING_OFF, DFE / dn_P, DFE, DFE, Sp, E);
    }
    if (IN(13) && IN(14) && dn_R > 0) xcd_barrier(bar);
    if (IN(14) && dn_R > 0) {
        for (int w = F.vcu; w < dn_R * 16; w += F.G) {
            const int j = w >> 4, rl = (w & 15) * 16 + (F.tid >> 5), cl = (F.tid & 31) * 8;
            pg8::Unit u; Sdn.decode(Sdn.lim + j, u);
            if (rl < u.nvalid) {
                const float* pp = PART + (size_t)(j * dn_P) * 65536 + (size_t)rl * 256 + cl;
                f32x4 a = (f32x4){0.f, 0.f, 0.f, 0.f}, b = a;
                for (int p = 0; p < dn_P; ++p) { a += *(const GAS f32x4*)(pp + (size_t)p * 65536); b += *(const GAS f32x4*)(pp + (size_t)p * 65536 + 4); }
                const float gwt = ((const float*)u.list)[rl];
                v4u o; o.x = cvtpk(a.x * gwt, a.y * gwt); o.y = cvtpk(a.z * gwt, a.w * gwt); o.z = cvtpk(b.x * gwt, b.y * gwt); o.w = cvtpk(b.z * gwt, b.w * gwt);
                *(GAS v4u*)((bf16*)(ws + WS_YS) + (size_t)(u.r0 + rl) * D + u.c0 + cl) = o;
            }
        }
    }
    if ((IN(12) || IN(13) || IN(14)) && IN(15)) xcd_barrier(bar);
    if (IN(15)) { p_combine(F, HB1, (const bf16*)(ws + WS_YS), (const int*)(ws + WS_TOKSLOT), (float*)(ws + WS_RSTD2)); } SEAM(15);
    if (IN(16)) {
        pg8::DenseSched Sd{(const char*)HB1, (const char*)(ws + WS_WPG1), 64, 4, F.G, bx, TS1024, 0, TS1024, WGM_1U};
        pg8::EpiPle<2, true> E{HB1, (const bf16*)(ws + WS_PROJ1), Hout, (const float*)(ws + WS_RSTD2), nullptr, EPS, 0};
        pg8::gemm_phase<pg8::EpiPle<2, true>, pg8::DenseSched, false, true>(F.lds + RING_OFF, D, D, D, Sd, E);
    }
#undef IN
#undef SEAM
}
extern "C" void kernel_launch(void* const* d_in, const int* in_sizes, int n_in, void* d_out, int out_size, void* d_ws, size_t ws_size, hipStream_t stream) {
    static int grid = 0;
    if (grid == 0) {
        if (n_in != 26 || in_sizes[0] != M * D || out_size != M * D || ws_size < WS_END) { fprintf(stderr, "kernel_launch: unexpected shapes / workspace (%zu)\n", ws_size); grid = -1; return; }
        int dev = 0, cus = 0, per_cu = 0;
        if (hipGetDevice(&dev) != hipSuccess || hipDeviceGetAttribute(&cus, hipDeviceAttributeMultiprocessorCount, dev) != hipSuccess) { grid = -1; return; }
        if (hipFuncSetAttribute((const void*)mega_fwd, hipFuncAttributeMaxDynamicSharedMemorySize, LDS_BYTES) != hipSuccess) { fprintf(stderr, "kernel_launch: hipFuncSetAttribute failed\n"); grid = -1; return; }
        if (hipOccupancyMaxActiveBlocksPerMultiprocessor(&per_cu, (const void*)mega_fwd, NWAVES * 64, LDS_BYTES) != hipSuccess || per_cu < 1) { fprintf(stderr, "kernel_launch: occupancy query says %d\n", per_cu); }
        (void)hipGetLastError();
        grid = cus;
    }
    if (grid < 0) return;
    if (hipMemsetAsync((char*)d_ws + WS_CTL, 0, CTL_ZERO_BYTES, stream) != hipSuccess) return;
    Args a{};
    for (int i = 0; i < 26; ++i) a.in[i] = (const float*)d_in[i];
    a.out = (float*)d_out; a.ws = (unsigned char*)d_ws;
#if MK_N_LAUNCHES == 1
    a.ph_lo = 0; a.ph_hi = MEGA_END; a.li = 0; a.pad = 0;
    hipLaunchKernelGGL(mega_fwd, dim3(grid), dim3(NWAVES * 64), LDS_BYTES, stream, a);
#else
    for (int ph = 0; ph < MEGA_END; ++ph) { a.ph_lo = ph; a.ph_hi = ph + 1; a.li = 0; a.pad = 0; hipLaunchKernelGGL(mega_fwd, dim3(grid), dim3(NWAVES * 64), LDS_BYTES, stream, a); }
#endif
#if MEGA_END < 17
    nv::naive_suffix(MEGA_END <= 5 ? 0 : MEGA_END <= 7 ? 1 : MEGA_END <= 8 ? 2 : MEGA_END <= 10 ? 3 : 4, d_in, (float*)d_out, (char*)d_ws, stream);
#endif
}
```

```cpp
#define MEGA_END 17
#define MK_N_LAUNCHES 1
#include <hip/hip_runtime.h>
#include <cstdio>
#include <cstdint>
namespace pg8 {
#define PG8_LAS __attribute__((address_space(3)))
typedef unsigned short bf16_t;
typedef short bf16x8 __attribute__((ext_vector_type(8)));
typedef float f32x4 __attribute__((ext_vector_type(4)));
typedef float f32x2 __attribute__((ext_vector_type(2)));
typedef unsigned u32x4 __attribute__((ext_vector_type(4)));
typedef unsigned u32x2 __attribute__((ext_vector_type(2)));
constexpr int BM = 256, BK = 64, HALF = 128, HTB = HALF * BK * 2  , STAGE_BYTES = 8 * HTB, NXCD = 8;

__host__ __device__ __forceinline__ int lds_byte(int r, int c) { const int st = (r >> 4) * 2 + (c >> 5), rr = r & 15, cc = c & 31, ob = rr * 64 + cc * 2; return st * 1024 + (ob ^ (((ob >> 9) & 1) << 5)); }
__host__ __device__ __forceinline__ void stage_rc(int b, int& R, int& C) { const int st = b / 1024, sb = b % 1024, swz = sb ^ (((sb >> 9) & 1) << 5); R = (st >> 1) * 16 + swz / 64; C = (st & 1) * 32 + (swz % 64) / 2; }
__host__ __device__ __forceinline__ int perm32(int rho) { const int n = rho >> 4, i = rho & 15; return 8 * (i >> 2) + 4 * n + (i & 3); }

struct Unit { const char* A; const char* B; const int* list; int r0, c0, nvalid, ex; };
struct Pre { float rs[2][4]; };

template <int CTRL> __device__ __forceinline__ float dpp_f(float v) { return __int_as_float(__builtin_amdgcn_update_dpp(0, __float_as_int(v), CTRL, 0xF, 0xF, true)); }
__device__ __forceinline__ float sum_x16(float v) { auto rr = __builtin_amdgcn_permlane16_swap(__float_as_uint(v), __float_as_uint(v), false, false); return __uint_as_float(rr[0]) + __uint_as_float(rr[1]); }
__device__ __forceinline__ float sum_x32(float v) { auto rr = __builtin_amdgcn_permlane32_swap(__float_as_uint(v), __float_as_uint(v), false, false); return __uint_as_float(rr[0]) + __uint_as_float(rr[1]); }
__device__ __forceinline__ float sum_row8(float v) { v += dpp_f<0xB1>(v); v += dpp_f<0x4E>(v); v += dpp_f<0x141>(v); return v; }
__device__ __forceinline__ float sum_wave(float v) { v = sum_row8(v); v += dpp_f<0x140>(v); return sum_x32(sum_x16(v)); }
__device__ __forceinline__ unsigned cvt_pk_bf16(float lo, float hi) { unsigned r; asm volatile("v_cvt_pk_bf16_f32 %0, %1, %2" : "=v"(r) : "v"(lo), "v"(hi)); return r; }
__device__ __forceinline__ float bf_lo(unsigned w) { return __uint_as_float(w << 16); }
__device__ __forceinline__ float bf_hi(unsigned w) { return __uint_as_float(w & 0xffff0000u); }

__device__ __forceinline__ void tile_of(int L, int nM, int nN, int& pm, int& pn, int WGM = 8) {
    const int nwg = nM * nN; int wgid = L; { const int q = nwg / NXCD, r = nwg % NXCD, xcd = wgid % NXCD, off = wgid / NXCD; wgid = (xcd < r ? xcd * (q + 1) : r * (q + 1) + (xcd - r) * q) + off; }
    const int nig = WGM * nN, gid = wgid / nig, fm = gid * WGM, gsz = (nM - fm) < WGM ? (nM - fm) : WGM;
    pm = fm + ((wgid % nig) % gsz); pn = (wgid % nig) / gsz;
}
struct DenseSched {
    static constexpr bool TILED_A = false;
    const char* A; const char* B; int nM, nN, G, c; long a_pm, a_pn, b_pn; int wgm; int rowstat;
    __device__ __forceinline__ bool next(int i, Unit& u) const {
        if (c < 0) return false; int pm, pn;
        if (rowstat) { pm = c >> 2; pn = (c & 3) + 4 * i; if (pn >= nN) return false; }
        else { const long L = (long)i * G + c; if (L >= (long)nM * nN) return false; tile_of((int)L, nM, nN, pm, pn, wgm); }
        u.A = A + pm * a_pm + pn * a_pn; u.B = B + pn * b_pn; u.list = nullptr; u.r0 = pm * BM; u.c0 = pn * BM; u.nvalid = BM; u.ex = 0; return true;
    }
};
struct ProjSched {
    static constexpr bool TILED_A = false;
    const char* A; const char* B; int layer, G, c, n_piece;
    __device__ __forceinline__ bool next(int i, Unit& u) const {
        if (c < 0) return false; int L;
        if (n_piece < 0) L = i * G + c;
        else { const int n_idle = G - n_piece, ii = c - n_piece; const bool idle = ii >= 0;
            if (idle) L = (i == 0) ? ii : (i == 1) ? ii + n_idle : 2 * n_idle + c + (i - 2) * G; else L = 2 * n_idle + c + i * G; }
        if (L >= 64 * 4) return false;
        int pm, pc; tile_of(L, 64, 4, pm, pc, 8);
        u.A = A + (long)pm * (256 * 256 * 2); u.B = B + (long)pc * (256 * 256 * 2); u.list = nullptr; u.r0 = pm * BM; u.c0 = pc * BM; u.nvalid = BM; u.ex = layer; return true;
    }
};
template <bool TILED> struct MoeSchedT {
    static constexpr bool TILED_A = TILED;
    const char* A; const char* B; const int* lists; int cnt[8]; int nN, G, c; long b_e, b_pn, a_row; int list_stride; bool gather; int lim; int WGM;
    __device__ __forceinline__ int total() const { int tot = 0;
#pragma unroll
        for (int e = 0; e < 8; ++e) tot += ((cnt[e] + 255) >> 8) * nN;
        return tot; }
    __device__ __forceinline__ void decode(int L, Unit& u) const {
        const int tot = total();
        int w = L; { const int q = tot / NXCD, r = tot % NXCD, xcd = w % NXCD, off = w / NXCD; w = (xcd < r ? xcd * (q + 1) : r * (q + 1) + (xcd - r) * q) + off; }
        int ex = 0, off_rows = 0, tiles = 0, ce = 0; bool found = false;
#pragma unroll
        for (int e = 0; e < 8; ++e) { const int t = (cnt[e] + 255) >> 8, ue = t * nN; if (!found) { if (w < ue) { found = true; ex = e; tiles = t; ce = cnt[e]; } else { w -= ue; off_rows += cnt[e]; } } }
        const int nig = WGM * nN, gid = w / nig, fm = gid * WGM, gsz = (tiles - fm) < WGM ? (tiles - fm) : WGM;
        int pm = fm + ((w % nig) % gsz); const int pn = (w % nig) / gsz;
        if constexpr (TILED) pm = tiles - 1 - pm;
        u.r0 = off_rows + pm * BM; u.c0 = pn * BM; u.nvalid = (ce - pm * BM) < BM ? (ce - pm * BM) : BM; u.ex = ex;
        u.B = B + ex * b_e + pn * b_pn;
        u.list = lists + (long)ex * list_stride + pm * BM;
        u.A = (gather || TILED) ? A : A + (long)u.r0 * a_row;
    }
    __device__ __forceinline__ bool next(int i, Unit& u) const {
        const long L0 = (long)i * G + c; if (L0 >= lim) return false;
        decode((int)L0, u); return true;
    }
};
using MoeSched = MoeSchedT<false>;
struct PieceSched {
    static constexpr bool TILED_A = true;
    MoeSchedT<true> S; int L0, R, P; long kbytesA, kbytes;
    __device__ __forceinline__ bool next(int i, Unit& u) const {
        if (i != 0 || S.c >= R * P) return false;
        const int q = S.c, j = q / P, p = q - j * P;
        S.decode(L0 + j, u); u.A += p * kbytesA; u.B += p * kbytes; u.ex = q; return true;
    }
};

template <class Epi, class Sched, bool GATHER, bool ALIGN_EPI>
__device__ __forceinline__ void gemm_phase(PG8_LAS unsigned char* lds, const int K, const int lda, const int ldb, const Sched& S, const Epi& E) {
    int tid_ = threadIdx.x; asm volatile("" : "+v"(tid_));
    const int tid = tid_, wid = __builtin_amdgcn_readfirstlane(tid >> 6), lane = tid & 63, wr = wid >> 2, wc = wid & 3, fr = lane & 15, fq = lane >> 4;
    int Kr_ = K; asm volatile("" : "+s"(Kr_));
    const int nt = Kr_ / BK;
    int RA[2], CA[2]; unsigned voffB[2];
#pragma unroll
    for (int i = 0; i < 2; ++i) { int R, C; stage_rc(tid * 16 + i * 8192, R, C); RA[i] = R; CA[i] = C; const int Rb = Epi::PERM ? ((R & ~31) + perm32(R & 31)) : R; voffB[i] = (unsigned)(Rb * ldb + C) * 2u; }
    const size_t kstep = (size_t)(BK * 2);
    const size_t kstepA = Sched::TILED_A ? (size_t)(256 * BK * 2) : kstep;
    const size_t hstep = (size_t)HALF * ldb * 2;
    const unsigned ldsw = (unsigned)wid * 1024u;
    const int aoff = lds_byte(wr * 64 + fr, fq * 8), boff = lds_byte(wc * 32 + fr, fq * 8);
#define PG8_SA(b, h) (((b) * 2 + (h)) * HTB)
#define PG8_SB(b, h) ((4 + (b) * 2 + (h)) * HTB)
#define PG8_STAGE(bufoff, gbase, voff) do { _Pragma("unroll") for (int _i = 0; _i < 2; ++_i) \
        __builtin_amdgcn_global_load_lds((const unsigned*)((const char*)(gbase) + (voff)[_i]), (PG8_LAS unsigned*)(lds + (bufoff) + ldsw + _i * 8192), 16, 0, 0); } while (0)
#define PG8_SETOFF(v, u) do { _Pragma("unroll") for (int _h = 0; _h < 2; ++_h) _Pragma("unroll") for (int _i = 0; _i < 2; ++_i) { const int _r = _h * HALF + RA[_i]; \
        if constexpr (GATHER) { const int _rr = _r < (u).nvalid ? _r : (u).nvalid - 1; v[_h][_i] = (unsigned)(u).list[_rr] * (unsigned)(lda * 2) + (unsigned)(CA[_i] * 2); } \
        else if constexpr (Sched::TILED_A) { v[_h][_i] = PG8_TOFF((u).r0 + _r) + (unsigned)(CA[_i] * 2); } \
        else { v[_h][_i] = (unsigned)(_r * lda + CA[_i]) * 2u; } } } while (0)
#define PG8_TOFF(row) (((unsigned)((((row) >> 8) * (lda / BK)) << 8) + (unsigned)((row) & 255)) * 128u)
#define PG8_LDA(dst, b, h) do { _Pragma("unroll") for (int m = 0; m < 4; ++m) _Pragma("unroll") for (int k = 0; k < 2; ++k) dst[m][k] = *(const PG8_LAS bf16x8*)(lds + PG8_SA(b, h) + aoff + m * 2048 + k * 1024); } while (0)
#define PG8_LDB(dst, b, h) do { _Pragma("unroll") for (int n = 0; n < 2; ++n) _Pragma("unroll") for (int k = 0; k < 2; ++k) dst[n][k] = *(const PG8_LAS bf16x8*)(lds + PG8_SB(b, h) + boff + n * 2048 + k * 1024); } while (0)
#define PG8_MMA(ai, bj, At, Bt) do { __builtin_amdgcn_s_setprio(1); _Pragma("unroll") for (int m = 0; m < 4; ++m) _Pragma("unroll") for (int n = 0; n < 2; ++n) _Pragma("unroll") for (int k = 0; k < 2; ++k) \
        acc[ai][bj][m][n] = __builtin_amdgcn_mfma_f32_16x16x32_bf16(Bt[n][k], At[m][k], acc[ai][bj][m][n], 0, 0, 0); __builtin_amdgcn_s_setprio(0); } while (0)
#define PG8_WAIT_V(n) asm volatile("s_waitcnt vmcnt(" #n ")" ::: "memory")
#define PG8_WAIT_L(n) asm volatile("s_waitcnt lgkmcnt(" #n ")" ::: "memory")
#define PG8_BAR __builtin_amdgcn_s_barrier()
#define PG8_SCHED __builtin_amdgcn_sched_barrier(0)
    Unit cur, nxt; int ui = 0;
    if (!S.next(0, cur)) return;
    unsigned va[2][2], vn[2][2];
    PG8_SETOFF(va, cur);
    Pre pre; E.prefetch(cur, wr, fr, pre);
#pragma unroll
    for (int h = 0; h < 2; ++h)
#pragma unroll
        for (int i = 0; i < 2; ++i) vn[h][i] = va[h][i];
    f32x4 acc[2][2][4][2];
#pragma unroll
    for (int a = 0; a < 2; ++a)
#pragma unroll
        for (int b = 0; b < 2; ++b)
#pragma unroll
            for (int m = 0; m < 4; ++m)
#pragma unroll
                for (int n = 0; n < 2; ++n) acc[a][b][m][n] = (f32x4){0.f, 0.f, 0.f, 0.f};
    bf16x8 At[4][2], B0[2][2], B1[2][2];
    const char* cA = cur.A; const char* cB = cur.B;
    PG8_STAGE(PG8_SB(0, 0), cB, voffB); PG8_STAGE(PG8_SB(0, 1), cB + hstep, voffB); PG8_STAGE(PG8_SA(0, 0), cA, va[0]); PG8_STAGE(PG8_SA(0, 1), cA, va[1]);
    if (wr == 1) PG8_BAR;
    PG8_WAIT_V(2); PG8_BAR;
    PG8_STAGE(PG8_SB(1, 0), cB + kstep, voffB); PG8_STAGE(PG8_SA(1, 0), cA + kstepA, va[0]); PG8_STAGE(PG8_SB(1, 1), cB + hstep + kstep, voffB);
    PG8_WAIT_V(6); PG8_BAR;
    for (;;) {
        const bool has_next = S.next(ui + 1, nxt);
        if constexpr (GATHER) { if (has_next) {
#pragma unroll
            for (int h = 0; h < 2; ++h)
#pragma unroll
                for (int i = 0; i < 2; ++i) { const int r_ = h * HALF + RA[i]; vn[h][i] = (unsigned)nxt.list[r_ < nxt.nvalid ? r_ : nxt.nvalid - 1]; } } }
        if constexpr (Sched::TILED_A) { if (has_next) {
#pragma unroll
            for (int h = 0; h < 2; ++h)
#pragma unroll
                for (int i = 0; i < 2; ++i) vn[h][i] = PG8_TOFF(nxt.r0 + h * HALF + RA[i]) + (unsigned)(CA[i] * 2); } }
        const char* nA = has_next ? nxt.A : cA; const char* nB = has_next ? nxt.B : cB;
        for (int t = 0; t < nt; t += 2) {
            const bool last = (t == nt - 2);
            const char* a1 = cA + (size_t)(t + 1) * kstepA;
            const char* a2 = last ? nA : cA + (size_t)(t + 2) * kstepA; const char* b2 = last ? nB : cB + (size_t)(t + 2) * kstep;
            const char* a3 = a2 + kstepA; const char* b3 = b2 + kstep;
            unsigned o2[2][2];
#pragma unroll
            for (int h = 0; h < 2; ++h)
#pragma unroll
                for (int i = 0; i < 2; ++i) { if constexpr (GATHER) o2[h][i] = (last && has_next) ? vn[h][i] * (unsigned)(lda * 2) + (unsigned)(CA[i] * 2) : va[h][i];
                    else if constexpr (Sched::TILED_A) o2[h][i] = (last && has_next) ? vn[h][i] : va[h][i]; else o2[h][i] = va[h][i]; }
            PG8_LDB(B0, 0, 0); PG8_LDB(B1, 0, 1); PG8_SCHED; PG8_LDA(At, 0, 0); PG8_STAGE(PG8_SA(1, 1), a1, va[1]);
            PG8_WAIT_V(8); PG8_WAIT_L(0); PG8_BAR; PG8_MMA(0, 0, At, B0); PG8_MMA(0, 1, At, B1); PG8_BAR; PG8_SCHED;
            PG8_LDA(At, 0, 1); PG8_STAGE(PG8_SB(0, 0), b2, voffB); PG8_STAGE(PG8_SB(0, 1), b2 + hstep, voffB); PG8_STAGE(PG8_SA(0, 0), a2, o2[0]);
            PG8_WAIT_V(8); PG8_WAIT_L(0); PG8_BAR; PG8_MMA(1, 0, At, B0); PG8_MMA(1, 1, At, B1); PG8_BAR; PG8_SCHED;
            PG8_LDB(B0, 1, 0); PG8_LDB(B1, 1, 1); PG8_SCHED; PG8_LDA(At, 1, 0); PG8_STAGE(PG8_SA(0, 1), a2, o2[1]);
            PG8_WAIT_V(8); PG8_WAIT_L(0); PG8_BAR; PG8_MMA(0, 0, At, B0); PG8_MMA(0, 1, At, B1); PG8_BAR; PG8_SCHED;
            PG8_LDA(At, 1, 1); PG8_STAGE(PG8_SB(1, 0), b3, voffB); PG8_STAGE(PG8_SB(1, 1), b3 + hstep, voffB); PG8_STAGE(PG8_SA(1, 0), a3, o2[0]);
            PG8_WAIT_V(8); PG8_WAIT_L(0); PG8_BAR; PG8_MMA(1, 0, At, B0); PG8_MMA(1, 1, At, B1); PG8_BAR; PG8_SCHED;
        }
        if constexpr (ALIGN_EPI) { if (wr == 0) PG8_BAR; }
        Pre pre2; if constexpr (Epi::PRE_EARLY) { if (has_next) E.prefetch(nxt, wr, fr, pre2); }
        E(acc, cur, wr, wc, fr, fq, pre);
        if (!has_next) break;
#pragma unroll
        for (int a = 0; a < 2; ++a)
#pragma unroll
            for (int b = 0; b < 2; ++b)
#pragma unroll
                for (int m = 0; m < 4; ++m)
#pragma unroll
                    for (int n = 0; n < 2; ++n) acc[a][b][m][n] = (f32x4){0.f, 0.f, 0.f, 0.f};
        const int pr0_ = cur.r0; cur = nxt; cA = nA; cB = nB; ++ui;
        if constexpr (Epi::PRE_EARLY) pre = pre2; else { if (cur.r0 != pr0_) E.prefetch(cur, wr, fr, pre); }
#pragma unroll
        for (int h = 0; h < 2; ++h)
#pragma unroll
            for (int i = 0; i < 2; ++i) { if constexpr (GATHER) va[h][i] = vn[h][i] * (unsigned)(lda * 2) + (unsigned)(CA[i] * 2); else va[h][i] = vn[h][i]; }
        if constexpr (ALIGN_EPI) { if (wr == 1) PG8_BAR; }
    }
    PG8_WAIT_V(0);
    if constexpr (!ALIGN_EPI) { if (wr == 0) PG8_BAR; }
    PG8_BAR;
#undef PG8_SA
#undef PG8_SB
#undef PG8_STAGE
#undef PG8_SETOFF
#undef PG8_TOFF
#undef PG8_LDA
#undef PG8_LDB
#undef PG8_MMA
#undef PG8_WAIT_V
#undef PG8_WAIT_L
#undef PG8_BAR
#undef PG8_SCHED
}
}
namespace pg8 {
constexpr float LOG2E = 1.4426950408889634f;
__device__ __forceinline__ float fast_sigmoid(float v) { return __builtin_amdgcn_rcpf(1.f + __builtin_amdgcn_exp2f(-v * LOG2E)); }
__device__ __forceinline__ f32x4 sig4(f32x4 v) { return (f32x4){fast_sigmoid(v[0]), fast_sigmoid(v[1]), fast_sigmoid(v[2]), fast_sigmoid(v[3])}; }
__device__ __forceinline__ u32x4 pack8(f32x4 a, f32x4 b) { u32x4 w; w.x = cvt_pk_bf16(a[0], a[1]); w.y = cvt_pk_bf16(a[2], a[3]); w.z = cvt_pk_bf16(b[0], b[1]); w.w = cvt_pk_bf16(b[2], b[3]); return w; }

struct EpiQKV {
    static constexpr bool PERM = true; static constexpr bool PRE_EARLY = false;
    bf16_t* Q; size_t split_stride  ; const float* qkn  ; const float* cosT; const float* sinT; float c2, eps;
    __device__ __forceinline__ void prefetch(const Unit&, int, int, Pre&) const {}
    __device__ __forceinline__ void operator()(const f32x4 (&acc)[2][2][4][2], const Unit& u, int wr, int wc, int fr, int fq, const Pre& pre) const {
        const int which = u.c0 >> 10, colt = u.c0 & 1023;
        bf16_t* base = Q + (size_t)which * split_stride;
        const int ocol = colt + 64 * wc + 8 * fq;
        if (which == 2) {
#pragma unroll
            for (int ai = 0; ai < 2; ++ai)
#pragma unroll
                for (int m = 0; m < 4; ++m) { bf16_t* rowp = base + (size_t)(u.r0 + ai * HALF + wr * 64 + m * 16 + fr) * 1024 + ocol;
#pragma unroll
                    for (int bj = 0; bj < 2; ++bj) *(u32x4*)(rowp + 32 * bj) = pack8(acc[ai][bj][m][0], acc[ai][bj][m][1]); }
        } else {
            const float* gp = qkn + 64 * which; const float sc = which == 0 ? c2 : 1.f;
            f32x4 g[2][2];
#pragma unroll
            for (int bj = 0; bj < 2; ++bj)
#pragma unroll
                for (int n = 0; n < 2; ++n) g[bj][n] = *(const f32x4*)(gp + 32 * bj + 8 * fq + 4 * n);
            const int rbase = u.r0 + wr * 64 + fr;
            f32x4 c[2], s[2];
#pragma unroll
            for (int n = 0; n < 2; ++n) { const int pos = rbase & 2047; c[n] = *(const f32x4*)(cosT + pos * 32 + 8 * fq + 4 * n); s[n] = *(const f32x4*)(sinT + pos * 32 + 8 * fq + 4 * n); }
#pragma unroll
            for (int ai = 0; ai < 2; ++ai)
#pragma unroll
                for (int m = 0; m < 4; ++m) {
                    const int row = rbase + ai * HALF + m * 16;
                    f32x4 cn[2], sn[2];
                    if (ai * 4 + m < 7) { const int rg = ai * 4 + m + 1, posn = (rbase + (rg >> 2) * HALF + (rg & 3) * 16) & 2047;
#pragma unroll
                        for (int n = 0; n < 2; ++n) { cn[n] = *(const f32x4*)(cosT + posn * 32 + 8 * fq + 4 * n); sn[n] = *(const f32x4*)(sinT + posn * 32 + 8 * fq + 4 * n); } }
                    float ss = 0.f;
#pragma unroll
                    for (int bj = 0; bj < 2; ++bj)
#pragma unroll
                        for (int n = 0; n < 2; ++n) { const f32x4 v = acc[ai][bj][m][n]; ss += (v[0] * v[0] + v[1] * v[1]) + (v[2] * v[2] + v[3] * v[3]); }
                    ss = sum_x32(sum_x16(ss));
                    const float rstd = __builtin_amdgcn_rsqf(ss * (1.f / 64.f) + eps);
                    f32x4 o0[2], o1[2];
#pragma unroll
                    for (int n = 0; n < 2; ++n) { const f32x4 y0 = acc[ai][0][m][n] * rstd * g[0][n], y1 = acc[ai][1][m][n] * rstd * g[1][n];
                        o0[n] = (y0 * c[n] - y1 * s[n]) * sc; o1[n] = (y1 * c[n] + y0 * s[n]) * sc; }
                    bf16_t* rowp = base + (size_t)row * 1024 + ocol;
                    *(u32x4*)(rowp) = pack8(o0[0], o0[1]); *(u32x4*)(rowp + 32) = pack8(o1[0], o1[1]);
                    if (ai * 4 + m < 7) {
#pragma unroll
                        for (int n = 0; n < 2; ++n) { c[n] = cn[n]; s[n] = sn[n]; } }
                }
        }
    }
};
__device__ __forceinline__ float row_rstd(const float* ssqp, int row, float eps) {
    const f32x4* p = (const f32x4*)(ssqp + (size_t)row * 16); const f32x4 a = p[0], b = p[1], c = p[2], d = p[3];
    const float s = (((a[0] + a[1]) + (a[2] + a[3])) + ((b[0] + b[1]) + (b[2] + b[3]))) + (((c[0] + c[1]) + (c[2] + c[3])) + ((d[0] + d[1]) + (d[2] + d[3])));
    return __builtin_amdgcn_rsqf(s * (1.f / 1024.f) + eps);
}
__device__ __forceinline__ f32x4 bf4(u32x2 w) { return (f32x4){bf_lo(w.x), bf_hi(w.x), bf_lo(w.y), bf_hi(w.y)}; }
template <bool BASE_BF16> struct EpiResNorm {
    static constexpr bool PERM = true; static constexpr bool PRE_EARLY = false;
    const void* base; bf16_t* hb; float* ssqp;
    __device__ __forceinline__ void prefetch(const Unit&, int, int, Pre&) const {}
    __device__ __forceinline__ void operator()(const f32x4 (&acc)[2][2][4][2], const Unit& u, int wr, int wc, int fr, int fq, const Pre& pre) const {
        const int col0 = u.c0 + wc * 32 + 8 * fq;
#pragma unroll
        for (int ai = 0; ai < 2; ++ai)
#pragma unroll
            for (int m = 0; m < 4; ++m) { const int row = u.r0 + ai * HALF + wr * 64 + m * 16 + fr; const size_t off = (size_t)row * 1024 + col0; float ss = 0.f;
#pragma unroll
                for (int bj = 0; bj < 2; ++bj) { const size_t o2 = off + bj * HALF;
                    f32x4 b0, b1;
                    if constexpr (BASE_BF16) { const u32x4 bw = *(const u32x4*)((const bf16_t*)base + o2); b0 = bf4((u32x2){bw.x, bw.y}); b1 = bf4((u32x2){bw.z, bw.w}); }
                    else { b0 = *(const f32x4*)((const float*)base + o2); b1 = *(const f32x4*)((const float*)base + o2 + 4); }
                    const u32x4 w = pack8(b0 + acc[ai][bj][m][0], b1 + acc[ai][bj][m][1]); *(u32x4*)(hb + o2) = w;
                    const f32x4 h0 = bf4((u32x2){w.x, w.y}), h1 = bf4((u32x2){w.z, w.w});
                    ss += ((h0[0] * h0[0] + h0[1] * h0[1]) + (h0[2] * h0[2] + h0[3] * h0[3])) + ((h1[0] * h1[0] + h1[1] * h1[1]) + (h1[2] * h1[2] + h1[3] * h1[3])); }
                ss = sum_x32(sum_x16(ss));
                if (fq == 0) ssqp[(size_t)row * 16 + (u.c0 >> 8) * 4 + wc] = ss; }
    }
};
template <int RS  > struct EpiSwiGLU {
    static constexpr bool PERM = true; static constexpr bool PRE_EARLY = (RS == 2);
    bf16_t* O; int ldo; float eps; const float* ssqp; const int* lists_base;
    __device__ __forceinline__ void prefetch(const Unit& u, int wr, int fr, Pre& pre) const {
#pragma unroll
        for (int ai = 0; ai < 2; ++ai)
#pragma unroll
            for (int m = 0; m < 4; ++m) { const int rl = ai * HALF + wr * 64 + m * 16 + fr;
                if constexpr (RS == 1) pre.rs[ai][m] = row_rstd(ssqp, u.r0 + rl, eps); else pre.rs[ai][m] = ssqp[(u.list - lists_base) + (rl < u.nvalid ? rl : u.nvalid - 1)]; }
    }
    __device__ __forceinline__ void operator()(const f32x4 (&acc)[2][2][4][2], const Unit& u, int wr, int wc, int fr, int fq, const Pre& pre) const {
        const int col0 = (u.c0 >> 1) + wc * 32 + 8 * fq;
#pragma unroll
        for (int ai = 0; ai < 2; ++ai)
#pragma unroll
            for (int m = 0; m < 4; ++m) { const int rl = ai * HALF + wr * 64 + m * 16 + fr;
                const float rs = pre.rs[ai][m];
                f32x4 o[2];
                const float c = -LOG2E * rs, q = __builtin_amdgcn_rcpf(rs * rs);
#pragma unroll
                for (int n = 0; n < 2; ++n) { const f32x4 g = acc[ai][0][m][n], up = acc[ai][1][m][n]; const f32x4 t = g * c;
                    const f32x4 ex = (f32x4){__builtin_amdgcn_exp2f(t[0]), __builtin_amdgcn_exp2f(t[1]), __builtin_amdgcn_exp2f(t[2]), __builtin_amdgcn_exp2f(t[3])};
                    const f32x4 a = ex * q + q;
                    const f32x4 r = (f32x4){__builtin_amdgcn_rcpf(a[0]), __builtin_amdgcn_rcpf(a[1]), __builtin_amdgcn_rcpf(a[2]), __builtin_amdgcn_rcpf(a[3])};
                    o[n] = (g * up) * r; }
                if (rl < u.nvalid) { size_t off;
                    if constexpr (RS == 2) { const int row = u.r0 + rl; off = ((size_t)((row >> 8) * (ldo >> 6) + (col0 >> 6)) * 256 + (row & 255)) * 64 + (col0 & 63); }
                    else off = (size_t)(u.r0 + rl) * ldo + col0;
                    *(u32x4*)(O + off) = pack8(o[0], o[1]); } }
    }
};
struct EpiProj {
    static constexpr bool PERM = true; static constexpr bool PRE_EARLY = false;
    bf16_t* P0; long dP;
    __device__ __forceinline__ void prefetch(const Unit&, int, int, Pre&) const {}
    __device__ __forceinline__ void operator()(const f32x4 (&acc)[2][2][4][2], const Unit& u, int wr, int wc, int fr, int fq, const Pre& pre) const {
        bf16_t* base = P0 + u.ex * dP; const int col0 = u.c0 + wc * 32 + 8 * fq;
#pragma unroll
        for (int ai = 0; ai < 2; ++ai)
#pragma unroll
            for (int m = 0; m < 4; ++m) { bf16_t* rowp = base + (size_t)(u.r0 + ai * HALF + wr * 64 + m * 16 + fr) * 1024 + col0;
#pragma unroll
                for (int bj = 0; bj < 2; ++bj) *(u32x4*)(rowp + bj * HALF) = pack8(acc[ai][bj][m][0], acc[ai][bj][m][1]); }
    }
};
template <int RS, bool OUT_F32> struct EpiPle {
    static constexpr bool PERM = true; static constexpr bool PRE_EARLY = false;
    const bf16_t* Hin; const bf16_t* P; void* out; const float* ssq_in; float* ssq_out; float eps; int pad;
    __device__ __forceinline__ void prefetch(const Unit& u, int wr, int fr, Pre& pre) const {
#pragma unroll
        for (int ai = 0; ai < 2; ++ai)
#pragma unroll
            for (int m = 0; m < 4; ++m) { const int row = u.r0 + ai * HALF + wr * 64 + m * 16 + fr;
                if constexpr (RS == 1) pre.rs[ai][m] = row_rstd(ssq_in, row, eps); else pre.rs[ai][m] = ssq_in[row]; }
    }
    __device__ __forceinline__ void operator()(const f32x4 (&acc)[2][2][4][2], const Unit& u, int wr, int wc, int fr, int fq, const Pre& pre) const {
        const int col0 = u.c0 + wc * 32 + 8 * fq;
#pragma unroll
        for (int ai = 0; ai < 2; ++ai)
#pragma unroll
            for (int m = 0; m < 4; ++m) { const int row = u.r0 + ai * HALF + wr * 64 + m * 16 + fr; const size_t off = (size_t)row * 1024 + col0; float ss = 0.f;
                const float rs = pre.rs[ai][m];
#pragma unroll
                for (int bj = 0; bj < 2; ++bj) { const size_t o2 = off + bj * HALF;
                    const u32x4 hw = *(const u32x4*)(Hin + o2), pw = *(const u32x4*)(P + o2);
                    const f32x4 h0 = bf4((u32x2){hw.x, hw.y}) + sig4(acc[ai][bj][m][0] * rs) * bf4((u32x2){pw.x, pw.y});
                    const f32x4 h1 = bf4((u32x2){hw.z, hw.w}) + sig4(acc[ai][bj][m][1] * rs) * bf4((u32x2){pw.z, pw.w});
                    if constexpr (OUT_F32) { *(f32x4*)((float*)out + o2) = h0; *(f32x4*)((float*)out + o2 + 4) = h1; }
                    else { const u32x4 w = pack8(h0, h1); *(u32x4*)((bf16_t*)out + o2) = w; const f32x4 r0 = bf4((u32x2){w.x, w.y}), r1 = bf4((u32x2){w.z, w.w});
                        ss += ((r0[0] * r0[0] + r0[1] * r0[1]) + (r0[2] * r0[2] + r0[3] * r0[3])) + ((r1[0] * r1[0] + r1[1] * r1[1]) + (r1[2] * r1[2] + r1[3] * r1[3])); } }
                if constexpr (!OUT_F32) { ss = sum_x32(sum_x16(ss)); if (fq == 0) ssq_out[(size_t)row * 16 + (u.c0 >> 8) * 4 + wc] = ss; } }
    }
};
struct EpiPool {
    static constexpr bool PERM = true; static constexpr bool PRE_EARLY = false;
    const bf16_t* HB; bf16_t* HBo; const float* bias; const float* scale;
    __device__ __forceinline__ void prefetch(const Unit&, int, int, Pre&) const {}
    __device__ __forceinline__ void operator()(const f32x4 (&acc)[2][2][4][2], const Unit& u, int wr, int wc, int fr, int fq, const Pre& pre) const {
        const int col0 = u.c0 + wc * 32 + 8 * fq;
#pragma unroll
        for (int bj = 0; bj < 2; ++bj) { const f32x4 bv0 = *(const f32x4*)(bias + col0 + bj * HALF), bv1 = *(const f32x4*)(bias + col0 + bj * HALF + 4), sv0 = *(const f32x4*)(scale + col0 + bj * HALF), sv1 = *(const f32x4*)(scale + col0 + bj * HALF + 4);
#pragma unroll
            for (int ai = 0; ai < 2; ++ai)
#pragma unroll
                for (int m = 0; m < 4; ++m) { const size_t o2 = (size_t)(u.r0 + ai * HALF + wr * 64 + m * 16 + fr) * 1024 + col0 + bj * HALF;
                    const u32x4 hw = *(const u32x4*)(HB + o2);
                    *(u32x4*)(HBo + o2) = pack8(bf4((u32x2){hw.x, hw.y}) + (acc[ai][bj][m][0] + bv0) * sv0, bf4((u32x2){hw.z, hw.w}) + (acc[ai][bj][m][1] + bv1) * sv1); } }
    }
};
struct EpiMoeDown {
    static constexpr bool PERM = true; static constexpr bool PRE_EARLY = true;
    bf16_t* Ys;
    __device__ __forceinline__ void prefetch(const Unit& u, int wr, int fr, Pre& pre) const { const float* gw = (const float*)u.list;
#pragma unroll
        for (int ai = 0; ai < 2; ++ai)
#pragma unroll
            for (int m = 0; m < 4; ++m) { const int rl = ai * HALF + wr * 64 + m * 16 + fr; pre.rs[ai][m] = gw[rl < u.nvalid ? rl : u.nvalid - 1]; }
    }
    __device__ __forceinline__ void operator()(const f32x4 (&acc)[2][2][4][2], const Unit& u, int wr, int wc, int fr, int fq, const Pre& pre) const {
        const int col0 = u.c0 + wc * 32 + 8 * fq;
#pragma unroll
        for (int ai = 0; ai < 2; ++ai)
#pragma unroll
            for (int m = 0; m < 4; ++m) { const int rl = ai * HALF + wr * 64 + m * 16 + fr;
                if (rl < u.nvalid) { const float g = pre.rs[ai][m]; bf16_t* rowp = Ys + (size_t)(u.r0 + rl) * 1024 + col0;
#pragma unroll
                    for (int bj = 0; bj < 2; ++bj) *(u32x4*)(rowp + bj * HALF) = pack8(acc[ai][bj][m][0] * g, acc[ai][bj][m][1] * g); } }
    }
};
struct EpiPart {
    static constexpr bool PERM = false; static constexpr bool PRE_EARLY = false;
    float* PART;
    __device__ __forceinline__ void prefetch(const Unit&, int, int, Pre&) const {}
    __device__ __forceinline__ void operator()(const f32x4 (&acc)[2][2][4][2], const Unit& u, int wr, int wc, int fr, int fq, const Pre& pre) const {
        float* base = PART + (size_t)u.ex * 65536 + wc * 32 + 4 * fq;
#pragma unroll
        for (int ai = 0; ai < 2; ++ai)
#pragma unroll
            for (int m = 0; m < 4; ++m) { float* rowp = base + (size_t)(ai * HALF + wr * 64 + m * 16 + fr) * 256;
#pragma unroll
                for (int bj = 0; bj < 2; ++bj)
#pragma unroll
                    for (int n = 0; n < 2; ++n) *(f32x4*)(rowp + bj * HALF + n * 16) = acc[ai][bj][m][n]; }
    }
};
}
#include <hip/hip_bf16.h>
#include <cmath>
namespace attn_body {
using bf16=__hip_bfloat16;
using bf16x8=__attribute__((ext_vector_type(8)))short;
using s16x4=__attribute__((ext_vector_type(4)))short;
using f32x16=__attribute__((ext_vector_type(16)))float;
using u32x4=__attribute__((ext_vector_type(4)))unsigned;
constexpr int BATCH=8,SEQ=2048,D=64,DM=1024;
constexpr int NW=8,QBLK=32,QB=QBLK*NW,KVBLK=64,NQB=SEQ/QB;
constexpr int ATTN_PITCH=DM, ATTN_UNIT_ROWS=QB;
__device__ __forceinline__ int crow(int r,int hi){return (r&3)+8*(r>>2)+4*hi;}
#define SBAR() __builtin_amdgcn_sched_barrier(0)
__device__ __forceinline__ void cmask(f32x16&p0,f32x16&p1,int jb,int qrel,int hi){
  const float NEG=-INFINITY; int kb=64*jb+4*hi;
  #pragma unroll
  for(int r=0;r<16;++r){int kv=kb+(r&3)+8*(r>>2); if(kv>qrel)p0[r]=NEG; if(kv+32>qrel)p1[r]=NEG;}
}

constexpr int NSLOT=3, SLOTB=8192;
constexpr int LDS_K=0, LDS_V=NSLOT*SLOTB, LDS_WS=2*NSLOT*SLOTB, LDS_OST=LDS_WS+NW*64*4, LDS_BYTES=LDS_OST+NW*4096;
constexpr float C2=0.125f*1.4426950408889634f;
__device__ __forceinline__ void glds16(const void*gsrc,unsigned lds_dst){unsigned keep;
  asm volatile("s_mov_b32 %0, m0\n\ts_mov_b32 m0, %2\n\ts_nop 0\n\tglobal_load_lds_dwordx4 %1, off\n\ts_mov_b32 m0, %0":"=&s"(keep):"v"(gsrc),"s"(lds_dst):"memory");}
__device__ __forceinline__ float max3f(float a,float b,float c){float r;asm("v_max3_f32 %0, %1, %2, %3":"=v"(r):"v"(a),"v"(b),"v"(c));return r;}
__device__ __forceinline__ float max2f(float a,float b){float r;asm("v_max_f32_e32 %0, %1, %2":"=v"(r):"v"(a),"v"(b));return r;}
__device__ __forceinline__ float fadd_s(float a,float b){float r;asm("v_add_f32_e32 %0, %1, %2":"=v"(r):"v"(a),"v"(b));return r;}
__device__ __forceinline__ float fsub_s(float a,float b){float r;asm("v_sub_f32_e32 %0, %1, %2":"=v"(r):"v"(a),"v"(b));return r;}
typedef float f32x2_t __attribute__((ext_vector_type(2))); typedef __bf16 bf16x2_t __attribute__((ext_vector_type(2)));
__device__ __forceinline__ unsigned cvtpk_s(float lo,float hi){f32x2_t v={lo,hi};bf16x2_t b=__builtin_convertvector(v,bf16x2_t);return __builtin_bit_cast(unsigned,b);}
#define WAIT_BAR(N) asm volatile("s_waitcnt vmcnt(" #N ") lgkmcnt(0)\n\ts_barrier":::"memory")

__device__ __forceinline__ void qkt(f32x16&p0,f32x16&p1,const char*Kslot,const bf16x8*qr,const f32x16&negm,int r32,int hi){
  const char*kb=Kslot+hi*1024+r32*16;
  #pragma unroll
  for(int d0=0;d0<4;++d0){
    const bf16x8 b0=*reinterpret_cast<const bf16x8*>(kb+d0*2048);
    const bf16x8 b1=*reinterpret_cast<const bf16x8*>(kb+d0*2048+512);
    if(d0==0){p0=__builtin_amdgcn_mfma_f32_32x32x16_bf16(b0,qr[0],negm,0,0,0);p1=__builtin_amdgcn_mfma_f32_32x32x16_bf16(b1,qr[0],negm,0,0,0);}
    else{p0=__builtin_amdgcn_mfma_f32_32x32x16_bf16(b0,qr[d0],p0,0,0,0);p1=__builtin_amdgcn_mfma_f32_32x32x16_bf16(b1,qr[d0],p1,0,0,0);}}
}
typedef __attribute__((address_space(3))) const char* lds_cptr;
typedef short v4i16_t __attribute__((ext_vector_type(4)));
__device__ __forceinline__ void kload8(bf16x8*kf,lds_cptr kp){
  kf[0]=*(const __attribute__((address_space(3))) bf16x8*)(kp);      kf[1]=*(const __attribute__((address_space(3))) bf16x8*)(kp+512);
  kf[2]=*(const __attribute__((address_space(3))) bf16x8*)(kp+2048); kf[3]=*(const __attribute__((address_space(3))) bf16x8*)(kp+2560);
  kf[4]=*(const __attribute__((address_space(3))) bf16x8*)(kp+4096); kf[5]=*(const __attribute__((address_space(3))) bf16x8*)(kp+4608);
  kf[6]=*(const __attribute__((address_space(3))) bf16x8*)(kp+6144); kf[7]=*(const __attribute__((address_space(3))) bf16x8*)(kp+6656);
}
__device__ __forceinline__ void kload2(bf16x8*kf,lds_cptr kp,int j){ kf[2*j]=*(const __attribute__((address_space(3))) bf16x8*)(kp+j*2048); kf[2*j+1]=*(const __attribute__((address_space(3))) bf16x8*)(kp+j*2048+512); }
__device__ __forceinline__ s16x4 vtr(lds_cptr p){ return __builtin_bit_cast(s16x4,__builtin_amdgcn_ds_read_tr16_b64_v4i16((__attribute__((address_space(3))) v4i16_t*)p)); }
__device__ __forceinline__ float rowmax(const f32x16&p0,const f32x16&p1){
  float a=max3f(p0[0],p0[1],p1[0]),b=max3f(p0[2],p0[3],p1[1]);a=max3f(a,p1[2],p1[3]);
  #pragma unroll
  for(int r=4;r<16;r+=4){a=max3f(a,p0[r],p0[r+1]);b=max3f(b,p0[r+2],p0[r+3]);a=max3f(a,p1[r],p1[r+1]);b=max3f(b,p1[r+2],p1[r+3]);}
  const float m=max2f(a,b);
  auto rr=__builtin_amdgcn_permlane32_swap(__float_as_uint(m),__float_as_uint(m),false,false);
  return max2f(__uint_as_float(rr[0]),__uint_as_float(rr[1]));
}
__device__ __forceinline__ void pv(f32x16*o,int vb,bf16x8 pa0,bf16x8 pa1,bf16x8 pa2,bf16x8 pa3){
  #pragma unroll
  for(int d0=0;d0<2;++d0){s16x4 lo[4],hi[4];
    #pragma unroll
    for(int ks=0;ks<4;++ks){
      asm volatile("ds_read_b64_tr_b16 %0,%1 offset:%c2":"=&v"(lo[ks]):"v"(vb),"i"(d0*4096+ks*1024):"memory");
      asm volatile("ds_read_b64_tr_b16 %0,%1 offset:%c2":"=&v"(hi[ks]):"v"(vb),"i"(d0*4096+ks*1024+512):"memory");}
    asm volatile("s_waitcnt lgkmcnt(0)":::"memory");SBAR();
    #define PK(k) (bf16x8){lo[k][0],lo[k][1],lo[k][2],lo[k][3],hi[k][0],hi[k][1],hi[k][2],hi[k][3]}
    o[d0]=__builtin_amdgcn_mfma_f32_32x32x16_bf16(pa0,PK(0),o[d0],0,0,0);
    o[d0]=__builtin_amdgcn_mfma_f32_32x32x16_bf16(pa1,PK(1),o[d0],0,0,0);
    o[d0]=__builtin_amdgcn_mfma_f32_32x32x16_bf16(pa2,PK(2),o[d0],0,0,0);
    o[d0]=__builtin_amdgcn_mfma_f32_32x32x16_bf16(pa3,PK(3),o[d0],0,0,0);
    #undef PK
  }
}

#ifndef ATTN_STORE16
#define ATTN_STORE16(p,v) (*(u32x4*)(p)=(v))
#endif
template<int THRL> __device__ __forceinline__ void attn_unit(int b,int qb,const bf16*Q,const bf16*__restrict__ K,const bf16*__restrict__ V,bf16*O,char*shm){
  int tid_=threadIdx.x; asm volatile("":"+v"(tid_));
  const int tid=tid_,lane=tid&63,r32=lane&31,hi=lane>>5; const int wid=__builtin_amdgcn_readfirstlane(tid>>6);
  const long rowbase=(long)b*SEQ; const int q0=qb*QB;
  const bf16*Qw=Q+(rowbase+q0+wid*QBLK)*DM;
  const bf16*Kh=K+rowbase*DM,*Vh=V+rowbase*DM;
  const unsigned lds0=(unsigned)(uintptr_t)shm;
  float*wsf=(float*)(shm+LDS_WS)+wid*64;
  const bf16*ksrc=Kh+(long)lane*DM+wid*8;
  const bf16*vsrc=Vh+(long)(16*(wid&3)+(lane>>2))*DM+(wid>>2)*32+(lane&3)*8;
  const unsigned kdst=lds0+LDS_K+wid*1024, vdst=lds0+LDS_V+wid*1024;
  #define DMA_K(t,slot) glds16(ksrc+(long)(t)*KVBLK*DM,(unsigned)__builtin_amdgcn_readfirstlane(kdst+(slot)))
  #define DMA_V(t,slot) glds16(vsrc+(long)(t)*KVBLK*DM,(unsigned)__builtin_amdgcn_readfirstlane(vdst+(slot)))
  const int vb0=(int)(lds0+LDS_V)+((lane>>4)&1)*32+(lane&3)*8+(4*hi+((lane&15)>>2))*64;
  const char*Kbase=shm+LDS_K; bf16x8 kf[8];
  const lds_cptr shm3=(lds_cptr)shm; const lds_cptr kp0=shm3+LDS_K+hi*1024+r32*16; const lds_cptr vp0=shm3+LDS_V+((lane>>4)&1)*32+(lane&3)*8+(4*hi+((lane&15)>>2))*64;
  const int NT=(q0+QB)/KVBLK;
  DMA_K(0,0);DMA_V(0,0);DMA_K(1,SLOTB);
  bf16x8 qr[4];
  #pragma unroll
  for(int d0=0;d0<4;++d0)qr[d0]=*reinterpret_cast<const bf16x8*>(&Qw[(long)r32*DM+d0*16+hi*8]);
  float zz_=0.f; asm volatile("":"+v"(zz_)); const f32x16 zv_={zz_,zz_,zz_,zz_,zz_,zz_,zz_,zz_,zz_,zz_,zz_,zz_,zz_,zz_,zz_,zz_};
  float mhat=zz_,l_reg=zz_;f32x16 o[2];o[0]=zv_;o[1]=zv_;f32x16 negm=zv_;asm volatile("":"+v"(negm));
  const int qrel=wid*QBLK+r32;
  #define CMASK(P0,P1,t) do{int jb_=(t)-(NT-4); if(jb_>=0)cmask(P0,P1,jb_,qrel,hi);}while(0)
  bool resc=false;
  #define START(P0,P1) do{ const float rm=rowmax(P0,P1); resc=false; \
    { const float dl=rm; mhat=fadd_s(mhat,dl); \
      _Pragma("unroll") for(int r=0;r<16;++r){P0[r]=fsub_s(P0[r],dl);P1[r]=fsub_s(P1[r],dl);} \
      _Pragma("unroll") for(int r=0;r<16;++r)negm[r]=-mhat; asm volatile("":"+v"(negm)); } \
    _Pragma("unroll") for(int r=0;r<16;++r)P0[r]=__builtin_amdgcn_exp2f(P0[r]); }while(0)
  #define RESC() do{ if(resc){ asm volatile("s_waitcnt lgkmcnt(0)":::"memory"); \
      _Pragma("unroll") for(int d_=0;d_<2;++d_) _Pragma("unroll") for(int r=0;r<16;++r)o[d_][r]*=wsf[crow(r,hi)]; } }while(0)
  f32x16 pA0,pA1,pB0,pB1;
  int sl_prev=0,sl_cur=0,sl_next=SLOTB;
  #define ROT() do{sl_prev=sl_cur;sl_cur=sl_next;sl_next=(sl_next==(NSLOT-1)*SLOTB)?0:sl_next+SLOTB;}while(0)
  DMA_K(2,2*SLOTB);
  WAIT_BAR(3);
  qkt(pA0,pA1,Kbase,qr,negm,r32,hi);asm volatile("s_nop 15\n\ts_nop 7":"+v"(pA0),"+v"(pA1));CMASK(pA0,pA1,0);
  START(pA0,pA1);
  _Pragma("unroll") for(int r=0;r<16;++r)pA1[r]=__builtin_amdgcn_exp2f(pA1[r]);
  WAIT_BAR(0);
  DMA_K(3,0);DMA_V(1,SLOTB);
  ROT();
  kload8(kf,kp0+sl_cur);
  WAIT_BAR(2);
  s16x4 vlo[8],vhi[8]; u32x4 pw0,pw1,pw2,pw3;
  #define PKW(P,B) cvtpk_s(P[B],P[B+1])
  #define PAF(k) __builtin_bit_cast(bf16x8,pw##k)
  #define VFR(i) (bf16x8){vlo[i][0],vlo[i][1],vlo[i][2],vlo[i][3],vhi[i][0],vhi[i][1],vhi[i][2],vhi[i][3]}
  #define PIN(x) asm volatile("":"+v"(x))
  #define MX3(a,b,c) __builtin_fmaxf(__builtin_fmaxf((a),(b)),(c))
  #define GAPA(MF,A0,A1,A2,A3,W0,W1,PW) do{ MF; sacc+=A0; sacc+=A1; sacc+=A2; sacc+=A3; PIN(sacc); W0; W1; PIN(PW); SBAR(); }while(0)
  #define EX(v) __builtin_amdgcn_exp2f(v)
  #define GAPB(MF,X,B) do{ MF; X[B]=EX(X[B]); X[B+1]=EX(X[B+1]); X[B+2]=EX(X[B+2]); X[B+3]=EX(X[B+3]); PIN(X); SBAR(); }while(0)
  #define VRD(i) do{ vlo[i]=vtr(vp_+(((i)>>2)*4096+((i)&3)*1024)); vhi[i]=vtr(vp_+(((i)>>2)*4096+((i)&3)*1024+512)); }while(0)
  #define KRD(G,j) do{ if(G){ kload2(kf,kp0+sl_next,j); SBAR(); } }while(0)
  #define STEP(C0,C1,P0,P1,t,GK,GV,GL) do{ SBAR(); \
    const lds_cptr vp_=vp0+sl_prev; \
    VRD(0); SBAR(); float sacc=(P0[0]+P0[1]); \
    GAPA(C0=__builtin_amdgcn_mfma_f32_32x32x16_bf16(kf[0],qr[0],negm,0,0,0), P0[2],P0[3],P0[4],P0[5],     pw0[0]=PKW(P0,0), pw0[1]=PKW(P0,2), pw0); \
    VRD(4); SBAR(); GAPA(C1=__builtin_amdgcn_mfma_f32_32x32x16_bf16(kf[1],qr[0],negm,0,0,0), P0[6],P0[7],P0[8],P0[9],     pw0[2]=PKW(P0,4), pw0[3]=PKW(P0,6), pw0); \
    VRD(1); SBAR(); GAPA(C0=__builtin_amdgcn_mfma_f32_32x32x16_bf16(kf[2],qr[1],C0,0,0,0),   P0[10],P0[11],P0[12],P0[13], pw1[0]=PKW(P0,8), pw1[1]=PKW(P0,10), pw1); \
    VRD(5); SBAR(); GAPA(C1=__builtin_amdgcn_mfma_f32_32x32x16_bf16(kf[3],qr[1],C1,0,0,0),   P0[14],P0[15],P1[0],P1[1],   pw1[2]=PKW(P0,12),pw1[3]=PKW(P0,14), pw1); \
    VRD(2); SBAR(); GAPA(C0=__builtin_amdgcn_mfma_f32_32x32x16_bf16(kf[4],qr[2],C0,0,0,0),   P1[2],P1[3],P1[4],P1[5],     pw2[0]=PKW(P1,0), pw2[1]=PKW(P1,2), pw2); \
    VRD(6); SBAR(); GAPA(C1=__builtin_amdgcn_mfma_f32_32x32x16_bf16(kf[5],qr[2],C1,0,0,0),   P1[6],P1[7],P1[8],P1[9],     pw2[2]=PKW(P1,4), pw2[3]=PKW(P1,6), pw2); \
    VRD(3); SBAR(); GAPA(C0=__builtin_amdgcn_mfma_f32_32x32x16_bf16(kf[6],qr[3],C0,0,0,0),   P1[10],P1[11],P1[12],P1[13], pw3[0]=PKW(P1,8), pw3[1]=PKW(P1,10), pw3); \
    VRD(7); SBAR(); GAPA(C1=__builtin_amdgcn_mfma_f32_32x32x16_bf16(kf[7],qr[3],C1,0,0,0),   P1[14],P1[15],0.f,0.f,       pw3[2]=PKW(P1,12),pw3[3]=PKW(P1,14), pw3); \
    l_reg+=sacc; \
    if(GK){DMA_K((t)+3,sl_cur);} if(GV){DMA_V((t)+1,sl_next);} \
    CMASK(C0,C1,t); \
    { float a=MX3(C0[0],C0[1],C1[0]),b=MX3(C0[2],C0[3],C1[1]); a=MX3(a,C1[2],C1[3]); \
      _Pragma("unroll") for(int r=4;r<16;r+=4){a=MX3(a,C0[r],C0[r+1]);b=MX3(b,C0[r+2],C0[r+3]);a=MX3(a,C1[r],C1[r+1]);b=MX3(b,C1[r+2],C1[r+3]);} \
      float rm=__builtin_fmaxf(a,b); { auto rr=__builtin_amdgcn_permlane32_swap(__float_as_uint(rm),__float_as_uint(rm),false,false); rm=__builtin_fmaxf(__uint_as_float(rr[0]),__uint_as_float(rr[1])); } \
      resc=false; \
      if(__builtin_expect(__any(rm>(float)THRL),0)){ const float dl=__builtin_fmaxf(rm,0.f); mhat+=dl; \
        _Pragma("unroll") for(int r=0;r<16;++r){C0[r]-=dl;C1[r]-=dl;} \
        _Pragma("unroll") for(int r=0;r<16;++r)negm[r]=-mhat; asm volatile("":"+v"(negm)); \
        const float f=__builtin_amdgcn_exp2f(-dl); l_reg*=f; if(hi==0)wsf[r32]=f; resc=true; } } \
    SBAR(); \
    GAPB(o[0]=__builtin_amdgcn_mfma_f32_32x32x16_bf16(PAF(0),VFR(0),o[0],0,0,0), C0,0); \
    GAPB(o[1]=__builtin_amdgcn_mfma_f32_32x32x16_bf16(PAF(0),VFR(4),o[1],0,0,0), C0,4); \
    KRD(GL,0); GAPB(o[0]=__builtin_amdgcn_mfma_f32_32x32x16_bf16(PAF(1),VFR(1),o[0],0,0,0), C0,8); \
    KRD(GL,1); GAPB(o[1]=__builtin_amdgcn_mfma_f32_32x32x16_bf16(PAF(1),VFR(5),o[1],0,0,0), C0,12); \
    KRD(GL,2); GAPB(o[0]=__builtin_amdgcn_mfma_f32_32x32x16_bf16(PAF(2),VFR(2),o[0],0,0,0), C1,0); \
    KRD(GL,3); GAPB(o[1]=__builtin_amdgcn_mfma_f32_32x32x16_bf16(PAF(2),VFR(6),o[1],0,0,0), C1,4); \
    GAPB(o[0]=__builtin_amdgcn_mfma_f32_32x32x16_bf16(PAF(3),VFR(3),o[0],0,0,0), C1,8); \
    GAPB(o[1]=__builtin_amdgcn_mfma_f32_32x32x16_bf16(PAF(3),VFR(7),o[1],0,0,0), C1,12); \
    }while(0)
  int t=1;
  #undef CMASK
  #define CMASK(P0,P1,t) do{}while(0)
  for(;t+5<NT;t+=2){
    STEP(pB0,pB1,pA0,pA1,t,true,true,true);     WAIT_BAR(2); RESC(); ROT();
    STEP(pA0,pA1,pB0,pB1,t+1,true,true,true);   WAIT_BAR(2); RESC(); ROT();
  }
  #undef CMASK
  #define CMASK(P0,P1,t) do{int jb_=(t)-(NT-4); if(jb_>=0)cmask(P0,P1,jb_,qrel,hi);}while(0)
  #define ENDW(tt) do{ if((tt)+3<NT){WAIT_BAR(2);} else if((tt)+2<NT){WAIT_BAR(1);} else {WAIT_BAR(0);} }while(0)
  for(;t+1<NT;t+=2){
    STEP(pB0,pB1,pA0,pA1,t,(t+3<NT),(t+1<NT),(t+1<NT));       ENDW(t);   RESC(); ROT();
    STEP(pA0,pA1,pB0,pB1,t+1,(t+4<NT),(t+2<NT),(t+2<NT));     ENDW(t+1); RESC(); ROT();
  }
  STEP(pB0,pB1,pA0,pA1,NT-1,false,false,false); RESC();
  { float sacc=pB0[0]+pB0[1]; _Pragma("unroll") for(int r=2;r<16;++r)sacc+=pB0[r]; _Pragma("unroll") for(int r=0;r<16;++r)sacc+=pB1[r]; l_reg+=sacc;
    pw0=(u32x4){PKW(pB0,0),PKW(pB0,2),PKW(pB0,4),PKW(pB0,6)};pw1=(u32x4){PKW(pB0,8),PKW(pB0,10),PKW(pB0,12),PKW(pB0,14)};pw2=(u32x4){PKW(pB1,0),PKW(pB1,2),PKW(pB1,4),PKW(pB1,6)};pw3=(u32x4){PKW(pB1,8),PKW(pB1,10),PKW(pB1,12),PKW(pB1,14)};
    SBAR(); pv(o,vb0+sl_cur,PAF(0),PAF(1),PAF(2),PAF(3)); }
  #undef PKW
  #undef PAF
  #undef VFR
  #undef PIN
  #undef MX3
  #undef GAPA
  #undef GAPB
  #undef EX
  #undef VRD
  #undef KRD
  #undef STEP
  #undef ENDW
  {auto rr=__builtin_amdgcn_permlane32_swap(__float_as_uint(l_reg),__float_as_uint(l_reg),false,false);l_reg=__uint_as_float(rr[0])+__uint_as_float(rr[1]);}
  if(hi==0)wsf[32+r32]=l_reg;asm volatile("s_waitcnt lgkmcnt(0)":::"memory");
  float rli[16];
  #pragma unroll
  for(int r=0;r<16;++r)rli[r]=__builtin_amdgcn_rcpf(wsf[32+crow(r,hi)]);
  bf16*Ow=O+(rowbase+q0+wid*QBLK)*DM;
  { bf16*stg=(bf16*)(shm+LDS_OST)+wid*2048;
    #pragma unroll
    for(int r=0;r<16;++r){const int orow=crow(r,hi);
      #pragma unroll
      for(int d0=0;d0<2;++d0)stg[orow*64+d0*32+r32]=__float2bfloat16(o[d0][r]*rli[r]);}
    asm volatile("s_waitcnt lgkmcnt(0)":::"memory");
    #pragma unroll
    for(int i=0;i<4;++i){const int row=i*8+(lane>>3),ch=lane&7; const u32x4 v=*(const u32x4*)(stg+row*64+ch*8); ATTN_STORE16(Ow+(long)row*DM+ch*8,v);} }
  asm volatile("s_waitcnt lgkmcnt(0)\n\ts_barrier":::"memory");
  #undef DMA_K
  #undef DMA_V
  #undef CMASK
  #undef START
  #undef RESC
  #undef ROT
}
__device__ __forceinline__ void pv4(f32x16*o,int vb,bf16x8 pa0,bf16x8 pa1,bf16x8 pa2,bf16x8 pa3){
  #pragma unroll
  for(int d0=0;d0<4;++d0){s16x4 lo[4],hi[4];
    #pragma unroll
    for(int ks=0;ks<4;++ks){
      asm volatile("ds_read_b64_tr_b16 %0,%1 offset:%c2":"=&v"(lo[ks]):"v"(vb),"i"(d0*4096+ks*1024):"memory");
      asm volatile("ds_read_b64_tr_b16 %0,%1 offset:%c2":"=&v"(hi[ks]):"v"(vb),"i"(d0*4096+ks*1024+512):"memory");}
    asm volatile("s_waitcnt lgkmcnt(0)":::"memory");SBAR();
    #define PK(k) (bf16x8){lo[k][0],lo[k][1],lo[k][2],lo[k][3],hi[k][0],hi[k][1],hi[k][2],hi[k][3]}
    o[d0]=__builtin_amdgcn_mfma_f32_32x32x16_bf16(pa0,PK(0),o[d0],0,0,0);
    o[d0]=__builtin_amdgcn_mfma_f32_32x32x16_bf16(pa1,PK(1),o[d0],0,0,0);
    o[d0]=__builtin_amdgcn_mfma_f32_32x32x16_bf16(pa2,PK(2),o[d0],0,0,0);
    o[d0]=__builtin_amdgcn_mfma_f32_32x32x16_bf16(pa3,PK(3),o[d0],0,0,0);
    #undef PK
  }
}

template<int THRL,bool FUSE> __device__ __forceinline__ void attn_unit128(int b,int qb,const bf16*Q,const bf16*__restrict__ K,const bf16*__restrict__ V,bf16*O,char*shm,bf16*ON=nullptr,const float*subg=nullptr,float lam=0.f,float oscale=1.f,float eps=0.f){
  int tid_=threadIdx.x; asm volatile("":"+v"(tid_));
  const int tid=tid_,lane=tid&63,r32=lane&31,hi=lane>>5; const int wid=__builtin_amdgcn_readfirstlane(tid>>6);
  const long rowbase=(long)b*SEQ; const int q0=qb*QB;
  const bf16*Qw=Q+(rowbase+q0+wid*QBLK)*DM;
  const bf16*Kh=K+rowbase*DM,*Vh=V+rowbase*DM;
  const unsigned lds0=(unsigned)(uintptr_t)shm;
  constexpr int LDS_V2=NSLOT*SLOTB, VSLOT=2*SLOTB, LDS_WS2=LDS_V2+NSLOT*VSLOT, LDS_OST2=LDS_WS2+NW*64*4;
  float*wsf=(float*)(shm+LDS_WS2)+wid*64;
  const bf16*ksrc=Kh+(long)lane*DM+wid*8;
  const bf16*vsrc=Vh+(long)(16*(wid&3)+(lane>>2))*DM+(wid>>2)*32+(lane&3)*8;
  const unsigned kdst=lds0+LDS_K+wid*1024, vdst=lds0+LDS_V2+wid*1024;
  #define DMA_K(t,slot) glds16(ksrc+(long)(t)*KVBLK*DM,(unsigned)__builtin_amdgcn_readfirstlane(kdst+(slot)))
  #define DMA_V(t,slot) do{ glds16(vsrc+(long)(t)*KVBLK*DM,(unsigned)__builtin_amdgcn_readfirstlane(vdst+2*(slot))); glds16(vsrc+(long)(t)*KVBLK*DM+64,(unsigned)__builtin_amdgcn_readfirstlane(vdst+2*(slot)+8192)); }while(0)
  const int vb0=(int)(lds0+LDS_V2)+((lane>>4)&1)*32+(lane&3)*8+(4*hi+((lane&15)>>2))*64;
  const char*Kbase=shm+LDS_K; bf16x8 kf[8];
  const lds_cptr shm3=(lds_cptr)shm; const lds_cptr kp0=shm3+LDS_K+hi*1024+r32*16; const lds_cptr vp0=shm3+LDS_V2+((lane>>4)&1)*32+(lane&3)*8+(4*hi+((lane&15)>>2))*64;
  const int NT=(q0+QB)/KVBLK;
  DMA_K(0,0);DMA_V(0,0);DMA_K(1,SLOTB);
  bf16x8 qr[4];
  #pragma unroll
  for(int d0=0;d0<4;++d0)qr[d0]=*reinterpret_cast<const bf16x8*>(&Qw[(long)r32*DM+d0*16+hi*8]);
  float zz_=0.f; asm volatile("":"+v"(zz_)); const f32x16 zv_={zz_,zz_,zz_,zz_,zz_,zz_,zz_,zz_,zz_,zz_,zz_,zz_,zz_,zz_,zz_,zz_};
  float mhat=zz_,l_reg=zz_;f32x16 o[4];o[0]=zv_;o[1]=zv_;o[2]=zv_;o[3]=zv_;f32x16 negm=zv_;asm volatile("":"+v"(negm));
  const int qrel=wid*QBLK+r32;
  #define CMASK(P0,P1,t) do{int jb_=(t)-(NT-4); if(jb_>=0)cmask(P0,P1,jb_,qrel,hi);}while(0)
  bool resc=false;
  #define START(P0,P1) do{ const float rm=rowmax(P0,P1); resc=false; \
    { const float dl=rm; mhat=fadd_s(mhat,dl); \
      _Pragma("unroll") for(int r=0;r<16;++r){P0[r]=fsub_s(P0[r],dl);P1[r]=fsub_s(P1[r],dl);} \
      _Pragma("unroll") for(int r=0;r<16;++r)negm[r]=-mhat; asm volatile("":"+v"(negm)); } \
    _Pragma("unroll") for(int r=0;r<16;++r)P0[r]=__builtin_amdgcn_exp2f(P0[r]); }while(0)
  #define RESC() do{ if(resc){ asm volatile("s_waitcnt lgkmcnt(0)":::"memory"); \
      _Pragma("unroll") for(int d_=0;d_<4;++d_) _Pragma("unroll") for(int r=0;r<16;++r)o[d_][r]*=wsf[crow(r,hi)]; } }while(0)
  f32x16 pA0,pA1,pB0,pB1;
  int sl_prev=0,sl_cur=0,sl_next=SLOTB;
  #define ROT() do{sl_prev=sl_cur;sl_cur=sl_next;sl_next=(sl_next==(NSLOT-1)*SLOTB)?0:sl_next+SLOTB;}while(0)
  DMA_K(2,2*SLOTB);
  WAIT_BAR(4);
  qkt(pA0,pA1,Kbase,qr,negm,r32,hi);asm volatile("s_nop 15\n\ts_nop 7":"+v"(pA0),"+v"(pA1));CMASK(pA0,pA1,0);
  START(pA0,pA1);
  _Pragma("unroll") for(int r=0;r<16;++r)pA1[r]=__builtin_amdgcn_exp2f(pA1[r]);
  WAIT_BAR(0);
  DMA_K(3,0);DMA_V(1,SLOTB);
  ROT();
  kload8(kf,kp0+sl_cur);
  WAIT_BAR(3);
  s16x4 vlo[8],vhi[8]; u32x4 pw0,pw1,pw2,pw3;
  #define PKW(P,B) cvtpk_s(P[B],P[B+1])
  #define PAF(k) __builtin_bit_cast(bf16x8,pw##k)
  #define VFR(s) (bf16x8){vlo[s][0],vlo[s][1],vlo[s][2],vlo[s][3],vhi[s][0],vhi[s][1],vhi[s][2],vhi[s][3]}
  #define PIN(x) asm volatile("":"+v"(x))
  #define MX3(a,b,c) __builtin_fmaxf(__builtin_fmaxf((a),(b)),(c))
  #define GAPA(MF,A0,A1,A2,A3,W0,W1,PW) do{ MF; sacc+=A0; sacc+=A1; sacc+=A2; sacc+=A3; PIN(sacc); W0; W1; PIN(PW); SBAR(); }while(0)
  #define EX(v) __builtin_amdgcn_exp2f(v)
  #define GAPB(MF,X,B) do{ MF; X[B]=EX(X[B]); X[B+1]=EX(X[B+1]); PIN(X); SBAR(); }while(0)
  #define VRD(s,f) do{ vlo[s]=vtr(vp_+(((f)>>2)*4096+((f)&3)*1024)); vhi[s]=vtr(vp_+(((f)>>2)*4096+((f)&3)*1024+512)); }while(0)
  #define KRD(G,j) do{ if(G){ kload2(kf,kp0+sl_next,j); SBAR(); } }while(0)
  #define STEP(C0,C1,P0,P1,t,GK,GV,GL) do{ SBAR(); \
    const lds_cptr vp_=vp0+2*sl_prev; \
    VRD(0,0); SBAR(); float sacc=(P0[0]+P0[1]); \
    GAPA(C0=__builtin_amdgcn_mfma_f32_32x32x16_bf16(kf[0],qr[0],negm,0,0,0), P0[2],P0[3],P0[4],P0[5],     pw0[0]=PKW(P0,0), pw0[1]=PKW(P0,2), pw0); \
    VRD(1,4); SBAR(); GAPA(C1=__builtin_amdgcn_mfma_f32_32x32x16_bf16(kf[1],qr[0],negm,0,0,0), P0[6],P0[7],P0[8],P0[9],     pw0[2]=PKW(P0,4), pw0[3]=PKW(P0,6), pw0); \
    VRD(2,8); SBAR(); GAPA(C0=__builtin_amdgcn_mfma_f32_32x32x16_bf16(kf[2],qr[1],C0,0,0,0),   P0[10],P0[11],P0[12],P0[13], pw1[0]=PKW(P0,8), pw1[1]=PKW(P0,10), pw1); \
    VRD(3,12); SBAR(); GAPA(C1=__builtin_amdgcn_mfma_f32_32x32x16_bf16(kf[3],qr[1],C1,0,0,0),   P0[14],P0[15],P1[0],P1[1],   pw1[2]=PKW(P0,12),pw1[3]=PKW(P0,14), pw1); \
    VRD(4,1); SBAR(); GAPA(C0=__builtin_amdgcn_mfma_f32_32x32x16_bf16(kf[4],qr[2],C0,0,0,0),   P1[2],P1[3],P1[4],P1[5],     pw2[0]=PKW(P1,0), pw2[1]=PKW(P1,2), pw2); \
    VRD(5,5); SBAR(); GAPA(C1=__builtin_amdgcn_mfma_f32_32x32x16_bf16(kf[5],qr[2],C1,0,0,0),   P1[6],P1[7],P1[8],P1[9],     pw2[2]=PKW(P1,4), pw2[3]=PKW(P1,6), pw2); \
    VRD(6,9); SBAR(); GAPA(C0=__builtin_amdgcn_mfma_f32_32x32x16_bf16(kf[6],qr[3],C0,0,0,0),   P1[10],P1[11],P1[12],P1[13], pw3[0]=PKW(P1,8), pw3[1]=PKW(P1,10), pw3); \
    VRD(7,13); SBAR(); GAPA(C1=__builtin_amdgcn_mfma_f32_32x32x16_bf16(kf[7],qr[3],C1,0,0,0),   P1[14],P1[15],0.f,0.f,       pw3[2]=PKW(P1,12),pw3[3]=PKW(P1,14), pw3); \
    l_reg+=sacc; \
    if(GK){DMA_K((t)+3,sl_cur);} if(GV){DMA_V((t)+1,sl_next);} \
    CMASK(C0,C1,t); \
    { float a=MX3(C0[0],C0[1],C1[0]),b=MX3(C0[2],C0[3],C1[1]); a=MX3(a,C1[2],C1[3]); \
      _Pragma("unroll") for(int r=4;r<16;r+=4){a=MX3(a,C0[r],C0[r+1]);b=MX3(b,C0[r+2],C0[r+3]);a=MX3(a,C1[r],C1[r+1]);b=MX3(b,C1[r+2],C1[r+3]);} \
      float rm=__builtin_fmaxf(a,b); { auto rr=__builtin_amdgcn_permlane32_swap(__float_as_uint(rm),__float_as_uint(rm),false,false); rm=__builtin_fmaxf(__uint_as_float(rr[0]),__uint_as_float(rr[1])); } \
      resc=false; \
      if(__builtin_expect(__any(rm>(float)THRL),0)){ const float dl=__builtin_fmaxf(rm,0.f); mhat+=dl; \
        _Pragma("unroll") for(int r=0;r<16;++r){C0[r]-=dl;C1[r]-=dl;} \
        _Pragma("unroll") for(int r=0;r<16;++r)negm[r]=-mhat; asm volatile("":"+v"(negm)); \
        const float f=__builtin_amdgcn_exp2f(-dl); l_reg*=f; if(hi==0)wsf[r32]=f; resc=true; } } \
    SBAR(); \
    GAPB(o[0]=__builtin_amdgcn_mfma_f32_32x32x16_bf16(PAF(0),VFR(0),o[0],0,0,0), C0,0); VRD(0,2); SBAR(); \
    GAPB(o[1]=__builtin_amdgcn_mfma_f32_32x32x16_bf16(PAF(0),VFR(1),o[1],0,0,0), C0,2); VRD(1,6); SBAR(); \
    GAPB(o[2]=__builtin_amdgcn_mfma_f32_32x32x16_bf16(PAF(0),VFR(2),o[2],0,0,0), C0,4); VRD(2,10); SBAR(); \
    GAPB(o[3]=__builtin_amdgcn_mfma_f32_32x32x16_bf16(PAF(0),VFR(3),o[3],0,0,0), C0,6); VRD(3,14); SBAR(); \
    GAPB(o[0]=__builtin_amdgcn_mfma_f32_32x32x16_bf16(PAF(1),VFR(4),o[0],0,0,0), C0,8); VRD(4,3); SBAR(); \
    GAPB(o[1]=__builtin_amdgcn_mfma_f32_32x32x16_bf16(PAF(1),VFR(5),o[1],0,0,0), C0,10); VRD(5,7); SBAR(); \
    GAPB(o[2]=__builtin_amdgcn_mfma_f32_32x32x16_bf16(PAF(1),VFR(6),o[2],0,0,0), C0,12); VRD(6,11); SBAR(); \
    GAPB(o[3]=__builtin_amdgcn_mfma_f32_32x32x16_bf16(PAF(1),VFR(7),o[3],0,0,0), C0,14); VRD(7,15); SBAR(); \
    KRD(GL,0); GAPB(o[0]=__builtin_amdgcn_mfma_f32_32x32x16_bf16(PAF(2),VFR(0),o[0],0,0,0), C1,0); \
    KRD(GL,1); GAPB(o[1]=__builtin_amdgcn_mfma_f32_32x32x16_bf16(PAF(2),VFR(1),o[1],0,0,0), C1,2); \
    KRD(GL,2); GAPB(o[2]=__builtin_amdgcn_mfma_f32_32x32x16_bf16(PAF(2),VFR(2),o[2],0,0,0), C1,4); \
    KRD(GL,3); GAPB(o[3]=__builtin_amdgcn_mfma_f32_32x32x16_bf16(PAF(2),VFR(3),o[3],0,0,0), C1,6); \
    GAPB(o[0]=__builtin_amdgcn_mfma_f32_32x32x16_bf16(PAF(3),VFR(4),o[0],0,0,0), C1,8); \
    GAPB(o[1]=__builtin_amdgcn_mfma_f32_32x32x16_bf16(PAF(3),VFR(5),o[1],0,0,0), C1,10); \
    GAPB(o[2]=__builtin_amdgcn_mfma_f32_32x32x16_bf16(PAF(3),VFR(6),o[2],0,0,0), C1,12); \
    GAPB(o[3]=__builtin_amdgcn_mfma_f32_32x32x16_bf16(PAF(3),VFR(7),o[3],0,0,0), C1,14); \
    }while(0)
  int t=1;
  #undef CMASK
  #define CMASK(P0,P1,t) do{}while(0)
  for(;t+5<NT;t+=2){
    STEP(pB0,pB1,pA0,pA1,t,true,true,true);     WAIT_BAR(3); RESC(); ROT();
    STEP(pA0,pA1,pB0,pB1,t+1,true,true,true);   WAIT_BAR(3); RESC(); ROT();
  }
  #undef CMASK
  #define CMASK(P0,P1,t) do{int jb_=(t)-(NT-4); if(jb_>=0)cmask(P0,P1,jb_,qrel,hi);}while(0)
  #define ENDW(tt) do{ if((tt)+3<NT){WAIT_BAR(3);} else if((tt)+2<NT){WAIT_BAR(2);} else {WAIT_BAR(0);} }while(0)
  for(;t+1<NT;t+=2){
    STEP(pB0,pB1,pA0,pA1,t,(t+3<NT),(t+1<NT),(t+1<NT));       ENDW(t);   RESC(); ROT();
    STEP(pA0,pA1,pB0,pB1,t+1,(t+4<NT),(t+2<NT),(t+2<NT));     ENDW(t+1); RESC(); ROT();
  }
  STEP(pB0,pB1,pA0,pA1,NT-1,false,false,false); RESC();
  { float sacc=pB0[0]+pB0[1]; _Pragma("unroll") for(int r=2;r<16;++r)sacc+=pB0[r]; _Pragma("unroll") for(int r=0;r<16;++r)sacc+=pB1[r]; l_reg+=sacc;
    pw0=(u32x4){PKW(pB0,0),PKW(pB0,2),PKW(pB0,4),PKW(pB0,6)};pw1=(u32x4){PKW(pB0,8),PKW(pB0,10),PKW(pB0,12),PKW(pB0,14)};pw2=(u32x4){PKW(pB1,0),PKW(pB1,2),PKW(pB1,4),PKW(pB1,6)};pw3=(u32x4){PKW(pB1,8),PKW(pB1,10),PKW(pB1,12),PKW(pB1,14)};
    SBAR(); pv4(o,vb0+2*sl_cur,PAF(0),PAF(1),PAF(2),PAF(3)); }
  #undef PKW
  #undef PAF
  #undef VFR
  #undef PIN
  #undef MX3
  #undef GAPA
  #undef GAPB
  #undef EX
  #undef VRD
  #undef KRD
  #undef STEP
  #undef ENDW
  {auto rr=__builtin_amdgcn_permlane32_swap(__float_as_uint(l_reg),__float_as_uint(l_reg),false,false);l_reg=__uint_as_float(rr[0])+__uint_as_float(rr[1]);}
  if(hi==0)wsf[32+r32]=l_reg;asm volatile("s_waitcnt lgkmcnt(0)":::"memory");
  float rli[16];
  #pragma unroll
  for(int r=0;r<16;++r)rli[r]=__builtin_amdgcn_rcpf(wsf[32+crow(r,hi)]);
  bf16*Ow=O+(rowbase+q0+wid*QBLK)*DM;
  { bf16*stg=(bf16*)(shm+LDS_OST2)+wid*2048;
    float dv[2][4][8]; float ssq[4]={0.f,0.f,0.f,0.f};
    #pragma unroll
    for(int hf=0;hf<2;++hf){
      #pragma unroll
      for(int r=0;r<16;++r){const int orow=crow(r,hi);
        #pragma unroll
        for(int d0=0;d0<2;++d0)stg[orow*64+d0*32+r32]=__float2bfloat16(o[2*hf+d0][r]*rli[r]);}
      asm volatile("s_waitcnt lgkmcnt(0)":::"memory");
      #pragma unroll
      for(int i=0;i<4;++i){const int row=i*8+(lane>>3),ch=lane&7; const u32x4 v=*(const u32x4*)(stg+row*64+ch*8);
        if constexpr(!FUSE){ ATTN_STORE16(Ow+(long)row*DM+hf*64+ch*8,v); }
        else{ const u32x4 v0=*(const u32x4*)(Ow+(long)row*DM+hf*64+ch*8);
          #pragma unroll
          for(int e=0;e<4;++e){ const float a0=__uint_as_float(v0[e]<<16),a1=__uint_as_float(v0[e]&0xffff0000u),b0=__uint_as_float(v[e]<<16),b1=__uint_as_float(v[e]&0xffff0000u);
            const float d0_=a0-lam*b0,d1_=a1-lam*b1; dv[hf][i][2*e]=d0_; dv[hf][i][2*e+1]=d1_; ssq[i]+=d0_*d0_+d1_*d1_; } } }
      asm volatile("s_waitcnt lgkmcnt(0)":::"memory"); }
    if constexpr(FUSE){
      bf16*Nw=ON+(rowbase+q0+wid*QBLK)*DM;
      #pragma unroll
      for(int i=0;i<4;++i){ float s_=ssq[i]; s_+=__shfl_xor(s_,1); s_+=__shfl_xor(s_,2); s_+=__shfl_xor(s_,4); ssq[i]=__builtin_amdgcn_rsqf(s_*(1.f/128.f)+eps)*oscale; }
      #pragma unroll
      for(int hf=0;hf<2;++hf){ const int ch=lane&7; float g_[8];
        #pragma unroll
        for(int e=0;e<8;++e)g_[e]=subg[hf*64+ch*8+e];
        #pragma unroll
        for(int i=0;i<4;++i){const int row=i*8+(lane>>3); u32x4 w;
          #pragma unroll
          for(int e=0;e<4;++e)w[e]=cvtpk_s(dv[hf][i][2*e]*ssq[i]*g_[2*e],dv[hf][i][2*e+1]*ssq[i]*g_[2*e+1]);
          *(u32x4*)(Nw+(long)row*DM+hf*64+ch*8)=w; } } } }
  asm volatile("s_waitcnt lgkmcnt(0)\n\ts_barrier":::"memory");
  #undef DMA_K
  #undef DMA_V
  #undef CMASK
  #undef START
  #undef RESC
  #undef ROT
}
constexpr int ATTN_LDS_BYTES=LDS_BYTES, ATTN128_LDS_BYTES=NSLOT*SLOTB+NSLOT*2*SLOTB+NW*64*4+NW*4096;
#undef SBAR
#undef WAIT_BAR
}
#define GAS __attribute__((address_space(1)))
#define LAS __attribute__((address_space(3)))
typedef unsigned short bf16;
typedef unsigned v4u __attribute__((ext_vector_type(4)));
typedef float f32x4 __attribute__((ext_vector_type(4)));
typedef short bf16x8 __attribute__((ext_vector_type(8)));
typedef GAS unsigned gu32;
typedef GAS unsigned long long gu64;
#define RLX_AGENT __ATOMIC_RELAXED, __HIP_MEMORY_SCOPE_AGENT
#define LDS_WAIT() asm volatile("s_waitcnt lgkmcnt(0)" ::: "memory")
#define VM_WAIT() asm volatile("s_waitcnt vmcnt(0)" ::: "memory")
__device__ __forceinline__ unsigned long long rt() { return __builtin_amdgcn_s_memrealtime(); }
__device__ __forceinline__ unsigned f2bf(float f) { unsigned u = __builtin_bit_cast(unsigned, f); return (u + 0x7fffu + ((u >> 16) & 1u)) >> 16; }
__device__ __forceinline__ unsigned pk2(float lo, float hi) { return f2bf(lo) | (f2bf(hi) << 16); }

#define XB_TMO      128
#define XB_XCNT(j)  (256  + 64 * (j))
#define XB_XSUB(j)  (1280 + 64 * (j))
#define XB_XGEN(j)  (2304 + 64 * (j))
#define XB_TOP      3328
#define XB_TOPGEN   3392
#define XCD_BAR_WORDS 3456
#define XB_SPIN_CAP (1u << 18)

__device__ __forceinline__ unsigned xb_ld(unsigned* p)              { return __hip_atomic_load(p, __ATOMIC_RELAXED, __HIP_MEMORY_SCOPE_AGENT); }
__device__ __forceinline__ unsigned xb_add(unsigned* p, unsigned v) { return __hip_atomic_fetch_add(p, v, __ATOMIC_RELAXED, __HIP_MEMORY_SCOPE_AGENT); }
__device__ __forceinline__ unsigned xb_xcc_id() { return (unsigned)__builtin_amdgcn_s_getreg((3 << 11) | 20) & 0xFu; }
#define XB_SPIN(cond, bar) do { unsigned _sp = 0; while (cond) { __builtin_amdgcn_s_sleep(1); \
    if ((++_sp & 255u) == 0u) { if (xb_ld(&(bar)[XB_TMO])) break; if (_sp > XB_SPIN_CAP) { atomicAdd(&(bar)[XB_TMO], 1u); break; } } } } while (0)

struct XcdBarrier {
    unsigned* bar; unsigned x;
    volatile LAS unsigned* st;
};

__device__ __forceinline__ XcdBarrier xcd_barrier_post(unsigned* bar, volatile LAS unsigned* st) {
    XcdBarrier b; b.bar = bar; b.x = xb_xcc_id(); b.st = st;
    if (threadIdx.x == 0) (void)xb_add(&bar[XB_XCNT(b.x)], 1u);
    return b;
}
__device__ __forceinline__ void xcd_barrier_complete(unsigned* bar, unsigned x, unsigned& nloc, unsigned& nx) {
    const unsigned G = gridDim.x * gridDim.y * gridDim.z;
    unsigned sum, cnt, mine, sp = 0u;
    for (;;) {
        sum = 0u; cnt = 0u; mine = 0u;
#pragma unroll
        for (unsigned j = 0; j < 16; ++j) { const unsigned c = xb_ld(&bar[XB_XCNT(j)]); sum += c; cnt += (c > 0u) ? 1u : 0u; mine = (j == x) ? c : mine; }
        if (sum == G) break;
        __builtin_amdgcn_s_sleep(1);
        if ((++sp & 255u) == 0u) { if (xb_ld(&bar[XB_TMO])) break; if (sp > XB_SPIN_CAP) { atomicAdd(&bar[XB_TMO], 1u); break; } }
    }
    nloc = mine > 0u ? mine : 1u; nx = cnt > 0u ? cnt : 1u;
}

__device__ __forceinline__ void xcd_barrier(const XcdBarrier& b) {
    asm volatile("s_waitcnt vmcnt(0)" ::: "memory");
    __syncthreads();
    if (threadIdx.x == 0) {
        unsigned* bar = b.bar;
        __builtin_amdgcn_s_waitcnt(0);
        unsigned nloc = b.st[0], nx = b.st[1];
        if (nloc == 0u) { xcd_barrier_complete(bar, b.x, nloc, nx); b.st[0] = nloc; b.st[1] = nx; }
        const unsigned old = xb_add(&bar[XB_XSUB(b.x)], 1u);
        const unsigned gen = old / nloc;
        if (old + 1u == (gen + 1u) * nloc) {
            __builtin_amdgcn_fence(__ATOMIC_RELEASE, "agent");
            asm volatile("s_waitcnt vmcnt(0)" ::: "memory");
            const unsigned og = xb_add(&bar[XB_TOP], 1u);
            const unsigned tg = og / nx;
            if (og + 1u == (tg + 1u) * nx) xb_add(&bar[XB_TOPGEN], 1u);
            else XB_SPIN(xb_ld(&bar[XB_TOPGEN]) == tg, bar);
            __builtin_amdgcn_fence(__ATOMIC_ACQUIRE, "agent");
            xb_add(&bar[XB_XGEN(b.x)], 1u);
            asm volatile("s_waitcnt vmcnt(0)" ::: "memory");
        } else {
            XB_SPIN(xb_ld(&bar[XB_XGEN(b.x)]) == gen, bar);
            __builtin_amdgcn_fence(__ATOMIC_ACQUIRE, "agent");
            asm volatile("s_waitcnt vmcnt(0)" ::: "memory");
        }
    }
    __syncthreads();
}
constexpr int NWAVES = 8;
constexpr int D = 1024, NB = 8, S = 2048, M = NB * S, PLE = 256, QKVW = 3072, DFF = 2816, NE = 8, DFE = 3584;
constexpr float EPS = 1e-6f, LAM_INIT0 = 0.2f;
constexpr int N_PHASES = 17;
#ifndef WGM_P1
#define WGM_P1 2
#endif
#ifndef WGM_P5
#define WGM_P5 2
#endif
#ifndef WGM_P11
#define WGM_P11 2
#endif
#ifndef WGM_1U
#define WGM_1U 8
#endif
#ifndef MK_N_LAUNCHES
#define MK_N_LAUNCHES 1
#endif
#ifndef MEGA_END
#define MEGA_END N_PHASES
#endif

constexpr size_t MiB = 1u << 20;
constexpr size_t WS_CTL = 0, CTL_ZERO_BYTES = 1 * MiB;
constexpr size_t WS_COS = 1 * MiB, WS_SIN = WS_COS + 256 * 1024, WS_TOKSLOT = WS_COS + 512 * 1024, WS_QKN = WS_TOKSLOT + 256 * 1024, WS_RSTL = 7 * MiB + 512 * 1024  , WS_RSTD1 = WS_QKN + 64 * 1024, WS_RSTD2 = WS_RSTD1 + 64 * 1024;
constexpr size_t WS_LISTS = 2 * MiB, WS_GWL = WS_LISTS + 512 * 1024;
constexpr size_t WS_WPOOL = 4 * MiB, WS_WPG1 = 5 * MiB, WS_WPP1 = 7 * MiB;
constexpr size_t WS_WGU = 8 * MiB, WS_WD = 120 * MiB;
constexpr size_t WS_YS = 8 * MiB;
constexpr size_t WS_XN = 176 * MiB, WS_PROJ1 = 208 * MiB, WS_BIG = 240 * MiB;
constexpr size_t WS_WQKV = 240 * MiB, WS_WO = 246 * MiB, WS_WGU0 = 248 * MiB, WS_WD0 = 259 * MiB, WS_WPG0 = 265 * MiB, WS_WPP0 = 267 * MiB;
constexpr size_t WS_Q = 268 * MiB, WS_K = 300 * MiB, WS_V = 332 * MiB, WS_O = 364 * MiB;
constexpr size_t WS_HFF = 268 * MiB, WS_PROJ0 = 364 * MiB, WS_PB = 428 * MiB;
constexpr size_t WS_HM = 240 * MiB;
constexpr size_t WS_XNB = 396 * MiB;
constexpr size_t WS_SSQA = 3 * MiB, WS_SSQB = 460 * MiB, WS_SSQC = 461 * MiB;
constexpr size_t WS_END = 466 * MiB;
static_assert(WS_WD0 + (size_t)D * DFF * 2 <= WS_WPG0 && WS_WGU0 + (size_t)2 * DFF * D * 2 <= WS_WD0 && WS_HFF + (size_t)M * DFF * 2 <= WS_PROJ0 && WS_HM + (size_t)(2 * M + 256) * DFE * 2 <= WS_END, "d_ws map");
constexpr int CW_TMO = 0, CW_CODE = 1, CW_BAR = 4096, CW_MOECNT = 65536, CW_STEAL = 98304, CW_P0Q = 98304 + 64, CW_PIECES = 98304 + 192;

constexpr int RING_OFF = 0, RING_BYTES = 131072, LDSCTL_OFF = RING_BYTES, MISC_OFF = LDSCTL_OFF + 320, LDS_BYTES = 147456;

struct Frame { LAS unsigned char* lds; volatile LAS unsigned* MISC; gu32* ctl; int tid, lane, wave, vcu, G; };

__device__ __forceinline__ float wave_sum(float v) { return pg8::sum_wave(v); }
__device__ __forceinline__ unsigned cvtpk(float lo, float hi) { unsigned r; asm volatile("v_cvt_pk_bf16_f32 %0, %1, %2" : "=v"(r) : "v"(lo), "v"(hi)); return r; }
__device__ __forceinline__ float bflo(unsigned w) { return __uint_as_float(w << 16); }
__device__ __forceinline__ float bfhi(unsigned w) { return __uint_as_float(w & 0xffff0000u); }

__device__ __forceinline__ int map_row(int map, int n) {
    if (map == 1) return (n & ~255) + ((n >> 5) & 1) * 128 + ((n >> 6) & 3) * 32 + (n & 31);
    if (map == 2) return ((n >> 7) << 8) + (n & 127);
    if (map == 3) return ((n >> 7) << 8) + 128 + (n & 127);
    return n;
}
typedef float f32x2g __attribute__((ext_vector_type(2)));
__device__ __forceinline__ void tr_load(f32x4 (&v)[16], f32x2g (&g)[8], const float* W, int N, int k0, int n0, int lane, const float* gk) {
    const int ksub = lane >> 4, n4 = (lane & 15) * 4;
#pragma unroll
    for (int it = 0; it < 8; ++it)
#pragma unroll
        for (int h = 0; h < 2; ++h) v[2 * it + h] = __builtin_nontemporal_load((const GAS f32x4*)(W + (size_t)(k0 + it * 8 + 2 * ksub + h) * N + n0 + n4));
    const float* gp = gk ? gk : W;
#pragma unroll
    for (int it = 0; it < 8; ++it) g[it] = *(const GAS f32x2g*)(gp + k0 + it * 8 + 2 * ksub);
}
__device__ __forceinline__ void tr_store(const f32x4 (&v)[16], bf16* dst, int ldd, int map, int k0, int n0, LAS unsigned* tile, int lane, const f32x2g (&graw)[8], float sel) {
    const int ksub = lane >> 4, q = lane & 15;
    f32x2g g[8];
#pragma unroll
    for (int it = 0; it < 8; ++it) g[it] = graw[it] * sel + (1.f - sel);
#pragma unroll
    for (int it = 0; it < 8; ++it)
#pragma unroll
        for (int j = 0; j < 4; ++j) tile[(4 * q + j) * 32 + ((4 * it + ksub) ^ ((q & 7) * 4))] = cvtpk(v[2 * it][j] * g[it].x, v[2 * it + 1][j] * g[it].y);
    LDS_WAIT(); asm volatile("" ::: "memory");
    const int c = lane & 7;
#pragma unroll
    for (int j2 = 0; j2 < 8; ++j2) { const int n = (lane >> 3) + 8 * j2, fz = ((n >> 2) & 7) * 4; const v4u w = *(const LAS v4u*)(tile + n * 32 + ((4 * c) ^ fz));
        *(GAS v4u*)(dst + (size_t)map_row(map, n0 + n) * ldd + k0 + 8 * c) = w; }
    LDS_WAIT(); asm volatile("" ::: "memory");
}
struct TItem { const float* W; bf16* dst; const float* g; int K, N, map, kb, nb; };
enum { A_X = 0, A_P, A_NORM_MIX, A_NORM_FFN, A_NORM_PLE, A_WQKV, A_WO, A_QNORM, A_KNORM, A_LQ1, A_LK1, A_LQ2, A_LK2, A_SUBLN, A_POOLW, A_POOLB, A_POOLS, A_FFNG, A_FFNU, A_FFND, A_ROUTER, A_MOEG, A_MOEU, A_MOED, A_PLEP, A_PLEG };
__device__ __forceinline__ const float* arg_ptr(int i) {
    const __attribute__((address_space(4))) char* kp = (const __attribute__((address_space(4))) char*)__builtin_amdgcn_kernarg_segment_ptr();
    unsigned off = (unsigned)i * 8u; asm volatile("" : "+s"(off));
    return *(const float* const __attribute__((address_space(4)))*)(kp + off);
}
constexpr int TI_QKV = 768, TI_O = 256, TI_FF = 704, TI_PG = 256, TI_PP = 64, TI_POOL = 64, TI_MOE = 7168;
constexpr int TI_TOTAL = TI_QKV + TI_O + 3 * TI_FF + 2 * TI_PG + 2 * TI_PP + TI_POOL + 3 * TI_MOE;
__device__ __forceinline__ void decode_item(unsigned char* ws, int r, TItem& t) {
    int ai = 0, gi = -1, gofs = 0; size_t wofs = 0;
    do {
#define TJOB(cnt, Ai, Wofs, Kp, Np, dstp, mapp, Gi, Gofs) if (r < (cnt)) { ai = (Ai); wofs = (Wofs); gi = (Gi); gofs = (Gofs); t.K = (Kp); t.N = (Np); t.dst = (bf16*)(dstp); t.map = (mapp); t.kb = r / ((Np) / 64); t.nb = r % ((Np) / 64); break; } r -= (cnt);
        if (r < TI_MOE) { const int e = r / 896; r -= e * 896; ai = A_MOEG; gi = A_NORM_FFN; gofs = D; wofs = (size_t)e * D * DFE; t.K = D; t.N = DFE; t.dst = (bf16*)(ws + WS_WGU) + (size_t)e * 2 * DFE * D; t.map = 2; t.kb = r / 56; t.nb = r % 56; break; } r -= TI_MOE;
        if (r < TI_MOE) { const int e = r / 896; r -= e * 896; ai = A_MOEU; gi = A_NORM_FFN; gofs = D; wofs = (size_t)e * D * DFE; t.K = D; t.N = DFE; t.dst = (bf16*)(ws + WS_WGU) + (size_t)e * 2 * DFE * D; t.map = 3; t.kb = r / 56; t.nb = r % 56; break; } r -= TI_MOE;
        if (r < TI_MOE) { const int e = r / 896; r -= e * 896; ai = A_MOED; wofs = (size_t)e * DFE * D; t.K = DFE; t.N = D; t.dst = (bf16*)(ws + WS_WD) + (size_t)e * D * DFE; t.map = 0; t.kb = r / 16; t.nb = r % 16; break; } r -= TI_MOE;
        TJOB(TI_QKV, A_WQKV, 0, D, QKVW, ws + WS_WQKV, 1, -1, 0)
        TJOB(TI_O, A_WO, 0, D, D, ws + WS_WO, 0, -1, 0)
        TJOB(TI_FF, A_FFNG, 0, D, DFF, ws + WS_WGU0, 2, A_NORM_FFN, 0)
        TJOB(TI_FF, A_FFNU, 0, D, DFF, ws + WS_WGU0, 3, A_NORM_FFN, 0)
        TJOB(TI_FF, A_FFND, 0, DFF, D, ws + WS_WD0, 0, -1, 0)
        TJOB(TI_PG, A_PLEG, 0, D, D, ws + WS_WPG0, 0, A_NORM_PLE, 0)
        TJOB(TI_PG, A_PLEG, (size_t)D * D, D, D, ws + WS_WPG1, 0, A_NORM_PLE, D)
        TJOB(TI_PP, A_PLEP, 0, PLE, D, ws + WS_WPP0, 0, -1, 0)
        TJOB(TI_PP, A_PLEP, (size_t)PLE * D, PLE, D, ws + WS_WPP1, 0, -1, 0)
        { const int g = r / 16; r -= g * 16; ai = A_POOLW; gi = A_NORM_MIX; gofs = D + g * 256; wofs = (size_t)g * 256 * 256; t.K = 256; t.N = 256; t.dst = (bf16*)(ws + WS_WPOOL) + (size_t)g * 256 * 256; t.map = 0; t.kb = r / 4; t.nb = r % 4; }
#undef TJOB
    } while (0);
    t.W = arg_ptr(ai) + wofs; t.g = nullptr; if (gi >= 0) t.g = arg_ptr(gi) + gofs;
}
__device__ __forceinline__ void rms_row_to_bf16(const float* xrow, const float* gain, bf16* orow, int lane) {
    const GAS f32x4* xr = (const GAS f32x4*)xrow + lane;
    f32x4 v[4]; float s = 0.f;
#pragma unroll
    for (int j = 0; j < 4; ++j) { v[j] = xr[64 * j]; s += (v[j].x * v[j].x + v[j].y * v[j].y) + (v[j].z * v[j].z + v[j].w * v[j].w); }
    const float rstd = __builtin_amdgcn_rsqf(wave_sum(s) * (1.f / D) + EPS);
    GAS unsigned long long* o8 = (GAS unsigned long long*)orow + lane;
#pragma unroll
    for (int j = 0; j < 4; ++j) { const f32x4 g = ((const GAS f32x4*)gain)[lane + 64 * j];
        o8[64 * j] = (unsigned long long)cvtpk(v[j].x * rstd * g.x, v[j].y * rstd * g.y) | ((unsigned long long)cvtpk(v[j].z * rstd * g.z, v[j].w * rstd * g.w) << 32); }
}
__device__ __forceinline__ void p_norm(Frame& F, const float* H, const float* gain, bf16* XN, gu32* ctr) {
    const int gw = F.vcu * NWAVES + F.wave, NGW = F.G * NWAVES, lane = F.lane;
    volatile LAS int* bw = (volatile LAS int*)(F.lds + MISC_OFF + 96);
    for (int ch = F.vcu; ch < M / 32;) {
        unsigned nx = 0u; if (F.tid == 0) nx = __hip_atomic_fetch_add(ctr, 1u, RLX_AGENT);
        const int m0 = ch * 32 + F.wave * 4;
        f32x4 v[4][4];
#pragma unroll
        for (int r = 0; r < 4; ++r) { const GAS f32x4* xr = (const GAS f32x4*)(H + (size_t)(m0 + r) * D) + lane;
#pragma unroll
            for (int j = 0; j < 4; ++j) v[r][j] = xr[64 * j]; }
#pragma unroll
        for (int r = 0; r < 4; ++r) { float s = 0.f;
#pragma unroll
            for (int j = 0; j < 4; ++j) s += (v[r][j].x * v[r][j].x + v[r][j].y * v[r][j].y) + (v[r][j].z * v[r][j].z + v[r][j].w * v[r][j].w);
            const float rstd = __builtin_amdgcn_rsqf(wave_sum(s) * (1.f / D) + EPS);
            GAS unsigned long long* o8 = (GAS unsigned long long*)(XN + (size_t)(m0 + r) * D) + lane;
#pragma unroll
            for (int j = 0; j < 4; ++j) { const f32x4 g = ((const GAS f32x4*)gain)[lane + 64 * j];
                o8[64 * j] = (unsigned long long)cvtpk(v[r][j].x * rstd * g.x, v[r][j].y * rstd * g.y) | ((unsigned long long)cvtpk(v[r][j].z * rstd * g.z, v[r][j].w * rstd * g.w) << 32); } }
        if (F.tid == 0) bw[0] = (int)nx;
        __syncthreads(); ch = F.G + __builtin_amdgcn_readfirstlane(bw[0]); __syncthreads();
    }
}
__device__ __forceinline__ void conv_range(unsigned char* ws, LAS unsigned* tile, int lane_in, int it0, int step, int nmax, int it_end) {
    int lane = lane_in; asm volatile("" : "+v"(lane));
    int it = it0, n = 0;
    for (; it + step < it_end && n + 1 < nmax; it += 2 * step, n += 2) {
        TItem ta, tb; f32x4 va[16], vb[16]; f32x2g ga[8], gb[8];
        decode_item(ws, it, ta); tr_load(va, ga, ta.W, ta.N, ta.kb * 64, ta.nb * 64, lane, ta.g);
        decode_item(ws, it + step, tb); tr_load(vb, gb, tb.W, tb.N, tb.kb * 64, tb.nb * 64, lane, tb.g);
        tr_store(va, ta.dst, ta.K, ta.map, ta.kb * 64, ta.nb * 64, tile, lane, ga, ta.g ? 1.f : 0.f);
        tr_store(vb, tb.dst, tb.K, tb.map, tb.kb * 64, tb.nb * 64, tile, lane, gb, tb.g ? 1.f : 0.f);
    }
    if (it < it_end && n < nmax) {
        TItem ta; f32x4 va[16]; f32x2g ga[8];
        decode_item(ws, it, ta); tr_load(va, ga, ta.W, ta.N, ta.kb * 64, ta.nb * 64, lane, ta.g);
        tr_store(va, ta.dst, ta.K, ta.map, ta.kb * 64, ta.nb * 64, tile, lane, ga, ta.g ? 1.f : 0.f);
    }
}
__device__ __forceinline__ void p0_prologue(Frame& F, unsigned char* ws) {
    const int gw = F.vcu * NWAVES + F.wave, NGW = F.G * NWAVES, gt = gw * 64 + F.lane, NGT = NGW * 64;
    for (int idx = gt; idx < S * 32; idx += NGT) {
        const int pos = idx >> 5, i = idx & 31;
        const float inv = 1.0f / __builtin_amdgcn_exp2f((float)i * (13.287712379549449f / 32.f));
        const float ang = (float)pos * inv; const double a = (double)ang * 0.15915494309189535; const float f = (float)(a - __builtin_rint(a));
        ((float*)(ws + WS_COS))[idx] = __builtin_amdgcn_cosf(f); ((float*)(ws + WS_SIN))[idx] = __builtin_amdgcn_sinf(f);
    }
    if (gt < 128) ((float*)(ws + WS_QKN))[gt] = gt < 64 ? arg_ptr(A_QNORM)[gt] : arg_ptr(A_KNORM)[gt - 64];
    { const float* pp = arg_ptr(A_P);
#pragma unroll 4
    for (int i = gt; i < M * PLE / 8; i += NGT) { const f32x4 a = ((const GAS f32x4*)pp)[2 * i], b = ((const GAS f32x4*)pp)[2 * i + 1];
        v4u w; w.x = cvtpk(a.x, a.y); w.y = cvtpk(a.z, a.w); w.z = cvtpk(b.x, b.y); w.w = cvtpk(b.z, b.w); ((GAS v4u*)(ws + WS_PB))[i] = w; } }
    conv_range(ws, (LAS unsigned*)(F.lds + RING_OFF + F.wave * 8192), F.lane, 3 * TI_MOE + gw, NGW, 1 << 30, TI_TOTAL);
    p_norm(F, arg_ptr(A_X), arg_ptr(A_NORM_MIX), (bf16*)(ws + WS_XN), F.ctl + CW_P0Q);
}
__device__ __forceinline__ void p_subln(Frame& F, const bf16* O, bf16* XN) {
    const int gw = F.vcu * NWAVES + F.wave, NGW = F.G * NWAVES, lane = F.lane;
    const float lam = __expf(wave_sum(arg_ptr(A_LQ1)[lane] * arg_ptr(A_LK1)[lane])) - __expf(wave_sum(arg_ptr(A_LQ2)[lane] * arg_ptr(A_LK2)[lane])) + LAM_INIT0;
    const float* subln_g = arg_ptr(A_SUBLN);
    float sg[16];
#pragma unroll
    for (int i = 0; i < 4; ++i) { const f32x4 g = *(const GAS f32x4*)(subln_g + (lane & 7) * 16 + 4 * i); sg[4 * i] = g.x; sg[4 * i + 1] = g.y; sg[4 * i + 2] = g.z; sg[4 * i + 3] = g.w; }
    for (int m = gw; m < M; m += NGW) {
        const GAS v4u* o0 = (const GAS v4u*)(O + (size_t)m * D) + 2 * lane; const GAS v4u* o1 = (const GAS v4u*)(O + (size_t)M * D + (size_t)m * D) + 2 * lane;
        const v4u a0 = o0[0], a1 = o0[1], b0 = o1[0], b1 = o1[1];
        const unsigned aw[8] = {a0.x, a0.y, a0.z, a0.w, a1.x, a1.y, a1.z, a1.w}, bw[8] = {b0.x, b0.y, b0.z, b0.w, b1.x, b1.y, b1.z, b1.w};
        float v[16]; float ss = 0.f;
#pragma unroll
        for (int i = 0; i < 8; ++i) { v[2 * i] = bflo(aw[i]) - lam * bflo(bw[i]); v[2 * i + 1] = bfhi(aw[i]) - lam * bfhi(bw[i]); ss += v[2 * i] * v[2 * i] + v[2 * i + 1] * v[2 * i + 1]; }
        ss += __shfl_xor(ss, 1); ss += __shfl_xor(ss, 2); ss += __shfl_xor(ss, 4);
        const float r = __builtin_amdgcn_rsqf(ss * (1.f / 128.f) + EPS) * (1.f - LAM_INIT0);
        v4u w0, w1;
        w0.x = cvtpk(v[0] * r * sg[0], v[1] * r * sg[1]); w0.y = cvtpk(v[2] * r * sg[2], v[3] * r * sg[3]); w0.z = cvtpk(v[4] * r * sg[4], v[5] * r * sg[5]); w0.w = cvtpk(v[6] * r * sg[6], v[7] * r * sg[7]);
        w1.x = cvtpk(v[8] * r * sg[8], v[9] * r * sg[9]); w1.y = cvtpk(v[10] * r * sg[10], v[11] * r * sg[11]); w1.z = cvtpk(v[12] * r * sg[12], v[13] * r * sg[13]); w1.w = cvtpk(v[14] * r * sg[14], v[15] * r * sg[15]);
        GAS v4u* o = (GAS v4u*)(XN + (size_t)m * D) + 2 * lane; o[0] = w0; o[1] = w1;
    }
}
template <int NC> __device__ __forceinline__ void p_pool_blk(Frame& F, const bf16* H, bf16* XN, const float* ssqp, int r0, int c0) {
    constexpr int R = 16 * (512 / NC);
    LAS float* rs = (LAS float*)(F.lds + RING_OFF);
    const int t0 = r0 & (S - 1);
    if (F.tid < R + 16) { const int row = r0 - 16 + F.tid; float r = 0.f; if (F.tid >= 16 || t0 != 0) r = pg8::row_rstd(ssqp, row, EPS); rs[F.tid] = r; }
    __syncthreads();
    const int cq = F.tid & (NC - 1), rq = F.tid / NC, col = c0 + 8 * cq, g = col >> 8, w = 2 << g, rbase = 16 * rq, tq = t0 + rbase;
    const bf16* Hc = H + (size_t)(r0 + rbase) * D + col;
#define LD8(dst, p) do { const v4u w_ = *(const GAS v4u*)(p); dst[0] = bflo(w_.x); dst[1] = bfhi(w_.x); dst[2] = bflo(w_.y); dst[3] = bfhi(w_.y); dst[4] = bflo(w_.z); dst[5] = bfhi(w_.z); dst[6] = bflo(w_.w); dst[7] = bfhi(w_.w); } while (0)
    float sw[8];
#pragma unroll
    for (int i = 0; i < 8; ++i) sw[i] = 0.f;
    if (tq != 0) for (int k = 1; k <= w; ++k) { float hv[8]; LD8(hv, Hc - (long)k * D); const float r = rs[16 + rbase - k];
#pragma unroll
        for (int i = 0; i < 8; ++i) sw[i] += hv[i] * r; }
#pragma unroll 1
    for (int rb = 0; rb < 16; rb += 8) {
        float nv[8][8], ov[8][8];
#pragma unroll
        for (int j = 0; j < 8; ++j) LD8(nv[j], Hc + (long)(rb + j) * D);
#pragma unroll
        for (int j = 0; j < 8; ++j) {
#pragma unroll
            for (int i = 0; i < 8; ++i) ov[j][i] = 0.f;
            if (tq + rb + j >= w) LD8(ov[j], Hc + (long)(rb + j - w) * D); }
#pragma unroll
        for (int j = 0; j < 8; ++j) { const int rl = rbase + rb + j, t = t0 + rl; const float rn = rs[16 + rl], ro = (t >= w) ? rs[16 + rl - w] : 0.f;
            const int cnt = (t + 1 < w) ? t + 1 : w; const float ic = 1.f / (float)cnt; float o[8];
#pragma unroll
            for (int i = 0; i < 8; ++i) { const float a = nv[j][i] * rn; sw[i] += a; sw[i] -= ov[j][i] * ro; o[i] = sw[i] * ic - a; }
            v4u ow; ow.x = cvtpk(o[0], o[1]); ow.y = cvtpk(o[2], o[3]); ow.z = cvtpk(o[4], o[5]); ow.w = cvtpk(o[6], o[7]);
            *(GAS v4u*)(XN + (size_t)(r0 + rl) * D + col) = ow; }
    }
#undef LD8
    __syncthreads();
}

__device__ __forceinline__ void p_router(Frame& F, const bf16* H, const float* gain, const float* Wr, float* rstl, int* lists, float* gwl, int* tokslot, gu32* cntw) {
    LAS float* rec = (LAS float*)(F.lds + RING_OFF);
    const int lane = F.lane;
    LAS float* wl = (LAS float*)(F.lds + RING_OFF + 4096);
#pragma unroll
    for (int q = 0; q < 4; ++q) { const int o4 = (F.tid + 512 * q) * 4; *(LAS f32x4*)(wl + (o4 >> 6) * 68 + (o4 & 63)) = *(const GAS f32x4*)(Wr + o4); }
    __syncthreads();
    float wr[4][4][8];
#pragma unroll
    for (int j = 0; j < 4; ++j)
#pragma unroll
        for (int i = 0; i < 4; ++i) { const LAS float* wp = wl + ((j >> 1) * 64 + lane) * 68 + (4 * (j & 1) + i) * 8; const f32x4 a = *(const LAS f32x4*)wp, b = *(const LAS f32x4*)(wp + 4);
            wr[j][i][0] = a.x; wr[j][i][1] = a.y; wr[j][i][2] = a.z; wr[j][i][3] = a.w; wr[j][i][4] = b.x; wr[j][i][5] = b.y; wr[j][i][6] = b.z; wr[j][i][7] = b.w; }
    f32x4 gn[4];
#pragma unroll
    for (int j = 0; j < 4; ++j) gn[j] = *(const GAS f32x4*)(gain + 8 * lane + 512 * (j >> 1) + 4 * (j & 1));
    for (int blk = F.vcu; blk < M / 64; blk += F.G) {
        v4u raw[8][2];
#pragma unroll
        for (int rr = 0; rr < 8; ++rr) { const GAS v4u* xr = (const GAS v4u*)(H + (size_t)(blk * 64 + F.wave * 8 + rr) * D) + lane;
#pragma unroll
            for (int p = 0; p < 2; ++p) raw[rr][p] = xr[64 * p]; }
#pragma unroll
        for (int rr = 0; rr < 8; ++rr) {
            const int rl = F.wave * 8 + rr;
            f32x4 v[4]; float s = 0.f;
#pragma unroll
            for (int j = 0; j < 4; ++j) { const v4u a = raw[rr][j >> 1]; const unsigned lo = (j & 1) ? a.z : a.x, hi = (j & 1) ? a.w : a.y; v[j] = (f32x4){bflo(lo), bfhi(lo), bflo(hi), bfhi(hi)}; s += (v[j].x * v[j].x + v[j].y * v[j].y) + (v[j].z * v[j].z + v[j].w * v[j].w); }
            const float rstd = __builtin_amdgcn_rsqf(wave_sum(s) * (1.f / D) + EPS);
            float lg[8];
#pragma unroll
            for (int e = 0; e < 8; ++e) lg[e] = 0.f;
#pragma unroll
            for (int j = 0; j < 4; ++j) { const float xu[4] = {v[j].x * rstd, v[j].y * rstd, v[j].z * rstd, v[j].w * rstd};
                const float xv[4] = {xu[0] * gn[j].x, xu[1] * gn[j].y, xu[2] * gn[j].z, xu[3] * gn[j].w};
#pragma unroll
                for (int i = 0; i < 4; ++i)
#pragma unroll
                    for (int e = 0; e < 8; ++e) lg[e] = __builtin_fmaf(xv[i], wr[j][i][e], lg[e]); }
            {
                const bool b5 = (lane & 32) != 0, b4 = (lane & 16) != 0, b3 = (lane & 8) != 0;
                float rb[4], rc[2], rd;
#pragma unroll
                for (int i = 0; i < 4; ++i) { auto rr = __builtin_amdgcn_permlane32_swap(__float_as_uint(lg[i]), __float_as_uint(lg[i + 4]), false, false); rb[i] = __uint_as_float(rr[0]) + __uint_as_float(rr[1]); }
#pragma unroll
                for (int i = 0; i < 2; ++i) { auto rr = __builtin_amdgcn_permlane16_swap(__float_as_uint(rb[i]), __float_as_uint(rb[i + 2]), false, false); rc[i] = __uint_as_float(rr[0]) + __uint_as_float(rr[1]); }
                { const float send = b3 ? rc[0] : rc[1], keep = b3 ? rc[1] : rc[0]; rd = keep + pg8::dpp_f<0x128>(send); }
                rd = pg8::sum_row8(rd);
#pragma unroll
                for (int e = 0; e < 8; ++e) lg[e] = __uint_as_float(__builtin_amdgcn_readlane(__float_as_uint(rd), 8 * e));
            }
            int i0 = 0; float v0 = lg[0];
#pragma unroll
            for (int e = 1; e < 8; ++e) if (lg[e] > v0) { v0 = lg[e]; i0 = e; }
            int i1 = 0; float v1 = -INFINITY;
#pragma unroll
            for (int e = 0; e < 8; ++e) if (e != i0 && lg[e] > v1) { v1 = lg[e]; i1 = e; }
            const float g1 = 1.f / (1.f + __expf(v0 - v1)), g0 = 1.f - g1;
            if (lane == 0) { rec[rl * 8 + 0] = __int_as_float(i0); rec[rl * 8 + 1] = __int_as_float(i1); rec[rl * 8 + 2] = g0; rec[rl * 8 + 3] = g1; rec[rl * 8 + 4] = rstd; }
        }
        __syncthreads();
        {
            const int ex = F.wave, rl = lane; const int a = __float_as_int(rec[rl * 8]), b = __float_as_int(rec[rl * 8 + 1]);
            const bool sel = (a == ex) || (b == ex); const unsigned long long bal = __ballot(sel);
            const int n = __popcll(bal), pre = __popcll(bal & ((1ull << lane) - 1ull));
            int base = 0; if (lane == 0) base = (int)__hip_atomic_fetch_add(cntw + 64 * ex, (unsigned)n, RLX_AGENT);
            base = __builtin_amdgcn_readfirstlane(base);
            if (sel) { const int k = (a == ex) ? 0 : 1, tok = blk * 64 + rl, pos = base + pre;
                lists[ex * M + pos] = tok; gwl[ex * M + pos] = rec[rl * 8 + 2 + k]; rstl[ex * M + pos] = rec[rl * 8 + 4]; tokslot[tok * 2 + k] = (ex << 16) | pos; }
        }
        __syncthreads();
    }
}
__device__ __forceinline__ void p_combine(Frame& F, const bf16* HB, bf16* HBo, const bf16* Ys, const int* tokslot, float* rstd_out) {
    const int gw = F.vcu * NWAVES + F.wave, NGW = F.G * NWAVES, lane = F.lane;
    int off[8]; { int a = 0;
#pragma unroll
        for (int e = 0; e < 8; ++e) { off[e] = a; a += (int)__hip_atomic_load(F.ctl + CW_MOECNT + 64 * e, RLX_AGENT); } }
    constexpr int RPW = 8;
    for (int m0 = gw * RPW; m0 < M; m0 += NGW * RPW) {
        const int ts = (lane < 2 * RPW) ? tokslot[2 * m0 + lane] : 0;
#pragma unroll
        for (int g = 0; g < RPW; g += 4) {
            v4u ya[4][2], yb[4][2], hh[4][2];
#pragma unroll
            for (int r = 0; r < 4; ++r) {
                const int ts0 = __builtin_amdgcn_readlane(ts, 2 * (g + r)), ts1 = __builtin_amdgcn_readlane(ts, 2 * (g + r) + 1);
                int s0 = ts0 & 0xffff, s1 = ts1 & 0xffff;
#pragma unroll
                for (int e = 0; e < 8; ++e) { if ((ts0 >> 16) == e) s0 += off[e]; if ((ts1 >> 16) == e) s1 += off[e]; }
                const GAS v4u* hr = (const GAS v4u*)(HB + (size_t)(m0 + g + r) * D) + lane;
                const GAS v4u* y0 = (const GAS v4u*)(Ys + (size_t)s0 * D) + lane; const GAS v4u* y1 = (const GAS v4u*)(Ys + (size_t)s1 * D) + lane;
#pragma unroll
                for (int j = 0; j < 2; ++j) { ya[r][j] = y0[64 * j]; yb[r][j] = y1[64 * j]; hh[r][j] = hr[64 * j]; }
            }
#pragma unroll
            for (int r = 0; r < 4; ++r) {
                GAS v4u* hw = (GAS v4u*)(HBo + (size_t)(m0 + g + r) * D) + lane; float s = 0.f;
#pragma unroll
                for (int j = 0; j < 2; ++j) { const unsigned aw[4] = {ya[r][j].x, ya[r][j].y, ya[r][j].z, ya[r][j].w}, bw_[4] = {yb[r][j].x, yb[r][j].y, yb[r][j].z, yb[r][j].w}, hw_[4] = {hh[r][j].x, hh[r][j].y, hh[r][j].z, hh[r][j].w};
                    unsigned ow[4];
#pragma unroll
                    for (int q = 0; q < 4; ++q) { ow[q] = cvtpk(bflo(hw_[q]) + (bflo(aw[q]) + bflo(bw_[q])), bfhi(hw_[q]) + (bfhi(aw[q]) + bfhi(bw_[q]))); s += bflo(ow[q]) * bflo(ow[q]) + bfhi(ow[q]) * bfhi(ow[q]); }
                    v4u o; o.x = ow[0]; o.y = ow[1]; o.z = ow[2]; o.w = ow[3]; hw[64 * j] = o; }
                const float rstd = __builtin_amdgcn_rsqf(wave_sum(s) * (1.f / D) + EPS);
                if (lane == 0) rstd_out[m0 + g + r] = rstd;
            }
        }
    }
}

struct Args { const float* in[26]; float* out; unsigned char* ws; int ph_lo, ph_hi, li, pad; };
__global__ void __launch_bounds__(NWAVES * 64, 2) mega_fwd(Args args) {
    extern __shared__ __attribute__((aligned(16))) unsigned char lds[];
    Frame F;
    F.lds = (LAS unsigned char*)lds;
    F.MISC = (volatile LAS unsigned*)(F.lds + MISC_OFF);
    F.tid = threadIdx.x; F.lane = F.tid & 63; F.wave = __builtin_amdgcn_readfirstlane(F.tid >> 6);
    F.G = gridDim.x; { const int bx = blockIdx.x; F.vcu = (F.G % 8 == 0) ? (bx % 8) * (F.G / 8) + bx / 8 : bx; }
    unsigned char* ws = args.ws;
    F.ctl = (gu32*)(ws + WS_CTL);
    float* const Hout = args.out;
    for (int u = F.tid; u < (LDS_BYTES - LDSCTL_OFF) / 4; u += NWAVES * 64) ((LAS unsigned*)(F.lds + LDSCTL_OFF))[u] = 0u;
    __syncthreads();
    XcdBarrier bar; bar.bar = (unsigned*)(F.ctl + CW_BAR) + args.li * XCD_BAR_WORDS; bar.x = 0; bar.st = nullptr;
    const int lo = args.ph_lo, hi = args.ph_hi;
    if (hi - lo > 1) bar = xcd_barrier_post((unsigned*)(F.ctl + CW_BAR) + args.li * XCD_BAR_WORDS, F.MISC + 8);
#ifndef PHASE_MASK
#define PHASE_MASK 0x1ffff
#endif
#define IN(k) (((PHASE_MASK >> (k)) & 1) && lo <= (k) && (k) < hi)
#define SEAM(k) do { if (IN(k) && IN((k) + 1)) xcd_barrier(bar); } while (0)
#ifndef REP_MASK
#define REP_MASK 0
#endif
#define REPS(k) (((REP_MASK >> (k)) & 1) ? 2 : 1)
#define REPEAT(k) _Pragma("unroll 1") for (int rep_ = 0; rep_ < REPS(k); (++rep_ < REPS(k)) ? xcd_barrier(bar) : (void)0)
    bf16* XN = (bf16*)(ws + WS_XN);
    const int bx = (int)blockIdx.x;
    const long TS1024 = 256L * 1024 * 2;

    float* SSQA = (float*)(ws + WS_SSQA); float* SSQB = (float*)(ws + WS_SSQB); float* SSQC = (float*)(ws + WS_SSQC);
    if (IN(0)) REPEAT(0) { p0_prologue(F, ws); } SEAM(0);
    if (IN(1)) REPEAT(1) {
        pg8::DenseSched Sd{(const char*)XN, (const char*)(ws + WS_WQKV), 64, 12, F.G, (F.G == 256) ? F.vcu : bx, TS1024, 0, TS1024, WGM_P1, (F.G == 256) ? 1 : 0};
        pg8::EpiQKV E{(bf16*)(ws + WS_Q), (size_t)(WS_K - WS_Q) / 2, (const float*)(ws + WS_QKN), (const float*)(ws + WS_COS), (const float*)(ws + WS_SIN), attn_body::C2, EPS};
        pg8::gemm_phase<pg8::EpiQKV, pg8::DenseSched, false, true>(F.lds + RING_OFF, D, D, D, Sd, E);
    } SEAM(1);
    if (IN(2)) REPEAT(2) {
        static_assert(attn_body::ATTN128_LDS_BYTES <= RING_BYTES, "attention LDS");
        const float lam = __expf(wave_sum(arg_ptr(A_LQ1)[F.lane] * arg_ptr(A_LK1)[F.lane])) - __expf(wave_sum(arg_ptr(A_LQ2)[F.lane] * arg_ptr(A_LK2)[F.lane])) + LAM_INIT0;
        const float* subg = arg_ptr(A_SUBLN);
        const int hgrp = (F.vcu * 3) / F.G; const int hkpos = (hgrp == 0) ? -1 : (hgrp == 1) ? 0 : 2; bool conv_done = false;
        for (int hc = F.vcu; hc < NB * 8 * 4; hc += F.G) {
            const int bh = hc >> 2, s_ = hc & 3, b = bh >> 3, h = bh & 7;
            const attn_body::bf16* Vp = (const attn_body::bf16*)(ws + WS_V) + h * 128; attn_body::bf16* Op = (attn_body::bf16*)(ws + WS_O) + h * 128;
            _Pragma("unroll 1") for (int qi = -1; qi < 4; ++qi) {
                if (qi >= 0) { int qb = (qi & 2) ? s_ : 7 - s_; asm volatile("" : "+s"(qb)); const int c = qi & 1;
                    const attn_body::bf16* Qp = (const attn_body::bf16*)(ws + WS_Q) + (h * 2 + c) * 64; const attn_body::bf16* Kp = (const attn_body::bf16*)(ws + WS_K) + (h * 2 + c) * 64;
                    if (c == 0) attn_body::attn_unit128<8, false>(b, qb, Qp, Kp, Vp, Op, (char*)lds + RING_OFF);
                    else attn_body::attn_unit128<8, true>(b, qb, Qp, Kp, Vp, Op, (char*)lds + RING_OFF, (attn_body::bf16*)XN + h * 128, subg, lam, 1.f - LAM_INIT0, EPS); }
                if (qi == hkpos && !conv_done) {
                    conv_range(ws, (LAS unsigned*)(F.lds + RING_OFF + F.wave * 8192), F.lane, F.vcu * NWAVES + F.wave, F.G * NWAVES, 1 << 30, 2 * TI_MOE); conv_done = true;
                    asm volatile("s_waitcnt lgkmcnt(0)" ::: "memory"); __builtin_amdgcn_s_barrier(); asm volatile("" ::: "memory"); }
            }
        }
    } SEAM(2);
    bf16* HB0 = (bf16*)Hout;
    bf16* HB1 = XN;
    bf16* PL = (bf16*)(ws + WS_Q);
    bf16* HB2 = HB0;
    if (IN(4)) REPEAT(4) {
        pg8::DenseSched Sd{(const char*)XN, (const char*)(ws + WS_WO), 64, 4, F.G, (F.G == 256) ? F.vcu : bx, TS1024, 0, TS1024, WGM_1U, (F.G == 256) ? 1 : 0};
        pg8::EpiResNorm<false> E{arg_ptr(A_X), HB0, SSQA};
        pg8::gemm_phase<pg8::EpiResNorm<false>, pg8::DenseSched, false, true>(F.lds + RING_OFF, D, D, D, Sd, E);
    } SEAM(4);
    if (IN(5)) REPEAT(5) {
        { const bool rst = (F.G == 256);
          pg8::DenseSched Sd{(const char*)HB0, (const char*)(ws + WS_WGU0), 64, 22, F.G, rst ? F.vcu : bx, TS1024, 0, TS1024, WGM_P5, rst ? 1 : 0};
          pg8::EpiSwiGLU<1> E{(bf16*)(ws + WS_HFF), DFF, EPS, SSQA, nullptr};
          pg8::gemm_phase<pg8::EpiSwiGLU<1>, pg8::DenseSched, false, true>(F.lds + RING_OFF, D, D, D, Sd, E); }
        { const bool split = (F.G == 256);
          pg8::ProjSched Sp{(const char*)(ws + WS_PB), (const char*)(ws + WS_WPP0), 0, split ? 128 : F.G, split ? (((F.vcu & 3) >= 2) ? (F.vcu >> 2) * 2 + (F.vcu & 3) - 2 : -1) : bx, -1};
          pg8::EpiProj E{(bf16*)(ws + WS_PROJ0), ((long)WS_PROJ1 - (long)WS_PROJ0) / 2};
          pg8::gemm_phase<pg8::EpiProj, pg8::ProjSched, false, true>(F.lds + RING_OFF, PLE, PLE, PLE, Sp, E); }
    } SEAM(5);
    if (IN(6)) {
        pg8::DenseSched Sd{(const char*)(ws + WS_HFF), (const char*)(ws + WS_WD0), 64, 4, F.G, (F.G == 256) ? F.vcu : bx, 256L * DFF * 2, 0, 256L * DFF * 2, WGM_1U, (F.G == 256) ? 1 : 0};
        pg8::EpiResNorm<true> E{HB0, HB0, SSQB};
        pg8::gemm_phase<pg8::EpiResNorm<true>, pg8::DenseSched, false, true>(F.lds + RING_OFF, DFF, DFF, DFF, Sd, E);
    } SEAM(6);
    if (IN(7)) {
        pg8::DenseSched Sd{(const char*)HB0, (const char*)(ws + WS_WPG0), 64, 4, F.G, (F.G == 256) ? F.vcu : bx, TS1024, 0, TS1024, WGM_1U, (F.G == 256) ? 1 : 0};
        pg8::EpiPle<1, false> E{HB0, (const bf16*)(ws + WS_PROJ0), HB1, SSQB, SSQC, EPS, 0};
        pg8::gemm_phase<pg8::EpiPle<1, false>, pg8::DenseSched, false, true>(F.lds + RING_OFF, D, D, D, Sd, E);
    } SEAM(7);
    if (IN(9)) {
        pg8::DenseSched Sd{(const char*)PL, (const char*)(ws + WS_WPOOL), 64, 4, F.G, (F.G == 256) ? F.vcu : bx, TS1024, 256L * 2, 256L * 256 * 2, WGM_1U, (F.G == 256) ? 1 : 0};
        { pg8::Unit pu; for (int i = 0; Sd.next(i, pu); ++i) p_pool_blk<32>(F, HB1, PL, SSQC, pu.r0, pu.c0);
          asm volatile("s_waitcnt vmcnt(0)" ::: "memory"); __syncthreads(); }
        pg8::EpiPool E{HB1, HB2, arg_ptr(A_POOLB), arg_ptr(A_POOLS)};
        pg8::gemm_phase<pg8::EpiPool, pg8::DenseSched, false, true>(F.lds + RING_OFF, 256, D, 256, Sd, E);
    } SEAM(9);
    bf16* PB1 = HB1;
    if (IN(10)) { const float* pp = arg_ptr(A_P) + (size_t)M * PLE; const int gt = (F.vcu * NWAVES + F.wave) * 64 + F.lane, NGT = F.G * NWAVES * 64;
#pragma unroll 4
        for (int i = gt; i < M * PLE / 8; i += NGT) { const f32x4 a = ((const GAS f32x4*)pp)[2 * i], b = ((const GAS f32x4*)pp)[2 * i + 1];
            v4u w; w.x = cvtpk(a.x, a.y); w.y = cvtpk(a.z, a.w); w.z = cvtpk(b.x, b.y); w.w = cvtpk(b.z, b.w); ((GAS v4u*)PB1)[i] = w; } }
    if (IN(10)) REPEAT(10) { const bool dmy = rep_ + 1 < REPS(10); unsigned char* wd = dmy ? ws + 300 * MiB : ws;
        p_router(F, HB2, arg_ptr(A_NORM_FFN) + D, arg_ptr(A_ROUTER), (float*)(wd + WS_RSTL), (int*)(wd + WS_LISTS), (float*)(wd + WS_GWL), (int*)(wd + WS_TOKSLOT), F.ctl + CW_MOECNT + (dmy ? 1024 : 0)); } SEAM(10);
    if (IN(11)) REPEAT(11) {
        pg8::MoeSched Sm; Sm.A = (const char*)HB2; Sm.B = (const char*)(ws + WS_WGU); Sm.lists = (const int*)(ws + WS_LISTS);
#pragma unroll
        for (int e = 0; e < 8; ++e) Sm.cnt[e] = __builtin_amdgcn_readfirstlane((int)__hip_atomic_load(F.ctl + CW_MOECNT + 64 * e, RLX_AGENT));
        Sm.nN = 28; Sm.G = F.G; Sm.c = bx; Sm.b_e = 2L * DFE * D * 2; Sm.b_pn = TS1024; Sm.a_row = 0; Sm.list_stride = M; Sm.gather = true; Sm.WGM = WGM_P11; Sm.lim = Sm.total();
        pg8::EpiSwiGLU<2> E{(bf16*)(ws + WS_HM), DFE, EPS, (const float*)(ws + WS_RSTL), (const int*)(ws + WS_LISTS)};
        pg8::gemm_phase<pg8::EpiSwiGLU<2>, pg8::MoeSched, true, true>(F.lds + RING_OFF, D, D, D, Sm, E);
        if (rep_ == 0) {
            volatile LAS int* bw = (volatile LAS int*)(F.lds + MISC_OFF + 96);
            for (;;) {
                if (F.tid == 0) bw[0] = (int)__hip_atomic_fetch_add(F.ctl + CW_STEAL, 1u, RLX_AGENT);
                __syncthreads();
                const int batch = __builtin_amdgcn_readfirstlane(bw[0]);
                __syncthreads();
                if (batch * 16 >= TI_MOE) break;
                conv_range(ws, (LAS unsigned*)(F.lds + RING_OFF + F.wave * 8192), F.lane, 2 * TI_MOE + batch * 16 + F.wave * 2, 1, 2, 3 * TI_MOE);
            }
        }
    } SEAM(11);
    pg8::MoeSchedT<true> Sdn; Sdn.A = (const char*)(ws + WS_HM); Sdn.B = (const char*)(ws + WS_WD); Sdn.lists = (const int*)(ws + WS_GWL);
    Sdn.nN = 4; Sdn.G = F.G; Sdn.c = bx; Sdn.b_e = (long)D * DFE * 2; Sdn.b_pn = 256L * DFE * 2; Sdn.a_row = (long)DFE * 2; Sdn.list_stride = M; Sdn.gather = false; Sdn.WGM = 8; Sdn.lim = 0;
    int dn_R = 0, dn_P = 1;
    if (IN(12) || IN(13) || IN(14)) {
#pragma unroll
        for (int e = 0; e < 8; ++e) Sdn.cnt[e] = __builtin_amdgcn_readfirstlane((int)__hip_atomic_load(F.ctl + CW_MOECNT + 64 * e, RLX_AGENT));
        const int tot = Sdn.total(), whole = (tot / F.G) * F.G;
        dn_R = tot - whole; Sdn.lim = whole;
        dn_P = (dn_R * 14 <= 192 && dn_R * 14 <= F.G) ? 14 : (dn_R * 7 <= 192 && dn_R * 7 <= F.G) ? 7 : (dn_R * 4 <= 192 && dn_R * 4 <= F.G) ? 4 : (dn_R * 2 <= 192 && dn_R * 2 <= F.G) ? 2 : 1;
        if (dn_R * dn_P > 192 || dn_R * dn_P > F.G) { Sdn.lim = tot; dn_R = 0; }
    }
    float* PART = (float*)(ws + 72 * MiB);
    if (IN(13) && dn_R > 0) {
        pg8::PieceSched Sp{Sdn, Sdn.lim, dn_R, dn_P, (long)(DFE / dn_P / 64) * 32768, (long)(DFE / dn_P) * 2};
        pg8::EpiPart E{PART};
        pg8::gemm_phase<pg8::EpiPart, pg8::PieceSched, false, true>(F.lds + RING_OFF, DFE / dn_P, DFE, DFE, Sp, E);
        if (bx < dn_R * dn_P && F.tid == 0) { __builtin_amdgcn_fence(__ATOMIC_RELEASE, "agent"); __hip_atomic_fetch_add(F.ctl + CW_PIECES, 1u, RLX_AGENT); }
    }
    if (IN(12)) REPEAT(12) {
        pg8::EpiMoeDown E{(bf16*)(ws + WS_YS)};
        pg8::gemm_phase<pg8::EpiMoeDown, pg8::MoeSchedT<true>, false, true>(F.lds + RING_OFF, DFE, DFE, DFE, Sdn, E);
    }
    if (IN(13)) {
        pg8::ProjSched Sp{(const char*)PB1, (const char*)(ws + WS_WPP1), 1, F.G, bx, dn_R * dn_P};
        pg8::EpiProj Ep{(bf16*)(ws + WS_PROJ0), ((long)WS_PROJ1 - (long)WS_PROJ0) / 2};
        pg8::gemm_phase<pg8::EpiProj, pg8::ProjSched, false, true>(F.lds + RING_OFF, PLE, PLE, PLE, Sp, Ep);
    }
    if (IN(14) && dn_R > 0) {
        if (F.tid == 0) { unsigned sp_ = 0; while (__hip_atomic_load(F.ctl + CW_PIECES, RLX_AGENT) < (unsigned)(dn_R * dn_P)) { __builtin_amdgcn_s_sleep(1); if (++sp_ > (1u << 22)) break; }
            __builtin_amdgcn_fence(__ATOMIC_ACQUIRE, "agent"); asm volatile("s_waitcnt vmcnt(0)" ::: "memory"); }
        __syncthreads();
        for (int w = F.vcu; w < dn_R * 16; w += F.G) {
            const int j = w >> 4, rl = (w & 15) * 16 + (F.tid >> 5), cl = (F.tid & 31) * 8;
            pg8::Unit u; Sdn.decode(Sdn.lim + j, u);
            if (rl < u.nvalid) {
                const float* pp = PART + (size_t)(j * dn_P) * 65536 + (size_t)rl * 256 + cl;
                f32x4 a = (f32x4){0.f, 0.f, 0.f, 0.f}, b = a;
                for (int p = 0; p < dn_P; ++p) { a += *(const GAS f32x4*)(pp + (size_t)p * 65536); b += *(const GAS f32x4*)(pp + (size_t)p * 65536 + 4); }
                const float gwt = ((const float*)u.list)[rl];
                v4u o; o.x = cvtpk(a.x * gwt, a.y * gwt); o.y = cvtpk(a.z * gwt, a.w * gwt); o.z = cvtpk(b.x * gwt, b.y * gwt); o.w = cvtpk(b.z * gwt, b.w * gwt);
                *(GAS v4u*)((bf16*)(ws + WS_YS) + (size_t)(u.r0 + rl) * D + u.c0 + cl) = o;
            }
        }
    }
    if ((IN(12) || IN(13) || IN(14)) && IN(15)) xcd_barrier(bar);
    if (IN(15)) { p_combine(F, HB2, HB1, (const bf16*)(ws + WS_YS), (const int*)(ws + WS_TOKSLOT), (float*)(ws + WS_RSTD2)); } SEAM(15);
    if (IN(16)) {
        pg8::DenseSched Sd{(const char*)HB1, (const char*)(ws + WS_WPG1), 64, 4, F.G, (F.G == 256) ? F.vcu : bx, TS1024, 0, TS1024, WGM_1U, (F.G == 256) ? 1 : 0};
        pg8::EpiPle<2, true> E{HB1, (const bf16*)(ws + WS_PROJ1), Hout, (const float*)(ws + WS_RSTD2), nullptr, EPS, 0};
        pg8::gemm_phase<pg8::EpiPle<2, true>, pg8::DenseSched, false, true>(F.lds + RING_OFF, D, D, D, Sd, E);
    }
#undef IN
#undef SEAM
}
extern "C" void kernel_launch(void* const* d_in, const int* in_sizes, int n_in, void* d_out, int out_size, void* d_ws, size_t ws_size, hipStream_t stream) {
    static int grid = 0;
    if (grid == 0) {
        if (n_in != 26 || in_sizes[0] != M * D || out_size != M * D || ws_size < WS_END) { fprintf(stderr, "kernel_launch: unexpected shapes / workspace (%zu)\n", ws_size); grid = -1; return; }
        int dev = 0, cus = 0, per_cu = 0;
        if (hipGetDevice(&dev) != hipSuccess || hipDeviceGetAttribute(&cus, hipDeviceAttributeMultiprocessorCount, dev) != hipSuccess) { grid = -1; return; }
        if (hipFuncSetAttribute((const void*)mega_fwd, hipFuncAttributeMaxDynamicSharedMemorySize, LDS_BYTES) != hipSuccess) { fprintf(stderr, "kernel_launch: hipFuncSetAttribute failed\n"); grid = -1; return; }
        if (hipOccupancyMaxActiveBlocksPerMultiprocessor(&per_cu, (const void*)mega_fwd, NWAVES * 64, LDS_BYTES) != hipSuccess || per_cu < 1) { fprintf(stderr, "kernel_launch: occupancy query says %d\n", per_cu); }
        (void)hipGetLastError();
        grid = cus;
    }
    if (grid < 0) return;
    if (hipMemsetAsync((char*)d_ws + WS_CTL, 0, CTL_ZERO_BYTES, stream) != hipSuccess) return;
    Args a{};
    for (int i = 0; i < 26; ++i) a.in[i] = (const float*)d_in[i];
    a.out = (float*)d_out; a.ws = (unsigned char*)d_ws;
#if MK_N_LAUNCHES == 1
    a.ph_lo = 0; a.ph_hi = MEGA_END; a.li = 0; a.pad = 0;
    hipLaunchKernelGGL(mega_fwd, dim3(grid), dim3(NWAVES * 64), LDS_BYTES, stream, a);
#else
    for (int ph = 0; ph < MEGA_END; ++ph) { a.ph_lo = ph; a.ph_hi = ph + 1; a.li = 0; a.pad = 0; hipLaunchKernelGGL(mega_fwd, dim3(grid), dim3(NWAVES * 64), LDS_BYTES, stream, a); }
#endif
#if MEGA_END < 17
    nv::naive_suffix(MEGA_END <= 5 ? 0 : MEGA_END <= 7 ? 1 : MEGA_END <= 8 ? 2 : MEGA_END <= 10 ? 3 : 4, d_in, (float*)d_out, (char*)d_ws, stream);
#endif
}
```
